# Optimizing an MI355X kernel written in HIP

```python
import jax, jax.numpy as jnp
from jax import lax
import numpy as np

D_MODEL = 1024
BATCH = 32
SEQ = 256
DEPTH = 2
DEC_BATCH = 4
DEC_SEQ = 1024
PAST_LEN = 256

GRID_W = 64
N_HEADS = 16
HEAD_DIM = D_MODEL // N_HEADS
WIN_H = 8
WIN_W = 16
Q_BLK_W = 16
K_BLK_W = 32
D_FF = 2816
N_MIXERS = 2
N_SC = (DEPTH + 1) // 2
N_NA = DEPTH // 2
CTX_Q_BLK = 128
EPS = 1e-6
NEG_INF = -1e30

kernel_name = "hybrid_shortconv_natten_diffusion_step"


def rmsnorm(x, g):
    xf = x.astype(jnp.float32)
    y = xf * lax.rsqrt(jnp.mean(xf * xf, axis=-1, keepdims=True) + EPS)
    return y.astype(x.dtype) * g


def adaln_params(cvec, w, b):
    m = jax.nn.silu(cvec) @ w + b
    return jnp.split(m[:, None, :], 6, axis=-1)


def modulate(h, shift, scale):
    return h * (1.0 + scale) + shift


def dwconv3(x, w, b):
    xp = jnp.pad(x, ((0, 0), (1, 1), (0, 0)))
    return xp[:, :-2] * w[0] + xp[:, 1:-1] * w[1] + xp[:, 2:] * w[2] + b


def short_conv_mixer(h, w_in, conv_w, conv_b, w_out):
    bg, cg, xv = jnp.split(h @ w_in, 3, axis=-1)
    return (bg * dwconv3(cg * xv, conv_w, conv_b)) @ w_out


def conv_ffn(h, w_up, conv_w, conv_b, w_down):
    u, g = jnp.split(h @ w_up, 2, axis=-1)
    u = dwconv3(u, conv_w, conv_b)
    return (jax.nn.gelu(u) * g) @ w_down


def split_heads(qkv):
    B, T, _ = qkv.shape
    qkv = qkv.reshape(B, T, 3, N_HEADS, HEAD_DIM).transpose(2, 0, 3, 1, 4)
    return qkv[0], qkv[1], qkv[2]


def merge_heads(o):
    B, H, T, dh = o.shape
    return o.transpose(0, 2, 1, 3).reshape(B, T, H * dh)


def context_attention(q, k, v):
    B, H, L, dh = q.shape
    nb = L // CTX_Q_BLK
    scale = HEAD_DIM ** -0.5
    qb = q.reshape(B, H, nb, CTX_Q_BLK, dh).transpose(2, 0, 1, 3, 4)

    def one_block(qblk):
        s = jnp.einsum('bhqd,bhkd->bhqk', qblk, k).astype(jnp.float32) * scale
        p = jax.nn.softmax(s, axis=-1).astype(v.dtype)
        return jnp.einsum('bhqk,bhkd->bhqd', p, v)

    o = lax.map(one_block, qb)
    return o.transpose(1, 2, 0, 3, 4).reshape(B, H, L, dh)


def neighbourhood_attention(q, k, v, k_ctx, v_ctx, rpb):
    B, H, N, dh = q.shape
    rows = N // GRID_W
    kh = min(WIN_H, rows)
    ncb = GRID_W // Q_BLK_W
    nk = kh * K_BLK_W
    scale = HEAD_DIM ** -0.5
    r = jnp.arange(rows)
    row_idx = jnp.clip(r - kh // 2, 0, rows - kh)[:, None] + jnp.arange(kh)
    j = jnp.arange(ncb)
    kb_start = jnp.clip(j * Q_BLK_W - WIN_W // 2, 0, GRID_W - K_BLK_W)
    col_idx = kb_start[:, None] + jnp.arange(K_BLK_W)
    qcol = j[:, None] * Q_BLK_W + jnp.arange(Q_BLK_W)
    col_start = jnp.clip(qcol - WIN_W // 2, 0, GRID_W - WIN_W)
    kc = col_idx[:, None, :]
    col_mask = (kc >= col_start[..., None]) & (kc < col_start[..., None] + WIN_W)
    dr = row_idx - r[:, None]
    dc = jnp.clip(kc - qcol[..., None], -(WIN_W - 1), WIN_W - 1)
    bias = rpb.astype(jnp.float32)[:, dr[:, None, None, :, None] + (WIN_H - 1),
                                   dc[None, :, :, None, :] + (WIN_W - 1)]
    bias = jnp.where(col_mask[None, None, :, :, None, :], bias, NEG_INF)
    bias = jnp.moveaxis(bias.reshape(H, rows, ncb, Q_BLK_W, nk), 1, 0)
    kg = k.reshape(B, H, rows, GRID_W, dh)
    vg = v.reshape(B, H, rows, GRID_W, dh)
    ri = row_idx[:, None, :, None]
    ci = col_idx[None, :, None, :]
    k_blk = jnp.moveaxis(kg[:, :, ri, ci].reshape(B, H, rows, ncb, nk, dh), 2, 0)
    v_blk = jnp.moveaxis(vg[:, :, ri, ci].reshape(B, H, rows, ncb, nk, dh), 2, 0)
    q_blk = jnp.moveaxis(q.reshape(B, H, rows, ncb, Q_BLK_W, dh), 2, 0)

    def one_row(args):
        q_r, k_r, v_r, b_r = args
        s_loc = jnp.einsum('bhjqd,bhjnd->bhjqn', q_r, k_r).astype(jnp.float32) * scale + b_r[None]
        s_ctx = jnp.einsum('bhjqd,bhld->bhjql', q_r, k_ctx).astype(jnp.float32) * scale
        p = jax.nn.softmax(jnp.concatenate([s_loc, s_ctx], axis=-1), axis=-1).astype(v_r.dtype)
        return (jnp.einsum('bhjqn,bhjnd->bhjqd', p[..., :nk], v_r)
                + jnp.einsum('bhjql,bhld->bhjqd', p[..., nk:], v_ctx))

    o = lax.map(one_row, (q_blk, k_blk, v_blk, bias))
    return jnp.moveaxis(o, 0, 2).reshape(B, H, N, dh)


def setup_inputs(seed: int = 0) -> dict:
    key = jax.random.key(seed)
    ks = jax.random.split(key, 24)
    D = D_MODEL
    nrm = jax.random.normal
    f32 = jnp.float32
    return {
        "x_prompt": nrm(ks[0], (BATCH, SEQ, D), f32),
        "x_sample": nrm(ks[1], (DEC_BATCH, DEC_SEQ, D), f32),
        "cache_k_ctx": nrm(ks[2], (DEC_BATCH, N_NA, N_HEADS, PAST_LEN, HEAD_DIM), f32),
        "cache_v_ctx": nrm(ks[3], (DEC_BATCH, N_NA, N_HEADS, PAST_LEN, HEAD_DIM), f32),
        "c": nrm(ks[4], (DEC_BATCH, D), f32),
        "c_ctx": nrm(ks[5], (D,), f32),
        "ada_w": nrm(ks[6], (DEPTH, D, 6 * D), f32) * (0.5 * D ** -0.5),
        "ada_b": nrm(ks[7], (DEPTH, 6 * D), f32) * 0.02,
        "norm_mix_g": 1.0 + 0.05 * nrm(ks[8], (DEPTH, D), f32),
        "norm_ffn_g": 1.0 + 0.05 * nrm(ks[9], (DEPTH, D), f32),
        "sc_w_in": nrm(ks[10], (N_SC, D, 3 * D), f32) * D ** -0.5,
        "sc_conv_w": nrm(ks[11], (N_SC, 3, D), f32) * 0.5,
        "sc_conv_b": nrm(ks[12], (N_SC, D), f32) * 0.02,
        "sc_w_out": nrm(ks[13], (N_SC, D, D), f32) * D ** -0.5,
        "na_w_qkv": nrm(ks[14], (N_NA, D, 3 * D), f32) * D ** -0.5,
        "na_rpb": nrm(ks[15], (N_NA, N_HEADS, 2 * WIN_H - 1, 2 * WIN_W - 1), f32) * 0.5,
        "na_w_o": nrm(ks[16], (N_NA, D, D), f32) * D ** -0.5,
        "ffn_w_up": nrm(ks[17], (DEPTH, D, 2 * D_FF), f32) * D ** -0.5,
        "ffn_conv_w": nrm(ks[18], (DEPTH, 3, D_FF), f32) * 0.5,
        "ffn_conv_b": nrm(ks[19], (DEPTH, D_FF), f32) * 0.02,
        "ffn_w_down": nrm(ks[20], (DEPTH, D_FF, D), f32) * D_FF ** -0.5,
        "final_g": 1.0 + 0.05 * nrm(ks[21], (D,), f32),
    }


def reference(x_prompt, x_sample, cache_k_ctx, cache_v_ctx, c, c_ctx, ada_w, ada_b,
              norm_mix_g, norm_ffn_g, sc_w_in, sc_conv_w, sc_conv_b, sc_w_out,
              na_w_qkv, na_rpb, na_w_o, ffn_w_up, ffn_conv_w, ffn_conv_b, ffn_w_down, final_g):
    xp = x_prompt
    xs = x_sample
    new_k, new_v = [], []
    for i in range(DEPTH):
        sh1p, sc1p, g1p, sh2p, sc2p, g2p = adaln_params(c_ctx[None, :], ada_w[i], ada_b[i])
        sh1s, sc1s, g1s, sh2s, sc2s, g2s = adaln_params(c, ada_w[i], ada_b[i])
        hp = modulate(rmsnorm(xp, norm_mix_g[i]), sh1p, sc1p)
        hs = modulate(rmsnorm(xs, norm_mix_g[i]), sh1s, sc1s)
        if i % N_MIXERS == 0:
            a = i // N_MIXERS
            yp = short_conv_mixer(hp, sc_w_in[a], sc_conv_w[a], sc_conv_b[a], sc_w_out[a])
            ys = short_conv_mixer(hs, sc_w_in[a], sc_conv_w[a], sc_conv_b[a], sc_w_out[a])
        else:
            b = i // N_MIXERS
            qp, kp, vp = split_heads(hp @ na_w_qkv[b])
            new_k.append(kp)
            new_v.append(vp)
            yp = merge_heads(context_attention(qp, kp, vp)) @ na_w_o[b]
            qs, ksl, vsl = split_heads(hs @ na_w_qkv[b])
            os_ = neighbourhood_attention(qs, ksl, vsl, cache_k_ctx[:, b], cache_v_ctx[:, b], na_rpb[b])
            ys = merge_heads(os_) @ na_w_o[b]
        xp = xp + g1p * yp
        xs = xs + g1s * ys
        hp = modulate(rmsnorm(xp, norm_ffn_g[i]), sh2p, sc2p)
        hs = modulate(rmsnorm(xs, norm_ffn_g[i]), sh2s, sc2s)
        xp = xp + g2p * conv_ffn(hp, ffn_w_up[i], ffn_conv_w[i], ffn_conv_b[i], ffn_w_down[i])
        xs = xs + g2s * conv_ffn(hs, ffn_w_up[i], ffn_conv_w[i], ffn_conv_b[i], ffn_w_down[i])
    y_prompt = rmsnorm(xp, final_g)
    y_sample = rmsnorm(xs, final_g)
    state_k_ctx = jnp.stack(new_k, axis=1)
    state_v_ctx = jnp.stack(new_v, axis=1)
    return (y_prompt, y_sample, state_k_ctx, state_v_ctx)
```

```cpp
#include <hip/hip_runtime.h>
#include <hip/hip_cooperative_groups.h>
#include <cstdio>
#include <cstdint>
namespace cg = cooperative_groups;

#ifndef MK_MULTI
#define MK_MULTI 1
#endif

#define LAS __attribute__((address_space(3)))
typedef unsigned short bf16_t;
typedef short bf16x8 __attribute__((ext_vector_type(8)));
typedef float f32x4 __attribute__((ext_vector_type(4)));
typedef float f32x2 __attribute__((ext_vector_type(2)));
typedef unsigned u32x4 __attribute__((ext_vector_type(4)));
typedef unsigned u32x2 __attribute__((ext_vector_type(2)));

constexpr int DM = 1024, NB_P = 32, SEQ_P = 256, NB_S = 4, SEQ_S = 1024, PAST = 256;
constexpr int MP = NB_P * SEQ_P;
constexpr int MS = NB_S * SEQ_S;
constexpr int MT = MP + MS;
constexpr int NH = 16, HD = 64, DFF = 2816, NCV = 5, MODW = 6 * DM;
constexpr float EPS = 1e-6f;
constexpr int NPH = 18;

constexpr size_t MiB = 1u << 20;
constexpr size_t WS_WIN = 0, WS_WOUT = 6 * MiB, WS_WQKV = 8 * MiB, WS_WO = 14 * MiB, WS_WUP = 16 * MiB, WS_WDN = 38 * MiB;
constexpr size_t WS_MOD = 49 * MiB, WS_KC = 50 * MiB, WS_VTC = 52 * MiB;
constexpr size_t WS_A3 = 54 * MiB, WS_H = WS_A3;
constexpr size_t WS_UG = 120 * MiB, WS_BCX = WS_UG, WS_A2 = 192 * MiB;
constexpr size_t WS_Q = 120 * MiB, WS_K = 144 * MiB, WS_VT = 168 * MiB;
constexpr size_t WS_END = 252 * MiB;
constexpr int LDS_BYTES = 147456;

struct Args { const float* in[22]; float* out; unsigned char* ws; int ph_lo, ph_hi; };

__device__ __forceinline__ unsigned cvt_pk_bf16(float lo, float hi) { unsigned r; asm volatile("v_cvt_pk_bf16_f32 %0, %1, %2" : "=v"(r) : "v"(lo), "v"(hi)); return r; }
__device__ __forceinline__ float bf_lo(unsigned u) { return __uint_as_float(u << 16); }
__device__ __forceinline__ float bf_hi(unsigned u) { return __uint_as_float(u & 0xffff0000u); }
__device__ __forceinline__ unsigned short f2bf(float f) { return (unsigned short)(cvt_pk_bf16(f, 0.f) & 0xffffu); }

namespace pg8 {
constexpr int BM = 256, BK = 64, HALF = 128, HTB = HALF * BK * 2, STAGE_BYTES = 8 * HTB, NXCD = 8, WGM = 8;
__host__ __device__ __forceinline__ int lds_byte(int r, int c) { const int st = (r >> 4) * 2 + (c >> 5), rr = r & 15, cc = c & 31, ob = rr * 64 + cc * 2; return st * 1024 + (ob ^ (((ob >> 9) & 1) << 5)); }
__host__ __device__ __forceinline__ void stage_rc(int b, int& R, int& C) { const int st = b / 1024, sb = b % 1024, swz = sb ^ (((sb >> 9) & 1) << 5); R = (st >> 1) * 16 + swz / 64; C = (st & 1) * 32 + (swz % 64) / 2; }
__host__ __device__ __forceinline__ int perm32(int rho) { const int n = rho >> 4, i = rho & 15; return 8 * (i >> 2) + 4 * n + (i & 3); }

struct Unit { int pm, pn; };
struct Gemm { const bf16_t* A; const bf16_t* Bt; int M, N, K; };

struct StaticOrder {
    int nM, nN, nwg, G, c;
    __device__ void init(int M, int N, int G_, int c_) { nM = M / BM; nN = N / BM; nwg = nM * nN; G = G_; c = c_; }
    __device__ bool next(int i, Unit& u) const {
        const long L = (long)i * G + c; if (L >= nwg) return false;
        int wgid = (int)L; { const int q = nwg / NXCD, r = nwg % NXCD, xcd = wgid % NXCD, off = wgid / NXCD; wgid = (xcd < r ? xcd * (q + 1) : r * (q + 1) + (xcd - r) * q) + off; }
        const int nig = WGM * nN, gid = wgid / nig, fm = gid * WGM, gsz = (nM - fm) < WGM ? (nM - fm) : WGM;
        u.pm = fm + ((wgid % nig) % gsz); u.pn = (wgid % nig) / gsz; return true;
    }
};

struct EpiBf16 {
    static constexpr bool PERM = true;
    bf16_t* O; int ldc;
    __device__ __forceinline__ void operator()(const f32x4 (&acc)[2][2][4][2], const Unit& u, int wr, int wc, int fr, int fq) const {
        const int row0 = u.pm * BM + wr * 64 + fr; const int col0 = u.pn * BM + wc * 32 + 8 * fq;
#pragma unroll
        for (int ai = 0; ai < 2; ++ai)
#pragma unroll
            for (int m = 0; m < 4; ++m) { bf16_t* rowp = O + (size_t)(row0 + ai * HALF + m * 16) * ldc + col0;
#pragma unroll
                for (int bj = 0; bj < 2; ++bj) { const f32x4 v0 = acc[ai][bj][m][0], v1 = acc[ai][bj][m][1];
                    u32x4 w; w.x = cvt_pk_bf16(v0[0], v0[1]); w.y = cvt_pk_bf16(v0[2], v0[3]); w.z = cvt_pk_bf16(v1[0], v1[1]); w.w = cvt_pk_bf16(v1[2], v1[3]);
                    *(u32x4*)(rowp + bj * HALF) = w; } }
    }
};

struct EpiRes {
    static constexpr bool PERM = false;
    const float* base_p; const float* base_s; float* out; const float* gate;
    __device__ __forceinline__ void operator()(const f32x4 (&acc)[2][2][4][2], const Unit& u, int wr, int wc, int fr, int fq) const {
        const int cv = u.pm < 32 ? 0 : 1 + ((u.pm - 32) >> 2);
        const int col0 = u.pn * BM + wc * 32 + 4 * fq;
        const float* gp = gate + cv * MODW + col0;
        f32x4 gv[2][2];
#pragma unroll
        for (int bj = 0; bj < 2; ++bj)
#pragma unroll
            for (int n = 0; n < 2; ++n) gv[bj][n] = *(const f32x4*)(gp + bj * HALF + n * 16);
        const float* bb = u.pm < 32 ? base_p + (size_t)u.pm * BM * DM : base_s + (size_t)(u.pm - 32) * BM * DM;
        float* ob = out + (size_t)u.pm * BM * DM;
#pragma unroll
        for (int ai = 0; ai < 2; ++ai)
#pragma unroll
            for (int m = 0; m < 4; ++m) { const size_t off = (size_t)(ai * HALF + wr * 64 + m * 16 + fr) * DM + col0;
#pragma unroll
                for (int bj = 0; bj < 2; ++bj)
#pragma unroll
                    for (int n = 0; n < 2; ++n) { const f32x4 bs = *(const f32x4*)(bb + off + bj * HALF + n * 16);
                        *(f32x4*)(ob + off + bj * HALF + n * 16) = bs + gv[bj][n] * acc[ai][bj][m][n]; }
                asm volatile("" ::: "memory"); }
    }
};

struct EpiQKV {
    static constexpr bool PERM = false;
    bf16_t* Q; bf16_t* Kb; bf16_t* Vt; float* sk; float* sv;
    __device__ __forceinline__ void operator()(const f32x4 (&acc)[2][2][4][2], const Unit& u, int wr, int wc, int fr, int fq) const {
        const int which = u.pn >> 2; const int cb = (u.pn & 3) * BM + wc * 32 + 4 * fq;
        const bool prompt = u.pm < 32;
        const int bidx = prompt ? u.pm : ((u.pm - 32) >> 2);
        const int tbase = (prompt ? 0 : ((u.pm - 32) & 3) * 256) + wr * 64 + fr;
        const int T = prompt ? SEQ_P : SEQ_S;
#pragma unroll
        for (int ai = 0; ai < 2; ++ai)
#pragma unroll
            for (int m = 0; m < 4; ++m) {
                const int t = tbase + ai * HALF + m * 16; const size_t row = (size_t)u.pm * BM + ai * HALF + wr * 64 + m * 16 + fr;
#pragma unroll
                for (int bj = 0; bj < 2; ++bj)
#pragma unroll
                    for (int n = 0; n < 2; ++n) { const int c = cb + bj * HALF + n * 16; const f32x4 v = acc[ai][bj][m][n];
                        if (which == 0) { u32x2 w; w.x = cvt_pk_bf16(v[0] * 0.125f, v[1] * 0.125f); w.y = cvt_pk_bf16(v[2] * 0.125f, v[3] * 0.125f); *(u32x2*)(Q + row * DM + c) = w; }
                        else if (which == 1) { u32x2 w; w.x = cvt_pk_bf16(v[0], v[1]); w.y = cvt_pk_bf16(v[2], v[3]); *(u32x2*)(Kb + row * DM + c) = w;
                            if (prompt) *(f32x4*)(sk + ((size_t)(bidx * NH + (c >> 6)) * SEQ_P + t) * HD + (c & 63)) = v; }
                        else { const int h = c >> 6, d = c & 63;
                            if (prompt) *(f32x4*)(sv + ((size_t)(bidx * NH + h) * SEQ_P + t) * HD + d) = v;
                            bf16_t* vp = Vt + (prompt ? 0 : (size_t)MP * DM) + ((size_t)(bidx * NH + h) * HD + d) * T + t;
                            vp[0] = f2bf(v[0]); vp[T] = f2bf(v[1]); vp[2 * T] = f2bf(v[2]); vp[3 * T] = f2bf(v[3]); }
                    }
            }
    }
};

template <class Epi, class Sched>
__device__ __forceinline__ void gemm_phase(LAS unsigned char* lds, const Gemm g, const Sched& S, const Epi& E, const int tid) {
    const int wid = __builtin_amdgcn_readfirstlane(tid >> 6), lane = tid & 63, wr = wid >> 2, wc = wid & 3, fr = lane & 15, fq = lane >> 4;
    const int K = g.K, nt = K / BK;
    unsigned voffA[2], voffB[2];
#pragma unroll
    for (int i = 0; i < 2; ++i) { int R, C; stage_rc(tid * 16 + i * 8192, R, C); const int Rb = Epi::PERM ? ((R & ~31) + perm32(R & 31)) : R;
        voffA[i] = (unsigned)(R * K + C) * 2u; voffB[i] = (unsigned)(Rb * K + C) * 2u; }
    const size_t kstep = (size_t)(BK * 2);
    const size_t hstep = (size_t)HALF * K * 2;
    const size_t tstep = 2 * hstep;
    const unsigned ldsw = (unsigned)wid * 1024u;
    const int aoff = lds_byte(wr * 64 + fr, fq * 8), boff = lds_byte(wc * 32 + fr, fq * 8);
#define PG8_SA(b, h) (((b) * 2 + (h)) * HTB)
#define PG8_SB(b, h) ((4 + (b) * 2 + (h)) * HTB)
#define PG8_STAGE(bufoff, gbase, voff) do { _Pragma("unroll") for (int _i = 0; _i < 2; ++_i) \
        __builtin_amdgcn_global_load_lds((const unsigned*)((const char*)(gbase) + (voff)[_i]), (LAS unsigned*)(lds + (bufoff) + ldsw + _i * 8192), 16, 0, 0); } while (0)
#define PG8_LDA(dst, b, h) do { _Pragma("unroll") for (int m = 0; m < 4; ++m) _Pragma("unroll") for (int k = 0; k < 2; ++k) dst[m][k] = *(const LAS bf16x8*)(lds + PG8_SA(b, h) + aoff + m * 2048 + k * 1024); } while (0)
#define PG8_LDB(dst, b, h) do { _Pragma("unroll") for (int n = 0; n < 2; ++n) _Pragma("unroll") for (int k = 0; k < 2; ++k) dst[n][k] = *(const LAS bf16x8*)(lds + PG8_SB(b, h) + boff + n * 2048 + k * 1024); } while (0)
#define PG8_MMA(ai, bj, At, Bt) do { __builtin_amdgcn_s_setprio(1); _Pragma("unroll") for (int m = 0; m < 4; ++m) _Pragma("unroll") for (int n = 0; n < 2; ++n) _Pragma("unroll") for (int k = 0; k < 2; ++k) \
        acc[ai][bj][m][n] = __builtin_amdgcn_mfma_f32_16x16x32_bf16(Bt[n][k], At[m][k], acc[ai][bj][m][n], 0, 0, 0); __builtin_amdgcn_s_setprio(0); } while (0)
#define PG8_WAIT_V(n) asm volatile("s_waitcnt vmcnt(" #n ")" ::: "memory")
#define PG8_WAIT_L(n) asm volatile("s_waitcnt lgkmcnt(" #n ")" ::: "memory")
#define PG8_BAR __builtin_amdgcn_s_barrier()
#define PG8_SCHED __builtin_amdgcn_sched_barrier(0)
    Unit cur, nxt; int ui = 0;
    if (!S.next(0, cur)) return;
    f32x4 acc[2][2][4][2];
#pragma unroll
    for (int a = 0; a < 2; ++a)
#pragma unroll
        for (int b = 0; b < 2; ++b)
#pragma unroll
            for (int m = 0; m < 4; ++m)
#pragma unroll
                for (int n = 0; n < 2; ++n) acc[a][b][m][n] = (f32x4){0.f, 0.f, 0.f, 0.f};
    bf16x8 At[4][2], B0[2][2], B1[2][2];
    const char* cA = (const char*)g.A + (size_t)cur.pm * tstep; const char* cB = (const char*)g.Bt + (size_t)cur.pn * tstep;
    PG8_STAGE(PG8_SB(0, 0), cB, voffB); PG8_STAGE(PG8_SB(0, 1), cB + hstep, voffB); PG8_STAGE(PG8_SA(0, 0), cA, voffA); PG8_STAGE(PG8_SA(0, 1), cA + hstep, voffA);
    if (wr == 1) PG8_BAR;
    PG8_WAIT_V(2); PG8_BAR;
    PG8_STAGE(PG8_SB(1, 0), cB + kstep, voffB); PG8_STAGE(PG8_SA(1, 0), cA + kstep, voffA); PG8_STAGE(PG8_SB(1, 1), cB + hstep + kstep, voffB);
    PG8_WAIT_V(6); PG8_BAR;
    for (;;) {
        const bool has_next = S.next(ui + 1, nxt);
        const char* nA = has_next ? (const char*)g.A + (size_t)nxt.pm * tstep : cA; const char* nB = has_next ? (const char*)g.Bt + (size_t)nxt.pn * tstep : cB;
        for (int t = 0; t < nt; t += 2) {
            const bool last = (t == nt - 2);
            const char* a1 = cA + (size_t)(t + 1) * kstep;
            const char* a2 = last ? nA : cA + (size_t)(t + 2) * kstep; const char* b2 = last ? nB : cB + (size_t)(t + 2) * kstep;
            const char* a3 = a2 + kstep; const char* b3 = b2 + kstep;
            PG8_LDB(B0, 0, 0); PG8_LDB(B1, 0, 1); PG8_SCHED; PG8_LDA(At, 0, 0); PG8_STAGE(PG8_SA(1, 1), a1 + hstep, voffA);
            PG8_WAIT_V(8); PG8_WAIT_L(0); PG8_BAR; PG8_MMA(0, 0, At, B0); PG8_MMA(0, 1, At, B1); PG8_BAR; PG8_SCHED;
            PG8_LDA(At, 0, 1); PG8_STAGE(PG8_SB(0, 0), b2, voffB); PG8_STAGE(PG8_SB(0, 1), b2 + hstep, voffB); PG8_STAGE(PG8_SA(0, 0), a2, voffA);
            PG8_WAIT_V(8); PG8_WAIT_L(0); PG8_BAR; PG8_MMA(1, 0, At, B0); PG8_MMA(1, 1, At, B1); PG8_BAR; PG8_SCHED;
            PG8_LDB(B0, 1, 0); PG8_LDB(B1, 1, 1); PG8_SCHED; PG8_LDA(At, 1, 0); PG8_STAGE(PG8_SA(0, 1), a2 + hstep, voffA);
            PG8_WAIT_V(8); PG8_WAIT_L(0); PG8_BAR; PG8_MMA(0, 0, At, B0); PG8_MMA(0, 1, At, B1); PG8_BAR; PG8_SCHED;
            PG8_LDA(At, 1, 1); PG8_STAGE(PG8_SB(1, 0), b3, voffB); PG8_STAGE(PG8_SB(1, 1), b3 + hstep, voffB); PG8_STAGE(PG8_SA(1, 0), a3, voffA);
            PG8_WAIT_V(8); PG8_WAIT_L(0); PG8_BAR; PG8_MMA(1, 0, At, B0); PG8_MMA(1, 1, At, B1); PG8_BAR; PG8_SCHED;
        }
        if (wr == 0) PG8_BAR;
        E(acc, cur, wr, wc, fr, fq);
        if (!has_next) break;
#pragma unroll
        for (int a = 0; a < 2; ++a)
#pragma unroll
            for (int b = 0; b < 2; ++b)
#pragma unroll
                for (int m = 0; m < 4; ++m)
#pragma unroll
                    for (int n = 0; n < 2; ++n) acc[a][b][m][n] = (f32x4){0.f, 0.f, 0.f, 0.f};
        cur = nxt; cA = nA; cB = nB; ++ui;
        if (wr == 1) PG8_BAR;
    }
    PG8_WAIT_V(0);
    PG8_BAR;
#undef PG8_SA
#undef PG8_SB
#undef PG8_STAGE
#undef PG8_LDA
#undef PG8_LDB
#undef PG8_MMA
#undef PG8_WAIT_V
#undef PG8_WAIT_L
#undef PG8_BAR
#undef PG8_SCHED
}
}

__device__ __forceinline__ float wave_sum(float v) {
#pragma unroll
    for (int o = 1; o < 64; o <<= 1) v += __shfl_xor(v, o);
    return v;
}
#define LDS_WAIT() asm volatile("s_waitcnt lgkmcnt(0)" ::: "memory")

__device__ __forceinline__ void p0_transpose_item(const float* W, int K, int N, bf16_t* WT, LAS float* scr, int item, int lane) {
    const int nblk = N / 32, kb = item / nblk, nb = item % nblk, k0 = 64 * kb, n0 = 32 * nb;
#pragma unroll 8
    for (int i = 0; i < 32; ++i) { const int kk = 2 * i + (lane >> 5); scr[kk * 33 + (lane & 31)] = W[(size_t)(k0 + kk) * N + n0 + (lane & 31)]; }
    LDS_WAIT(); asm volatile("" ::: "memory");
    const int c = lane & 7;
#pragma unroll
    for (int j = 0; j < 4; ++j) { const int n = (lane >> 3) + 8 * j; const LAS float* s = scr + (8 * c) * 33 + n;
        u32x4 o; o.x = cvt_pk_bf16(s[0 * 33], s[1 * 33]); o.y = cvt_pk_bf16(s[2 * 33], s[3 * 33]); o.z = cvt_pk_bf16(s[4 * 33], s[5 * 33]); o.w = cvt_pk_bf16(s[6 * 33], s[7 * 33]);
        *(u32x4*)(WT + (size_t)(n0 + n) * K + k0 + 8 * c) = o; }
    LDS_WAIT(); asm volatile("" ::: "memory");
}

__device__ __forceinline__ void prologue(const Args& a, LAS unsigned char* lds, int tid, int wave, int lane, int bid, int G) {
    unsigned char* ws = a.ws;
    float* MOD = (float*)(ws + WS_MOD);
    LAS float* sil = (LAS float*)lds;
    LAS float* red = (LAS float*)(lds + 5 * 1024 * 4);
    for (int i = tid; i < NCV * DM; i += 512) { const int cv = i >> 10, k = i & 1023; const float x = cv == 0 ? a.in[5][k] : a.in[4][(cv - 1) * DM + k]; sil[i] = x / (1.f + __expf(-x)); }
    __syncthreads();
    for (int item = bid; item < 2 * (MODW / 32); item += G) {
        const int l = item / (MODW / 32), col0 = (item % (MODW / 32)) * 32;
        const float* W = a.in[6] + (size_t)l * DM * MODW + col0 + 4 * (lane & 7);
        f32x4 acc[NCV];
#pragma unroll
        for (int cv = 0; cv < NCV; ++cv) acc[cv] = (f32x4){0.f, 0.f, 0.f, 0.f};
#pragma unroll 4
        for (int i = 0; i < 16; ++i) { const int k = 128 * wave + 8 * i + (lane >> 3); const f32x4 w = *(const f32x4*)(W + (size_t)k * MODW);
#pragma unroll
            for (int cv = 0; cv < NCV; ++cv) acc[cv] += sil[cv * DM + k] * w; }
#pragma unroll
        for (int cv = 0; cv < NCV; ++cv)
#pragma unroll
            for (int j = 0; j < 4; ++j) { float v = acc[cv][j]; v += __shfl_xor(v, 8); v += __shfl_xor(v, 16); v += __shfl_xor(v, 32); acc[cv][j] = v; }
        if (lane < 8) {
#pragma unroll
            for (int cv = 0; cv < NCV; ++cv)
#pragma unroll
                for (int j = 0; j < 4; ++j) red[(wave * NCV + cv) * 32 + 4 * lane + j] = acc[cv][j];
        }
        __syncthreads();
        if (tid < NCV * 32) { const int cv = tid >> 5, c = tid & 31; float s = 0.f;
#pragma unroll
            for (int w = 0; w < 8; ++w) s += red[(w * NCV + cv) * 32 + c];
            MOD[((size_t)l * NCV + cv) * MODW + col0 + c] = s + a.in[7][l * MODW + col0 + c]; }
        __syncthreads();
    }
    __syncthreads();
    LAS float* scr = (LAS float*)(lds + wave * 16384);
    const int gw = bid * 8 + wave, NGW = G * 8;
    constexpr int I_IN = 16 * 96, I_OUT = 16 * 32, I_UP = 16 * 176, I_DN = 44 * 32;
    constexpr int NITEMS = 2 * I_IN + 2 * I_OUT + 2 * I_UP + 2 * I_DN;
    for (int it = gw; it < NITEMS; it += NGW) {
        int r = it;
        if (r < I_IN) { p0_transpose_item(a.in[10], DM, 3 * DM, (bf16_t*)(ws + WS_WIN), scr, r, lane); continue; } r -= I_IN;
        if (r < I_IN) { p0_transpose_item(a.in[14], DM, 3 * DM, (bf16_t*)(ws + WS_WQKV), scr, r, lane); continue; } r -= I_IN;
        if (r < I_OUT) { p0_transpose_item(a.in[13], DM, DM, (bf16_t*)(ws + WS_WOUT), scr, r, lane); continue; } r -= I_OUT;
        if (r < I_OUT) { p0_transpose_item(a.in[16], DM, DM, (bf16_t*)(ws + WS_WO), scr, r, lane); continue; } r -= I_OUT;
        if (r < 2 * I_UP) { const int l = r / I_UP; p0_transpose_item(a.in[17] + (size_t)l * DM * 2 * DFF, DM, 2 * DFF, (bf16_t*)(ws + WS_WUP) + (size_t)l * DM * 2 * DFF, scr, r % I_UP, lane); continue; } r -= 2 * I_UP;
        { const int l = r / I_DN; p0_transpose_item(a.in[20] + (size_t)l * DM * DFF, DFF, DM, (bf16_t*)(ws + WS_WDN) + (size_t)l * DM * DFF, scr, r % I_DN, lane); }
    }
    const int gt = bid * 512 + tid, NGT = G * 512;
    bf16_t* Kc = (bf16_t*)(ws + WS_KC); bf16_t* Vtc = (bf16_t*)(ws + WS_VTC);
    for (int i = gt; i < NB_S * NH * PAST * HD; i += NGT) {
        Kc[i] = f2bf(a.in[2][i]);
        const int t = i & 255, d = (i >> 8) & 63, bh = i >> 14;
        Vtc[i] = f2bf(a.in[3][((size_t)bh * PAST + t) * HD + d]);
    }
}

__device__ __forceinline__ void norm_phase(const Args& a, int ph, int wave, int lane, int bid, int G) {
    const int gw = bid * 8 + wave, NGW = G * 8;
    const bool is_final = ph == 17, ffn = (ph == 5 || ph == 13); const int layer = ph >= 9 ? 1 : 0;
    const float* g = is_final ? a.in[21] : ((ffn ? a.in[9] : a.in[8]) + layer * DM);
    const float* mod = (const float*)(a.ws + WS_MOD) + (size_t)layer * NCV * MODW + (ffn ? 3 * DM : 0);
    bf16_t* H = (bf16_t*)(a.ws + WS_H);
    f32x4 gv[4];
#pragma unroll
    for (int j = 0; j < 4; ++j) gv[j] = *(const f32x4*)(g + 4 * lane + 256 * j);
    for (int row = gw; row < MT; row += NGW) {
        const float* xr = (ph == 1) ? (row < MP ? a.in[0] + (size_t)row * DM : a.in[1] + (size_t)(row - MP) * DM) : a.out + (size_t)row * DM;
        f32x4 v[4]; float s = 0.f;
#pragma unroll
        for (int j = 0; j < 4; ++j) { v[j] = *(const f32x4*)(xr + 4 * lane + 256 * j); s += (v[j].x * v[j].x + v[j].y * v[j].y) + (v[j].z * v[j].z + v[j].w * v[j].w); }
        const float rstd = 1.0f / sqrtf(wave_sum(s) * (1.f / DM) + EPS);
        if (is_final) {
#pragma unroll
            for (int j = 0; j < 4; ++j) *(f32x4*)(a.out + (size_t)row * DM + 4 * lane + 256 * j) = (v[j] * rstd) * gv[j];
        } else {
            const int cv = row < MP ? 0 : 1 + ((row - MP) >> 10);
            const float* mp = mod + (size_t)cv * MODW + 4 * lane;
#pragma unroll
            for (int j = 0; j < 4; ++j) { const f32x4 sh = *(const f32x4*)(mp + 256 * j), sc = *(const f32x4*)(mp + DM + 256 * j);
                const f32x4 h = ((v[j] * rstd) * gv[j]) * (1.0f + sc) + sh;
                u32x2 w; w.x = cvt_pk_bf16(h.x, h.y); w.y = cvt_pk_bf16(h.z, h.w);
                *(u32x2*)(H + (size_t)row * DM + 4 * lane + 256 * j) = w; }
        }
    }
}

struct F8 { float v[8]; };
__device__ __forceinline__ F8 ld8(const bf16_t* p) { const u32x4 w = *(const u32x4*)p; F8 r; r.v[0] = bf_lo(w.x); r.v[1] = bf_hi(w.x); r.v[2] = bf_lo(w.y); r.v[3] = bf_hi(w.y); r.v[4] = bf_lo(w.z); r.v[5] = bf_hi(w.z); r.v[6] = bf_lo(w.w); r.v[7] = bf_hi(w.w); return r; }
__device__ __forceinline__ F8 ldf8(const float* p) { const f32x4 a = *(const f32x4*)p, b = *(const f32x4*)(p + 4); F8 r; r.v[0] = a.x; r.v[1] = a.y; r.v[2] = a.z; r.v[3] = a.w; r.v[4] = b.x; r.v[5] = b.y; r.v[6] = b.z; r.v[7] = b.w; return r; }
__device__ __forceinline__ void st8(bf16_t* p, const F8& o) { u32x4 w; w.x = cvt_pk_bf16(o.v[0], o.v[1]); w.y = cvt_pk_bf16(o.v[2], o.v[3]); w.z = cvt_pk_bf16(o.v[4], o.v[5]); w.w = cvt_pk_bf16(o.v[6], o.v[7]); *(u32x4*)p = w; }
__device__ __forceinline__ F8 zero8() { F8 r;
#pragma unroll
    for (int e = 0; e < 8; ++e) r.v[e] = 0.f;
    return r; }

constexpr int RS = 8;
__device__ __forceinline__ void convgate_phase(const Args& a, int tid, int bid, int G) {
    const bf16_t* BCX = (const bf16_t*)(a.ws + WS_BCX); bf16_t* A2 = (bf16_t*)(a.ws + WS_A2);
    const float* cw = a.in[11]; const float* cbias = a.in[12];
    const int gt = bid * 512 + tid, NGT = G * 512;
    for (int item = gt; item < (MT / RS) * (DM / 8); item += NGT) {
        const int strip = item >> 7, c = (item & 127) * 8, r0 = strip * RS;
        const int seqm = r0 < MP ? (SEQ_P - 1) : (SEQ_S - 1);
        const bool first = (r0 & seqm) == 0, last = ((r0 + RS) & seqm) == 0;
        const F8 w0 = ldf8(cw + c), w1 = ldf8(cw + DM + c), w2 = ldf8(cw + 2 * DM + c), cb = ldf8(cbias + c);
        const bf16_t* p = BCX + (size_t)r0 * (3 * DM) + c;
        F8 prev = zero8(), cur, nxt;
        if (!first) { const F8 x = ld8(p - 3 * DM + DM), y = ld8(p - 3 * DM + 2 * DM);
#pragma unroll
            for (int e = 0; e < 8; ++e) prev.v[e] = x.v[e] * y.v[e]; }
        { const F8 x = ld8(p + DM), y = ld8(p + 2 * DM);
#pragma unroll
            for (int e = 0; e < 8; ++e) cur.v[e] = x.v[e] * y.v[e]; }
#pragma unroll
        for (int i = 0; i < RS; ++i) {
            nxt = zero8();
            if (!(i == RS - 1 && last)) { const F8 x = ld8(p + (size_t)(i + 1) * 3 * DM + DM), y = ld8(p + (size_t)(i + 1) * 3 * DM + 2 * DM);
#pragma unroll
                for (int e = 0; e < 8; ++e) nxt.v[e] = x.v[e] * y.v[e]; }
            const F8 bg = ld8(p + (size_t)i * 3 * DM); F8 o;
#pragma unroll
            for (int e = 0; e < 8; ++e) o.v[e] = bg.v[e] * (w0.v[e] * prev.v[e] + w1.v[e] * cur.v[e] + w2.v[e] * nxt.v[e] + cb.v[e]);
            st8(A2 + (size_t)(r0 + i) * DM + c, o);
            prev = cur; cur = nxt;
        }
    }
}
__device__ __forceinline__ float gelu_tanh(float x) {
    const float z = 0.7978845608028654f * (x + 0.044715f * x * x * x);
    return x / (1.0f + __expf(-2.0f * z));
}
__device__ __forceinline__ void ffngate_phase(const Args& a, int layer, int tid, int bid, int G) {
    const bf16_t* UG = (const bf16_t*)(a.ws + WS_UG); bf16_t* A3 = (bf16_t*)(a.ws + WS_A3);
    const float* cw = a.in[18] + (size_t)layer * 3 * DFF; const float* cbias = a.in[19] + (size_t)layer * DFF;
    const int gt = bid * 512 + tid, NGT = G * 512;
    constexpr int NCG = DFF / 8;
    for (int item = gt; item < (MT / RS) * NCG; item += NGT) {
        const int strip = item / NCG, c = (item % NCG) * 8, r0 = strip * RS;
        const int seqm = r0 < MP ? (SEQ_P - 1) : (SEQ_S - 1);
        const bool first = (r0 & seqm) == 0, last = ((r0 + RS) & seqm) == 0;
        const F8 w0 = ldf8(cw + c), w1 = ldf8(cw + DFF + c), w2 = ldf8(cw + 2 * DFF + c), cb = ldf8(cbias + c);
        const bf16_t* p = UG + (size_t)r0 * (2 * DFF) + c;
        F8 prev = zero8(), cur, nxt;
        if (!first) prev = ld8(p - 2 * DFF);
        cur = ld8(p);
#pragma unroll
        for (int i = 0; i < RS; ++i) {
            nxt = zero8();
            if (!(i == RS - 1 && last)) nxt = ld8(p + (size_t)(i + 1) * 2 * DFF);
            const F8 gg = ld8(p + (size_t)i * 2 * DFF + DFF); F8 o;
#pragma unroll
            for (int e = 0; e < 8; ++e) o.v[e] = gelu_tanh(w0.v[e] * prev.v[e] + w1.v[e] * cur.v[e] + w2.v[e] * nxt.v[e] + cb.v[e]) * gg.v[e];
            st8(A3 + (size_t)(r0 + i) * DFF + c, o);
            prev = cur; cur = nxt;
        }
    }
}

template <bool BIAS>
__device__ __forceinline__ void attn_chunk(const bf16_t* Kp, int kpitch, const bf16_t* Vp, int vpitch, int tok0, int gstride,
                                           const bf16x8 qf0, const bf16x8 qf1, float& m_run, float& l_run, f32x4 (&o)[4],
                                           const float* rpb_h, int drow0, int kc0, int qc, int lane) {
    const int i = lane & 15, q = lane >> 4;
    f32x4 s[8];
#pragma unroll
    for (int kt = 0; kt < 8; ++kt) {
        const bf16_t* kp = Kp + (size_t)(tok0 + (kt >> 1) * gstride + (kt & 1) * 16 + i) * kpitch + 8 * q;
        const bf16x8 a0 = *(const bf16x8*)kp, a1 = *(const bf16x8*)(kp + 32);
        f32x4 z = (f32x4){0.f, 0.f, 0.f, 0.f};
        z = __builtin_amdgcn_mfma_f32_16x16x32_bf16(a0, qf0, z, 0, 0, 0);
        s[kt] = __builtin_amdgcn_mfma_f32_16x16x32_bf16(a1, qf1, z, 0, 0, 0);
    }
    if (BIAS) {
        const int cs = min(max(qc - 8, 0), 48);
#pragma unroll
        for (int kt = 0; kt < 8; ++kt) {
            const float* rp = rpb_h + ((kt >> 1) + drow0) * 31;
#pragma unroll
            for (int j = 0; j < 4; ++j) { const int kc = kc0 + (kt & 1) * 16 + 4 * q + j; const bool ok = (kc >= cs) && (kc < cs + 16);
                const int dc = min(max(kc - qc, -15), 15);
                s[kt][j] = ok ? s[kt][j] + rp[dc + 15] : -1e30f; }
        }
    }
    float mx = -1e30f;
#pragma unroll
    for (int kt = 0; kt < 8; ++kt) mx = fmaxf(mx, fmaxf(fmaxf(s[kt][0], s[kt][1]), fmaxf(s[kt][2], s[kt][3])));
    mx = fmaxf(mx, __shfl_xor(mx, 16)); mx = fmaxf(mx, __shfl_xor(mx, 32));
    const float m_new = fmaxf(m_run, mx), alpha = __expf(m_run - m_new);
    float ls = 0.f;
#pragma unroll
    for (int kt = 0; kt < 8; ++kt)
#pragma unroll
        for (int j = 0; j < 4; ++j) { const float p = __expf(s[kt][j] - m_new); s[kt][j] = p; ls += p; }
    ls += __shfl_xor(ls, 16); ls += __shfl_xor(ls, 32);
    l_run = l_run * alpha + ls; m_run = m_new;
#pragma unroll
    for (int dt = 0; dt < 4; ++dt) o[dt] = o[dt] * alpha;
#pragma unroll
    for (int g = 0; g < 4; ++g) {
        u32x4 pw; pw.x = cvt_pk_bf16(s[2 * g][0], s[2 * g][1]); pw.y = cvt_pk_bf16(s[2 * g][2], s[2 * g][3]);
        pw.z = cvt_pk_bf16(s[2 * g + 1][0], s[2 * g + 1][1]); pw.w = cvt_pk_bf16(s[2 * g + 1][2], s[2 * g + 1][3]);
        const bf16x8 pb = __builtin_bit_cast(bf16x8, pw);
#pragma unroll
        for (int dt = 0; dt < 4; ++dt) {
            const bf16_t* vp = Vp + (size_t)(16 * dt + i) * vpitch + tok0 + g * gstride + 4 * q;
            const u32x2 lo = *(const u32x2*)vp, hi = *(const u32x2*)(vp + 16);
            u32x4 vw; vw.x = lo.x; vw.y = lo.y; vw.z = hi.x; vw.w = hi.y;
            o[dt] = __builtin_amdgcn_mfma_f32_16x16x32_bf16(__builtin_bit_cast(bf16x8, vw), pb, o[dt], 0, 0, 0);
        }
    }
    asm volatile("" ::: "memory");
}

__device__ __forceinline__ void attn_phase(const Args& a, int wave, int lane, int bid, int G) {
    const bf16_t* Q = (const bf16_t*)(a.ws + WS_Q); const bf16_t* Kb = (const bf16_t*)(a.ws + WS_K); const bf16_t* Vt = (const bf16_t*)(a.ws + WS_VT);
    const bf16_t* Kc = (const bf16_t*)(a.ws + WS_KC); const bf16_t* Vtc = (const bf16_t*)(a.ws + WS_VTC);
    bf16_t* O = (bf16_t*)(a.ws + WS_A2);
    const int gw = bid * 8 + wave, NGW = G * 8;
    const int i = lane & 15, q = lane >> 4;
    constexpr int N_CTX = NB_P * NH * (SEQ_P / 16), N_NA = NB_S * NH * 16 * 4;
    for (int item = gw; item < N_CTX + N_NA; item += NGW) {
        float m_run = -1e30f, l_run = 0.f; f32x4 o[4];
#pragma unroll
        for (int dt = 0; dt < 4; ++dt) o[dt] = (f32x4){0.f, 0.f, 0.f, 0.f};
        size_t qrow; int h;
        if (item < N_CTX) {
            const int bh = item >> 4, qb = item & 15, b = bh >> 4; h = bh & 15;
            qrow = (size_t)b * SEQ_P + qb * 16;
            const bf16_t* qp = Q + (qrow + i) * DM + h * HD + 8 * q;
            const bf16x8 qf0 = *(const bf16x8*)qp, qf1 = *(const bf16x8*)(qp + 32);
            const bf16_t* kp = Kb + (size_t)b * SEQ_P * DM + h * HD; const bf16_t* vp = Vt + (size_t)bh * HD * SEQ_P;
#pragma unroll 1
            for (int c = 0; c < 2; ++c) attn_chunk<false>(kp, DM, vp, SEQ_P, c * 128, 32, qf0, qf1, m_run, l_run, o, nullptr, 0, 0, 0, lane);
        } else {
            const int it2 = item - N_CTX, jb = it2 & 3, r = (it2 >> 2) & 15, bh = it2 >> 6, b = bh >> 4; h = bh & 15;
            const int r0 = min(max(r - 4, 0), 8), kb0 = min(max(jb * 16 - 8, 0), 32);
            qrow = (size_t)MP + (size_t)b * SEQ_S + r * 64 + jb * 16;
            const bf16_t* qp = Q + (qrow + i) * DM + h * HD + 8 * q;
            const bf16x8 qf0 = *(const bf16x8*)qp, qf1 = *(const bf16x8*)(qp + 32);
            const float* rpb_h = a.in[15] + (size_t)h * 15 * 31;
            const bf16_t* kp = Kb + ((size_t)MP + (size_t)b * SEQ_S) * DM + h * HD; const bf16_t* vp = Vt + (size_t)MP * DM + (size_t)bh * HD * SEQ_S;
#pragma unroll 1
            for (int c = 0; c < 2; ++c) attn_chunk<true>(kp, DM, vp, SEQ_S, (r0 + 4 * c) * 64 + kb0, 64, qf0, qf1, m_run, l_run, o, rpb_h, r0 + 4 * c - r + 7, kb0, jb * 16 + i, lane);
            const bf16_t* kcp = Kc + (size_t)bh * PAST * HD; const bf16_t* vcp = Vtc + (size_t)bh * HD * PAST;
#pragma unroll 1
            for (int c = 0; c < 2; ++c) attn_chunk<false>(kcp, HD, vcp, PAST, c * 128, 32, qf0, qf1, m_run, l_run, o, nullptr, 0, 0, 0, lane);
        }
        const float inv = 1.0f / l_run;
        bf16_t* op = O + (qrow + i) * DM + h * HD + 4 * q;
#pragma unroll
        for (int dt = 0; dt < 4; ++dt) { u32x2 w; w.x = cvt_pk_bf16(o[dt][0] * inv, o[dt][1] * inv); w.y = cvt_pk_bf16(o[dt][2] * inv, o[dt][3] * inv); *(u32x2*)(op + 16 * dt) = w; }
    }
}

__global__ void __launch_bounds__(512, 2) fwd_kernel(Args a) {
    extern __shared__ __attribute__((aligned(16))) unsigned char lds_raw[];
    LAS unsigned char* lds = (LAS unsigned char*)lds_raw;
    unsigned char* ws = a.ws;
    for (int ph = a.ph_lo; ph < a.ph_hi; ++ph) {
        if (ph > a.ph_lo) { cg::this_grid().sync(); }
        int tid = threadIdx.x, bid = blockIdx.x, G = gridDim.x;
        asm volatile("" : "+v"(tid)); asm volatile("" : "+s"(bid)); asm volatile("" : "+s"(G));
        const int lane = tid & 63, wave = __builtin_amdgcn_readfirstlane(tid >> 6);
        if (ph == 0) {
#ifndef DIS_P0
 prologue(a, lds, tid, wave, lane, bid, G);
#endif
 }
        else if (ph == 1 || ph == 5 || ph == 9 || ph == 13 || ph == 17) {
#ifndef DIS_NORM
 norm_phase(a, ph, wave, lane, bid, G);
#endif
 }
        else if (ph == 3) {
#ifndef DIS_CONV
 convgate_phase(a, tid, bid, G);
#endif
 }
        else if (ph == 7 || ph == 15) {
#ifndef DIS_FFNG
 ffngate_phase(a, ph == 15 ? 1 : 0, tid, bid, G);
#endif
 }
        else if (ph == 11) {
#ifndef DIS_ATTN
 attn_phase(a, wave, lane, bid, G);
#endif
 }
        else if (ph == 2 || ph == 6 || ph == 14) {
            pg8::Gemm g; pg8::EpiBf16 E;
            if (ph == 2) { g = pg8::Gemm{(const bf16_t*)(ws + WS_H), (const bf16_t*)(ws + WS_WIN), MT, 3 * DM, DM}; E = pg8::EpiBf16{(bf16_t*)(ws + WS_BCX), 3 * DM}; }
            else { const int l = ph == 14 ? 1 : 0; g = pg8::Gemm{(const bf16_t*)(ws + WS_H), (const bf16_t*)(ws + WS_WUP) + (size_t)l * DM * 2 * DFF, MT, 2 * DFF, DM}; E = pg8::EpiBf16{(bf16_t*)(ws + WS_UG), 2 * DFF}; }
            pg8::StaticOrder S; S.init(g.M, g.N, G, bid);
#ifndef DIS_G1
            pg8::gemm_phase<pg8::EpiBf16, pg8::StaticOrder>(lds, g, S, E, tid);
#endif
        }
        else if (ph == 10) {
            pg8::Gemm g{(const bf16_t*)(ws + WS_H), (const bf16_t*)(ws + WS_WQKV), MT, 3 * DM, DM};
            float* sk = a.out + (size_t)MT * DM; float* sv = sk + (size_t)NB_P * NH * SEQ_P * HD;
            pg8::EpiQKV E{(bf16_t*)(ws + WS_Q), (bf16_t*)(ws + WS_K), (bf16_t*)(ws + WS_VT), sk, sv};
            pg8::StaticOrder S; S.init(g.M, g.N, G, bid);
#ifndef DIS_G2
            pg8::gemm_phase<pg8::EpiQKV, pg8::StaticOrder>(lds, g, S, E, tid);
#endif
        }
        else {
            pg8::Gemm g; pg8::EpiRes E;
            const float* MOD = (const float*)(ws + WS_MOD);
            if (ph == 4) { g = pg8::Gemm{(const bf16_t*)(ws + WS_A2), (const bf16_t*)(ws + WS_WOUT), MT, DM, DM}; E = pg8::EpiRes{a.in[0], a.in[1], a.out, MOD + 2 * DM}; }
            else if (ph == 12) { g = pg8::Gemm{(const bf16_t*)(ws + WS_A2), (const bf16_t*)(ws + WS_WO), MT, DM, DM}; E = pg8::EpiRes{a.out, a.out + (size_t)MP * DM, a.out, MOD + (size_t)NCV * MODW + 2 * DM}; }
            else { const int l = ph == 16 ? 1 : 0; g = pg8::Gemm{(const bf16_t*)(ws + WS_A3), (const bf16_t*)(ws + WS_WDN) + (size_t)l * DM * DFF, MT, DM, DFF};
                E = pg8::EpiRes{a.out, a.out + (size_t)MP * DM, a.out, MOD + (size_t)l * NCV * MODW + 5 * DM}; }
            pg8::StaticOrder S; S.init(g.M, g.N, G, bid);
#ifndef DIS_G3
            pg8::gemm_phase<pg8::EpiRes, pg8::StaticOrder>(lds, g, S, E, tid);
#endif
        }
    }
}

extern "C" void kernel_launch(void* const* d_in, const int* in_sizes, int n_in, void* d_out, int out_size, void* d_ws, size_t ws_size, hipStream_t stream) {
    static int grid = 0;
    if (grid == 0) {
        if (n_in != 22 || ws_size < WS_END) { fprintf(stderr, "kernel_launch: unexpected n_in %d / ws_size %zu\n", n_in, ws_size); grid = -1; return; }
        int dev = 0, cus = 0, per_cu = 0;
        hipGetDevice(&dev); hipDeviceGetAttribute(&cus, hipDeviceAttributeMultiprocessorCount, dev);
        if (hipFuncSetAttribute((const void*)fwd_kernel, hipFuncAttributeMaxDynamicSharedMemorySize, LDS_BYTES) != hipSuccess) { fprintf(stderr, "hipFuncSetAttribute failed\n"); grid = -1; return; }
        hipOccupancyMaxActiveBlocksPerMultiprocessor(&per_cu, (const void*)fwd_kernel, 512, LDS_BYTES);
        (void)hipGetLastError();
        if (per_cu < 1) { fprintf(stderr, "occupancy query says %d\n", per_cu); per_cu = 1; }
        grid = cus;
    }
    if (grid < 0) return;
    Args a{};
    for (int i = 0; i < 22; ++i) a.in[i] = (const float*)d_in[i];
    a.out = (float*)d_out; a.ws = (unsigned char*)d_ws;
#if MK_MULTI
    for (int ph = 0; ph < NPH; ++ph) { a.ph_lo = ph; a.ph_hi = ph + 1; hipLaunchKernelGGL(fwd_kernel, dim3(grid), dim3(512), LDS_BYTES, stream, a); }
#else
    a.ph_lo = 0; a.ph_hi = NPH;
    void* args[] = {&a};
    hipError_t e = hipLaunchCooperativeKernel((const void*)fwd_kernel, dim3(grid), dim3(512), args, LDS_BYTES, stream);
    if (e != hipSuccess) fprintf(stderr, "cooperative launch failed: %s (grid %d)\n", hipGetErrorString(e), grid);
#endif
}
```

```cpp
#include <hip/hip_runtime.h>
#include <hip/hip_cooperative_groups.h>
#include <cstdio>
#include <cstdint>
namespace cg = cooperative_groups;

#ifndef MK_MULTI
#define MK_MULTI 0
#endif

#define LAS __attribute__((address_space(3)))
typedef unsigned short bf16_t;
typedef short bf16x8 __attribute__((ext_vector_type(8)));
typedef float f32x4 __attribute__((ext_vector_type(4)));
typedef float f32x2 __attribute__((ext_vector_type(2)));
typedef unsigned u32x4 __attribute__((ext_vector_type(4)));
typedef unsigned u32x2 __attribute__((ext_vector_type(2)));

constexpr int DM = 1024, NB_P = 32, SEQ_P = 256, NB_S = 4, SEQ_S = 1024, PAST = 256;
constexpr int MP = NB_P * SEQ_P;
constexpr int MS = NB_S * SEQ_S;
constexpr int MT = MP + MS;
constexpr int NH = 16, HD = 64, DFF = 2816, NCV = 5, MODW = 6 * DM;
constexpr float EPS = 1e-6f;
constexpr int NPH = 18;

constexpr size_t MiB = 1u << 20;
constexpr size_t WS_WIN = 0, WS_WOUT = 6 * MiB, WS_WQKV = 8 * MiB, WS_WO = 14 * MiB, WS_WUP = 16 * MiB, WS_WDN = 38 * MiB;
constexpr size_t WS_MOD = 49 * MiB, WS_KC = 50 * MiB, WS_VTC = 52 * MiB;
constexpr size_t WS_A3 = 54 * MiB;
constexpr size_t WS_H = 120 * MiB, WS_HB = WS_H;
constexpr size_t WS_BCX = 144 * MiB, WS_A2 = 216 * MiB;
constexpr size_t WS_Q = 144 * MiB, WS_K = 168 * MiB, WS_VT = 192 * MiB;
constexpr size_t WS_CTL = 252 * MiB, CTL_BYTES = 32768;
constexpr size_t WS_XCH = 253 * MiB;
constexpr size_t WS_SB = 254 * MiB;
constexpr size_t WS_END = 256 * MiB;
constexpr int CW_CNT = 4096;
constexpr int LDS_BYTES = 147456;

struct Args { const float* in[22]; float* out; unsigned char* ws; int ph_lo, ph_hi; };

__device__ __forceinline__ unsigned cvt_pk_bf16(float lo, float hi) { unsigned r; asm volatile("v_cvt_pk_bf16_f32 %0, %1, %2" : "=v"(r) : "v"(lo), "v"(hi)); return r; }
__device__ __forceinline__ float bf_lo(unsigned u) { return __uint_as_float(u << 16); }
__device__ __forceinline__ float bf_hi(unsigned u) { return __uint_as_float(u & 0xffff0000u); }
__device__ __forceinline__ unsigned short f2bf(float f) { return (unsigned short)(cvt_pk_bf16(f, 0.f) & 0xffffu); }

namespace pg8 {
constexpr int BM = 256, BK = 64, HALF = 128, HTB = HALF * BK * 2, STAGE_BYTES = 8 * HTB, NXCD = 8, WGM = 8;
__host__ __device__ __forceinline__ int lds_byte(int r, int c) { const int st = (r >> 4) * 2 + (c >> 5), rr = r & 15, cc = c & 31, ob = rr * 64 + cc * 2; return st * 1024 + (ob ^ (((ob >> 9) & 1) << 5)); }
__host__ __device__ __forceinline__ void stage_rc(int b, int& R, int& C) { const int st = b / 1024, sb = b % 1024, swz = sb ^ (((sb >> 9) & 1) << 5); R = (st >> 1) * 16 + swz / 64; C = (st & 1) * 32 + (swz % 64) / 2; }
__host__ __device__ __forceinline__ int perm32(int rho) { const int n = rho >> 4, i = rho & 15; return 8 * (i >> 2) + 4 * n + (i & 3); }

struct Unit { int pm, pn; };
struct Gemm { const bf16_t* A; const bf16_t* Bt; int M, N, K; };

struct StaticOrder {
    int nM, nN, nwg, G, c;
    __device__ void init(int M, int N, int G_, int c_) { nM = M / BM; nN = N / BM; nwg = nM * nN; G = G_; c = c_; }
    __device__ bool next(int i, Unit& u) const {
        const long L = (long)i * G + c; if (L >= nwg) return false;
        int wgid = (int)L; { const int q = nwg / NXCD, r = nwg % NXCD, xcd = wgid % NXCD, off = wgid / NXCD; wgid = (xcd < r ? xcd * (q + 1) : r * (q + 1) + (xcd - r) * q) + off; }
        const int nig = WGM * nN, gid = wgid / nig, fm = gid * WGM, gsz = (nM - fm) < WGM ? (nM - fm) : WGM;
        u.pm = fm + ((wgid % nig) % gsz); u.pn = (wgid % nig) / gsz; return true;
    }
};

struct EpiBf16 {
    static constexpr bool PERM = true, AFTER_DRAIN = false, NEEDS_LDS = false;
    bf16_t* O; int ldc;
    __device__ __forceinline__ void operator()(const f32x4 (&acc)[2][2][4][2], const Unit& u, int wr, int wc, int fr, int fq) const {
        const int row0 = u.pm * BM + wr * 64 + fr; const int col0 = u.pn * BM + wc * 32 + 8 * fq;
#pragma unroll
        for (int ai = 0; ai < 2; ++ai)
#pragma unroll
            for (int m = 0; m < 4; ++m) { bf16_t* rowp = O + (size_t)(row0 + ai * HALF + m * 16) * ldc + col0;
#pragma unroll
                for (int bj = 0; bj < 2; ++bj) { const f32x4 v0 = acc[ai][bj][m][0], v1 = acc[ai][bj][m][1];
                    u32x4 w; w.x = cvt_pk_bf16(v0[0], v0[1]); w.y = cvt_pk_bf16(v0[2], v0[3]); w.z = cvt_pk_bf16(v1[0], v1[1]); w.w = cvt_pk_bf16(v1[2], v1[3]);
                    *(u32x4*)(rowp + bj * HALF) = w; } }
    }
};

struct EpiRes {
    static constexpr bool PERM = false, AFTER_DRAIN = false, NEEDS_LDS = false;
    const float* base_p; const float* base_s; float* out; const float* gate;
    __device__ __forceinline__ void operator()(const f32x4 (&acc)[2][2][4][2], const Unit& u, int wr, int wc, int fr, int fq) const {
        const int cv = u.pm < 32 ? 0 : 1 + ((u.pm - 32) >> 2);
        const int col0 = u.pn * BM + wc * 32 + 4 * fq;
        const float* gp = gate + cv * MODW + col0;
        f32x4 gv[2][2];
#pragma unroll
        for (int bj = 0; bj < 2; ++bj)
#pragma unroll
            for (int n = 0; n < 2; ++n) gv[bj][n] = *(const f32x4*)(gp + bj * HALF + n * 16);
        const float* bb = u.pm < 32 ? base_p + (size_t)u.pm * BM * DM : base_s + (size_t)(u.pm - 32) * BM * DM;
        float* ob = out + (size_t)u.pm * BM * DM;
#pragma unroll
        for (int ai = 0; ai < 2; ++ai)
#pragma unroll
            for (int m = 0; m < 4; ++m) { const size_t off = (size_t)(ai * HALF + wr * 64 + m * 16 + fr) * DM + col0;
#pragma unroll
                for (int bj = 0; bj < 2; ++bj)
#pragma unroll
                    for (int n = 0; n < 2; ++n) { const f32x4 bs = *(const f32x4*)(bb + off + bj * HALF + n * 16);
                        *(f32x4*)(ob + off + bj * HALF + n * 16) = bs + gv[bj][n] * acc[ai][bj][m][n]; }
                asm volatile("" ::: "memory"); }
    }
};

struct EpiResNorm {
    static constexpr bool PERM = false, AFTER_DRAIN = true, NEEDS_LDS = false;
    const float* base_p; const float* base_s; float* out; const float* gate; bf16_t* H; const float* gn; const float* mod_sh; const float* mod_sc; float* xbuf; unsigned* cnt; int final_mode;
    __device__ __forceinline__ void fused(f32x4 (&acc)[2][2][4][2], const Unit& u, int wr, int wc, int fr, int fq, LAS unsigned char* lds, int wid, int lane) const {
        LAS float* P = (LAS float*)lds;
        LAS float* S = (LAS float*)(lds + 8192);
        const int cv = u.pm < 32 ? 0 : 1 + ((u.pm - 32) >> 2);
        const int col0 = u.pn * BM + wc * 32 + 4 * fq;
        const float* bb = u.pm < 32 ? base_p + (size_t)u.pm * BM * DM : base_s + (size_t)(u.pm - 32) * BM * DM;
        float* ob = out + (size_t)u.pm * BM * DM;
        {   const float* gp = gate + cv * MODW + col0;
            f32x4 gv[2][2];
#pragma unroll
            for (int bj = 0; bj < 2; ++bj)
#pragma unroll
                for (int n = 0; n < 2; ++n) gv[bj][n] = *(const f32x4*)(gp + bj * HALF + n * 16);
#pragma unroll
            for (int ai = 0; ai < 2; ++ai)
#pragma unroll
                for (int m = 0; m < 4; ++m) { const size_t off = (size_t)(ai * HALF + wr * 64 + m * 16 + fr) * DM + col0;
                    float ss = 0.f;
#pragma unroll
                    for (int bj = 0; bj < 2; ++bj)
#pragma unroll
                        for (int n = 0; n < 2; ++n) { const f32x4 bs = *(const f32x4*)(bb + off + bj * HALF + n * 16);
                            const f32x4 x = bs + gv[bj][n] * acc[ai][bj][m][n]; acc[ai][bj][m][n] = x;
                            if (!final_mode) *(f32x4*)(ob + off + bj * HALF + n * 16) = x;
                            ss += (x[0] * x[0] + x[1] * x[1]) + (x[2] * x[2] + x[3] * x[3]); }
                    ss += __shfl_xor(ss, 16); ss += __shfl_xor(ss, 32);
                    if (fq == 0) P[(ai * HALF + wr * 64 + m * 16 + fr) * 4 + wc] = ss;
                    asm volatile("" ::: "memory"); }
        }
        asm volatile("s_waitcnt lgkmcnt(0)" ::: "memory"); __builtin_amdgcn_s_barrier(); asm volatile("" ::: "memory");
        const int row = wid * 32 + (lane & 31);
        if (lane < 32) {
            const float tot = (P[row * 4 + 0] + P[row * 4 + 1]) + (P[row * 4 + 2] + P[row * 4 + 3]);
            __hip_atomic_store(xbuf + ((size_t)(u.pm * BM + row) * 4 + u.pn), tot, __ATOMIC_RELAXED, __HIP_MEMORY_SCOPE_AGENT);
        }
        asm volatile("s_waitcnt vmcnt(0)" ::: "memory");
        if (lane == 0) __hip_atomic_fetch_add(cnt + 16 * u.pm, 1u, __ATOMIC_RELAXED, __HIP_MEMORY_SCOPE_AGENT);
        if (wid == 0) {
            unsigned sp = 0;
            while ((unsigned)__builtin_amdgcn_readfirstlane(__hip_atomic_load(cnt + 16 * u.pm, __ATOMIC_RELAXED, __HIP_MEMORY_SCOPE_AGENT)) < 32u) { __builtin_amdgcn_s_sleep(2); if (++sp > (1u << 22)) break; }
            __builtin_amdgcn_fence(__ATOMIC_ACQUIRE, "agent");
        }
        asm volatile("s_waitcnt vmcnt(0) lgkmcnt(0)" ::: "memory"); __builtin_amdgcn_s_barrier(); asm volatile("" ::: "memory");
        if (lane < 32) {
            const float* slot = xbuf + (size_t)(u.pm * BM + row) * 4; float t = 0.f;
#pragma unroll
            for (int k = 0; k < 4; ++k) t += __hip_atomic_load(slot + k, __ATOMIC_RELAXED, __HIP_MEMORY_SCOPE_AGENT);
            S[row] = 1.0f / sqrtf(t * (1.0f / DM) + EPS);
        }
        asm volatile("s_waitcnt vmcnt(0) lgkmcnt(0)" ::: "memory"); __builtin_amdgcn_s_barrier(); asm volatile("" ::: "memory");
        f32x4 ga[2][2], gb[2][2];
#pragma unroll
        for (int bj = 0; bj < 2; ++bj)
#pragma unroll
            for (int n = 0; n < 2; ++n) { const int c = col0 + bj * HALF + n * 16; const f32x4 g4 = *(const f32x4*)(gn + c);
                if (final_mode) { ga[bj][n] = g4; gb[bj][n] = (f32x4){0.f, 0.f, 0.f, 0.f}; }
                else { const f32x4 sc = *(const f32x4*)(mod_sc + cv * MODW + c), sh = *(const f32x4*)(mod_sh + cv * MODW + c); ga[bj][n] = g4 * (1.0f + sc); gb[bj][n] = sh; } }
#pragma unroll
        for (int ai = 0; ai < 2; ++ai)
#pragma unroll
            for (int m = 0; m < 4; ++m) { const int r = ai * HALF + wr * 64 + m * 16 + fr; const float rstd = S[r]; const size_t off = (size_t)r * DM + col0;
#pragma unroll
                for (int bj = 0; bj < 2; ++bj)
#pragma unroll
                    for (int n = 0; n < 2; ++n) { const f32x4 h = (acc[ai][bj][m][n] * rstd) * ga[bj][n] + gb[bj][n];
                        if (final_mode) __builtin_nontemporal_store(h, (f32x4*)(ob + off + bj * HALF + n * 16));
                        else { u32x2 w; w.x = cvt_pk_bf16(h[0], h[1]); w.y = cvt_pk_bf16(h[2], h[3]); *(u32x2*)(H + (size_t)u.pm * BM * DM + off + bj * HALF + n * 16) = w; } }
            }
    }
};

__device__ __forceinline__ float gelu_tanh_f(float x) {
    const float t = x * x; const float p = __builtin_fmaf(t, -0.10294324f, -2.3022082f);
    return x * __builtin_amdgcn_rcpf(1.0f + __builtin_amdgcn_exp2f(p * x));
}
template <int CTRL> __device__ __forceinline__ float dppf(float oldv, float src) {
    return __int_as_float(__builtin_amdgcn_update_dpp(__float_as_int(oldv), __float_as_int(src), CTRL, 0xf, 0xf, false));
}
struct EpiGate {
    static constexpr bool PERM = true, AFTER_DRAIN = false, NEEDS_LDS = true;
    bf16_t* A3; const float* cw; const float* cbias; float* SB;
    __device__ __forceinline__ void operator()(f32x4 (&acc)[2][2][4][2], const Unit& u, int wr, int wc, int fr, int fq, LAS unsigned char* lds) const {
        LAS float* XU = (LAS float*)(lds + 131072);
        const int c8 = wc * 32 + 8 * fq, gc = u.pn * HALF + c8;
#ifndef NOXU
#pragma unroll
        for (int ai = 0; ai < 2; ++ai) { const int sidx = 2 * ai + wr;
            if (fr == 0)  { *(LAS f32x4*)(XU + (sidx * 2 + 0) * 128 + c8) = acc[ai][0][0][0]; *(LAS f32x4*)(XU + (sidx * 2 + 0) * 128 + c8 + 4) = acc[ai][0][0][1]; }
            if (fr == 15) { *(LAS f32x4*)(XU + (sidx * 2 + 1) * 128 + c8) = acc[ai][0][3][0]; *(LAS f32x4*)(XU + (sidx * 2 + 1) * 128 + c8 + 4) = acc[ai][0][3][1]; } }
#endif
        if (u.pm >= 32) {
            float* sb = SB + (size_t)(u.pm - 32) * 6 * DFF + gc;
            if (wr == 0 && fr < 2) { *(f32x4*)(sb + fr * DFF) = acc[0][0][0][0]; *(f32x4*)(sb + fr * DFF + 4) = acc[0][0][0][1];
                if (fr == 0) { *(f32x4*)(sb + 2 * DFF) = acc[0][1][0][0]; *(f32x4*)(sb + 2 * DFF + 4) = acc[0][1][0][1]; } }
            if (wr == 1 && fr >= 14) { *(f32x4*)(sb + (fr - 11) * DFF) = acc[1][0][3][0]; *(f32x4*)(sb + (fr - 11) * DFF + 4) = acc[1][0][3][1];
                if (fr == 15) { *(f32x4*)(sb + 5 * DFF) = acc[1][1][3][0]; *(f32x4*)(sb + 5 * DFF + 4) = acc[1][1][3][1]; } }
        }
        f32x4 w0[2], w1[2], w2[2], cb[2];
#pragma unroll
        for (int n = 0; n < 2; ++n) { w0[n] = *(const f32x4*)(cw + gc + 4 * n); w1[n] = *(const f32x4*)(cw + DFF + gc + 4 * n); w2[n] = *(const f32x4*)(cw + 2 * DFF + gc + 4 * n); cb[n] = *(const f32x4*)(cbias + gc + 4 * n); }
#ifndef NOXU
        asm volatile("s_waitcnt lgkmcnt(0)" ::: "memory"); __builtin_amdgcn_s_barrier(); asm volatile("" ::: "memory");
#endif
#pragma unroll
        for (int ai = 0; ai < 2; ++ai) { const int sidx = 2 * ai + wr;
            f32x4 top[2], bot[2];
#pragma unroll
            for (int n = 0; n < 2; ++n) {
#ifdef NOXU
                top[n] = (f32x4){0.f,0.f,0.f,0.f}; bot[n] = top[n];
#else
                top[n] = sidx > 0 ? *(const LAS f32x4*)(XU + ((sidx - 1) * 2 + 1) * 128 + c8 + 4 * n) : (f32x4){0.f, 0.f, 0.f, 0.f};
                bot[n] = sidx < 3 ? *(const LAS f32x4*)(XU + ((sidx + 1) * 2 + 0) * 128 + c8 + 4 * n) : (f32x4){0.f, 0.f, 0.f, 0.f};
#endif
            }
#pragma unroll
            for (int m = 0; m < 4; ++m) {
                u32x4 w;
#pragma unroll
                for (int n = 0; n < 2; ++n) { float ov[4];
#pragma unroll
                    for (int j = 0; j < 4; ++j) {
                        const float uc = acc[ai][0][m][n][j];
                        const float upo = m > 0 ? dppf<0x140>(0.f, acc[ai][0][m - 1][n][j]) : top[n][j];
                        const float up = dppf<0x111>(upo, uc);
                        const float dno = m < 3 ? dppf<0x140>(0.f, acc[ai][0][m + 1][n][j]) : bot[n][j];
                        const float dn = dppf<0x101>(dno, uc);
                        const float cv = __builtin_fmaf(w0[n][j], up, __builtin_fmaf(w1[n][j], uc, __builtin_fmaf(w2[n][j], dn, cb[n][j])));
                        ov[j] = gelu_tanh_f(cv) * acc[ai][1][m][n][j]; }
                    if (n == 0) { w.x = cvt_pk_bf16(ov[0], ov[1]); w.y = cvt_pk_bf16(ov[2], ov[3]); } else { w.z = cvt_pk_bf16(ov[0], ov[1]); w.w = cvt_pk_bf16(ov[2], ov[3]); } }
                *(u32x4*)(A3 + (size_t)(u.pm * BM + ai * HALF + wr * 64 + m * 16 + fr) * DFF + gc) = w;
            }
        }
#ifndef NOXU
        asm volatile("s_waitcnt lgkmcnt(0)" ::: "memory"); __builtin_amdgcn_s_barrier(); asm volatile("" ::: "memory");
#endif
    }
};

struct EpiQKV {
    static constexpr bool PERM = false, AFTER_DRAIN = false, NEEDS_LDS = false;
    bf16_t* Q; bf16_t* Kb; bf16_t* Vt; float* sk; float* sv;
    __device__ __forceinline__ void operator()(const f32x4 (&acc)[2][2][4][2], const Unit& u, int wr, int wc, int fr, int fq) const {
        const int which = u.pn >> 2; const int cb = (u.pn & 3) * BM + wc * 32 + 4 * fq;
        const bool prompt = u.pm < 32;
        const int bidx = prompt ? u.pm : ((u.pm - 32) >> 2);
        const int tbase = (prompt ? 0 : ((u.pm - 32) & 3) * 256) + wr * 64 + fr;
        const int T = prompt ? SEQ_P : SEQ_S;
#pragma unroll
        for (int ai = 0; ai < 2; ++ai)
#pragma unroll
            for (int m = 0; m < 4; ++m) {
                const int t = tbase + ai * HALF + m * 16; const size_t row = (size_t)u.pm * BM + ai * HALF + wr * 64 + m * 16 + fr;
#pragma unroll
                for (int bj = 0; bj < 2; ++bj)
#pragma unroll
                    for (int n = 0; n < 2; ++n) { const int c = cb + bj * HALF + n * 16; const f32x4 v = acc[ai][bj][m][n];
                        if (which == 0) { u32x2 w; w.x = cvt_pk_bf16(v[0] * 0.125f, v[1] * 0.125f); w.y = cvt_pk_bf16(v[2] * 0.125f, v[3] * 0.125f); *(u32x2*)(Q + row * DM + c) = w; }
                        else if (which == 1) { u32x2 w; w.x = cvt_pk_bf16(v[0], v[1]); w.y = cvt_pk_bf16(v[2], v[3]); *(u32x2*)(Kb + row * DM + c) = w;
                            if (prompt) __builtin_nontemporal_store(v, (f32x4*)(sk + ((size_t)(bidx * NH + (c >> 6)) * SEQ_P + t) * HD + (c & 63))); }
                        else { const int h = c >> 6, d = c & 63;
                            if (prompt) __builtin_nontemporal_store(v, (f32x4*)(sv + ((size_t)(bidx * NH + h) * SEQ_P + t) * HD + d));
                            bf16_t* vp = Vt + (prompt ? 0 : (size_t)MP * DM) + ((size_t)(bidx * NH + h) * HD + d) * T + t;
                            vp[0] = f2bf(v[0]); vp[T] = f2bf(v[1]); vp[2 * T] = f2bf(v[2]); vp[3 * T] = f2bf(v[3]); }
                    }
            }
    }
};

template <class Epi, class Sched>
__device__ __forceinline__ void gemm_phase(LAS unsigned char* lds, const Gemm g, const Sched& S, const Epi& E, const int tid) {
    const int wid = __builtin_amdgcn_readfirstlane(tid >> 6), lane = tid & 63, wr = wid >> 2, wc = wid & 3, fr = lane & 15, fq = lane >> 4;
    const int K = g.K, nt = K / BK;
    unsigned voffA[2], voffB[2];
#pragma unroll
    for (int i = 0; i < 2; ++i) { int R, C; stage_rc(tid * 16 + i * 8192, R, C); const int Rb = Epi::PERM ? ((R & ~31) + perm32(R & 31)) : R;
        voffA[i] = (unsigned)(R * K + C) * 2u; voffB[i] = (unsigned)(Rb * K + C) * 2u; }
    const size_t kstep = (size_t)(BK * 2);
    const size_t hstep = (size_t)HALF * K * 2;
    const size_t tstep = 2 * hstep;
    const unsigned ldsw = (unsigned)wid * 1024u;
    const int aoff = lds_byte(wr * 64 + fr, fq * 8), boff = lds_byte(wc * 32 + fr, fq * 8);
#define PG8_SA(b, h) (((b) * 2 + (h)) * HTB)
#define PG8_SB(b, h) ((4 + (b) * 2 + (h)) * HTB)
#define PG8_STAGE(bufoff, gbase, voff) do { _Pragma("unroll") for (int _i = 0; _i < 2; ++_i) \
        __builtin_amdgcn_global_load_lds((const unsigned*)((const char*)(gbase) + (voff)[_i]), (LAS unsigned*)(lds + (bufoff) + ldsw + _i * 8192), 16, 0, 0); } while (0)
#define PG8_LDA(dst, b, h) do { _Pragma("unroll") for (int m = 0; m < 4; ++m) _Pragma("unroll") for (int k = 0; k < 2; ++k) dst[m][k] = *(const LAS bf16x8*)(lds + PG8_SA(b, h) + aoff + m * 2048 + k * 1024); } while (0)
#define PG8_LDB(dst, b, h) do { _Pragma("unroll") for (int n = 0; n < 2; ++n) _Pragma("unroll") for (int k = 0; k < 2; ++k) dst[n][k] = *(const LAS bf16x8*)(lds + PG8_SB(b, h) + boff + n * 2048 + k * 1024); } while (0)
#define PG8_MMA(ai, bj, At, Bt) do { __builtin_amdgcn_s_setprio(1); _Pragma("unroll") for (int m = 0; m < 4; ++m) _Pragma("unroll") for (int n = 0; n < 2; ++n) _Pragma("unroll") for (int k = 0; k < 2; ++k) \
        acc[ai][bj][m][n] = __builtin_amdgcn_mfma_f32_16x16x32_bf16(Bt[n][k], At[m][k], acc[ai][bj][m][n], 0, 0, 0); __builtin_amdgcn_s_setprio(0); } while (0)
#define PG8_WAIT_V(n) asm volatile("s_waitcnt vmcnt(" #n ")" ::: "memory")
#define PG8_WAIT_L(n) asm volatile("s_waitcnt lgkmcnt(" #n ")" ::: "memory")
#define PG8_BAR __builtin_amdgcn_s_barrier()
#define PG8_SCHED __builtin_amdgcn_sched_barrier(0)
    Unit cur, nxt; int ui = 0;
    if (!S.next(0, cur)) return;
    f32x4 acc[2][2][4][2];
#pragma unroll
    for (int a = 0; a < 2; ++a)
#pragma unroll
        for (int b = 0; b < 2; ++b)
#pragma unroll
            for (int m = 0; m < 4; ++m)
#pragma unroll
                for (int n = 0; n < 2; ++n) acc[a][b][m][n] = (f32x4){0.f, 0.f, 0.f, 0.f};
    bf16x8 At[4][2], B0[2][2], B1[2][2];
    const char* cA = (const char*)g.A + (size_t)cur.pm * tstep; const char* cB = (const char*)g.Bt + (size_t)cur.pn * tstep;
    PG8_STAGE(PG8_SB(0, 0), cB, voffB); PG8_STAGE(PG8_SB(0, 1), cB + hstep, voffB); PG8_STAGE(PG8_SA(0, 0), cA, voffA); PG8_STAGE(PG8_SA(0, 1), cA + hstep, voffA);
    if (wr == 1) PG8_BAR;
    PG8_WAIT_V(2); PG8_BAR;
    PG8_STAGE(PG8_SB(1, 0), cB + kstep, voffB); PG8_STAGE(PG8_SA(1, 0), cA + kstep, voffA); PG8_STAGE(PG8_SB(1, 1), cB + hstep + kstep, voffB);
    PG8_WAIT_V(6); PG8_BAR;
    for (;;) {
        const bool has_next = S.next(ui + 1, nxt);
        const char* nA = has_next ? (const char*)g.A + (size_t)nxt.pm * tstep : cA; const char* nB = has_next ? (const char*)g.Bt + (size_t)nxt.pn * tstep : cB;
        for (int t = 0; t < nt; t += 2) {
            const bool last = (t == nt - 2);
            const char* a1 = cA + (size_t)(t + 1) * kstep;
            const char* a2 = last ? nA : cA + (size_t)(t + 2) * kstep; const char* b2 = last ? nB : cB + (size_t)(t + 2) * kstep;
            const char* a3 = a2 + kstep; const char* b3 = b2 + kstep;
            PG8_LDB(B0, 0, 0); PG8_LDB(B1, 0, 1); PG8_SCHED; PG8_LDA(At, 0, 0); PG8_STAGE(PG8_SA(1, 1), a1 + hstep, voffA);
            PG8_WAIT_V(8); PG8_WAIT_L(0); PG8_BAR; PG8_MMA(0, 0, At, B0); PG8_MMA(0, 1, At, B1); PG8_BAR; PG8_SCHED;
            PG8_LDA(At, 0, 1); PG8_STAGE(PG8_SB(0, 0), b2, voffB); PG8_STAGE(PG8_SB(0, 1), b2 + hstep, voffB); PG8_STAGE(PG8_SA(0, 0), a2, voffA);
            PG8_WAIT_V(8); PG8_WAIT_L(0); PG8_BAR; PG8_MMA(1, 0, At, B0); PG8_MMA(1, 1, At, B1); PG8_BAR; PG8_SCHED;
            PG8_LDB(B0, 1, 0); PG8_LDB(B1, 1, 1); PG8_SCHED; PG8_LDA(At, 1, 0); PG8_STAGE(PG8_SA(0, 1), a2 + hstep, voffA);
            PG8_WAIT_V(8); PG8_WAIT_L(0); PG8_BAR; PG8_MMA(0, 0, At, B0); PG8_MMA(0, 1, At, B1); PG8_BAR; PG8_SCHED;
            PG8_LDA(At, 1, 1); PG8_STAGE(PG8_SB(1, 0), b3, voffB); PG8_STAGE(PG8_SB(1, 1), b3 + hstep, voffB); PG8_STAGE(PG8_SA(1, 0), a3, voffA);
            PG8_WAIT_V(8); PG8_WAIT_L(0); PG8_BAR; PG8_MMA(1, 0, At, B0); PG8_MMA(1, 1, At, B1); PG8_BAR; PG8_SCHED;
        }
        if (wr == 0) PG8_BAR;
        if constexpr (!Epi::AFTER_DRAIN) { if constexpr (Epi::NEEDS_LDS) E(acc, cur, wr, wc, fr, fq, lds); else E(acc, cur, wr, wc, fr, fq); }
        if (!has_next) break;
#pragma unroll
        for (int a = 0; a < 2; ++a)
#pragma unroll
            for (int b = 0; b < 2; ++b)
#pragma unroll
                for (int m = 0; m < 4; ++m)
#pragma unroll
                    for (int n = 0; n < 2; ++n) acc[a][b][m][n] = (f32x4){0.f, 0.f, 0.f, 0.f};
        cur = nxt; cA = nA; cB = nB; ++ui;
        if (wr == 1) PG8_BAR;
    }
    PG8_WAIT_V(0);
    PG8_BAR;
    if constexpr (Epi::AFTER_DRAIN) E.fused(acc, cur, wr, wc, fr, fq, lds, wid, lane);
#undef PG8_SA
#undef PG8_SB
#undef PG8_STAGE
#undef PG8_LDA
#undef PG8_LDB
#undef PG8_MMA
#undef PG8_WAIT_V
#undef PG8_WAIT_L
#undef PG8_BAR
#undef PG8_SCHED
}
}

__device__ __forceinline__ float wave_sum(float v) {
#pragma unroll
    for (int o = 1; o < 64; o <<= 1) v += __shfl_xor(v, o);
    return v;
}
#define LDS_WAIT() asm volatile("s_waitcnt lgkmcnt(0)" ::: "memory")

template <bool UPMAP = false>
__device__ __forceinline__ void p0_transpose_item(const float* W, int K, int N, bf16_t* WT, LAS float* scr, int item, int lane) {
    const int nblk = N / 32, kb = item / nblk, nb = item % nblk, k0 = 64 * kb, n0 = 32 * nb;
    int d0 = n0; if (UPMAP) { const int part = n0 >= DFF ? 1 : 0, cc = n0 - part * DFF; d0 = 256 * (cc >> 7) + 128 * part + (cc & 127); }
    {
        f32x4 v[8]; const int cq = 4 * (lane & 7), kr = lane >> 3;
#pragma unroll
        for (int i = 0; i < 8; ++i) v[i] = *(const f32x4*)(W + (size_t)(k0 + 8 * i + kr) * N + n0 + cq);
#pragma unroll
        for (int i = 0; i < 8; ++i) { LAS float* d = scr + (8 * i + kr) * 33 + cq; d[0] = v[i].x; d[1] = v[i].y; d[2] = v[i].z; d[3] = v[i].w; }
    }
    LDS_WAIT(); asm volatile("" ::: "memory");
    const int c = lane & 7;
#pragma unroll
    for (int j = 0; j < 4; ++j) { const int n = (lane >> 3) + 8 * j; const LAS float* s = scr + (8 * c) * 33 + n;
        u32x4 o; o.x = cvt_pk_bf16(s[0 * 33], s[1 * 33]); o.y = cvt_pk_bf16(s[2 * 33], s[3 * 33]); o.z = cvt_pk_bf16(s[4 * 33], s[5 * 33]); o.w = cvt_pk_bf16(s[6 * 33], s[7 * 33]);
        *(u32x4*)(WT + (size_t)(d0 + n) * K + k0 + 8 * c) = o; }
    LDS_WAIT(); asm volatile("" ::: "memory");
}

constexpr int I_IN = 16 * 96, I_OUT = 16 * 32, I_UP = 16 * 176, I_DN = 44 * 32;
constexpr int TI_R0 = I_IN + I_OUT + I_UP, TI_R1 = TI_R0 + I_DN, TI_R2 = TI_R1 + I_IN + I_OUT + I_UP + I_DN;
__device__ __forceinline__ void transpose_items(const Args& a, LAS unsigned char* lds, int lo, int hi, int worker, int nworkers, int wave, int lane) {
    unsigned char* ws = a.ws;
    LAS float* scr = (LAS float*)(lds + wave * 16384);
    for (int it = lo + worker; it < hi; it += nworkers) {
        int r = it;
        if (r < I_IN) { p0_transpose_item(a.in[10], DM, 3 * DM, (bf16_t*)(ws + WS_WIN), scr, r, lane); continue; } r -= I_IN;
        if (r < I_OUT) { p0_transpose_item(a.in[13], DM, DM, (bf16_t*)(ws + WS_WOUT), scr, r, lane); continue; } r -= I_OUT;
        if (r < I_UP) { p0_transpose_item<true>(a.in[17], DM, 2 * DFF, (bf16_t*)(ws + WS_WUP), scr, r, lane); continue; } r -= I_UP;
        if (r < I_DN) { p0_transpose_item(a.in[20], DFF, DM, (bf16_t*)(ws + WS_WDN), scr, r, lane); continue; } r -= I_DN;
        if (r < I_IN) { p0_transpose_item(a.in[14], DM, 3 * DM, (bf16_t*)(ws + WS_WQKV), scr, r, lane); continue; } r -= I_IN;
        if (r < I_OUT) { p0_transpose_item(a.in[16], DM, DM, (bf16_t*)(ws + WS_WO), scr, r, lane); continue; } r -= I_OUT;
        if (r < I_UP) { p0_transpose_item<true>(a.in[17] + (size_t)DM * 2 * DFF, DM, 2 * DFF, (bf16_t*)(ws + WS_WUP) + (size_t)DM * 2 * DFF, scr, r, lane); continue; } r -= I_UP;
        p0_transpose_item(a.in[20] + (size_t)DM * DFF, DFF, DM, (bf16_t*)(ws + WS_WDN) + (size_t)DM * DFF, scr, r, lane);
    }
}

__device__ __forceinline__ void prologue(const Args& a, LAS unsigned char* lds, int tid, int wave, int lane, int bid, int G) {
    unsigned char* ws = a.ws;
    float* MOD = (float*)(ws + WS_MOD);
    LAS float* sil = (LAS float*)lds;
    LAS float* red = (LAS float*)(lds + 5 * 1024 * 4);
    for (int i = tid; i < NCV * DM; i += 512) { const int cv = i >> 10, k = i & 1023; const float x = cv == 0 ? a.in[5][k] : a.in[4][(cv - 1) * DM + k]; sil[i] = x / (1.f + __expf(-x)); }
    __syncthreads();
    for (int item = bid; item < 2 * (MODW / 32); item += G) {
        const int l = item / (MODW / 32), col0 = (item % (MODW / 32)) * 32;
        const float* W = a.in[6] + (size_t)l * DM * MODW + col0 + 4 * (lane & 7);
        f32x4 acc[NCV];
#pragma unroll
        for (int cv = 0; cv < NCV; ++cv) acc[cv] = (f32x4){0.f, 0.f, 0.f, 0.f};
#pragma unroll 4
        for (int i = 0; i < 16; ++i) { const int k = 128 * wave + 8 * i + (lane >> 3); const f32x4 w = *(const f32x4*)(W + (size_t)k * MODW);
#pragma unroll
            for (int cv = 0; cv < NCV; ++cv) acc[cv] += sil[cv * DM + k] * w; }
#pragma unroll
        for (int cv = 0; cv < NCV; ++cv)
#pragma unroll
            for (int j = 0; j < 4; ++j) { float v = acc[cv][j]; v += __shfl_xor(v, 8); v += __shfl_xor(v, 16); v += __shfl_xor(v, 32); acc[cv][j] = v; }
        if (lane < 8) {
#pragma unroll
            for (int cv = 0; cv < NCV; ++cv)
#pragma unroll
                for (int j = 0; j < 4; ++j) red[(wave * NCV + cv) * 32 + 4 * lane + j] = acc[cv][j];
        }
        __syncthreads();
        if (tid < NCV * 32) { const int cv = tid >> 5, c = tid & 31; float s = 0.f;
#pragma unroll
            for (int w = 0; w < 8; ++w) s += red[(w * NCV + cv) * 32 + c];
            MOD[((size_t)l * NCV + cv) * MODW + col0 + c] = s + a.in[7][l * MODW + col0 + c]; }
        __syncthreads();
    }
    __syncthreads();
    transpose_items(a, lds, 0, TI_R0, bid * 8 + wave, G * 8, wave, lane);
    const int gt = bid * 512 + tid, NGT = G * 512;
    bf16_t* Kc = (bf16_t*)(ws + WS_KC); bf16_t* Vtc = (bf16_t*)(ws + WS_VTC);
    for (int i = gt; i < NB_S * NH * PAST * HD; i += NGT) {
        Kc[i] = f2bf(a.in[2][i]);
        const int t = i & 255, d = (i >> 8) & 63, bh = i >> 14;
        Vtc[i] = f2bf(a.in[3][((size_t)bh * PAST + t) * HD + d]);
    }
}

__device__ __forceinline__ void norm_phase(const Args& a, int ph, int wave, int lane, int bid, int G) {
    const int gw = bid * 8 + wave, NGW = G * 8;
    const bool is_final = ph == 17, ffn = (ph == 5 || ph == 13); const int layer = ph >= 9 ? 1 : 0;
    const float* g = is_final ? a.in[21] : ((ffn ? a.in[9] : a.in[8]) + layer * DM);
    const float* mod = (const float*)(a.ws + WS_MOD) + (size_t)layer * NCV * MODW + (ffn ? 3 * DM : 0);
    bf16_t* H = (bf16_t*)(a.ws + WS_H);
    f32x4 gv[4];
#pragma unroll
    for (int j = 0; j < 4; ++j) gv[j] = *(const f32x4*)(g + 4 * lane + 256 * j);
    for (int row = gw; row < MT; row += NGW) {
        const float* xr = (ph == 1) ? (row < MP ? a.in[0] + (size_t)row * DM : a.in[1] + (size_t)(row - MP) * DM) : a.out + (size_t)row * DM;
        f32x4 v[4]; float s = 0.f;
#pragma unroll
        for (int j = 0; j < 4; ++j) { v[j] = *(const f32x4*)(xr + 4 * lane + 256 * j); s += (v[j].x * v[j].x + v[j].y * v[j].y) + (v[j].z * v[j].z + v[j].w * v[j].w); }
        const float rstd = 1.0f / sqrtf(wave_sum(s) * (1.f / DM) + EPS);
        if (is_final) {
#pragma unroll
            for (int j = 0; j < 4; ++j) *(f32x4*)(a.out + (size_t)row * DM + 4 * lane + 256 * j) = (v[j] * rstd) * gv[j];
        } else {
            const int cv = row < MP ? 0 : 1 + ((row - MP) >> 10);
            const float* mp = mod + (size_t)cv * MODW + 4 * lane;
#pragma unroll
            for (int j = 0; j < 4; ++j) { const f32x4 sh = *(const f32x4*)(mp + 256 * j), sc = *(const f32x4*)(mp + DM + 256 * j);
                const f32x4 h = ((v[j] * rstd) * gv[j]) * (1.0f + sc) + sh;
                u32x2 w; w.x = cvt_pk_bf16(h.x, h.y); w.y = cvt_pk_bf16(h.z, h.w);
                *(u32x2*)(H + (size_t)row * DM + 4 * lane + 256 * j) = w; }
        }
    }
}

struct F8 { float v[8]; };
__device__ __forceinline__ F8 ld8(const bf16_t* p) { const u32x4 w = *(const u32x4*)p; F8 r; r.v[0] = bf_lo(w.x); r.v[1] = bf_hi(w.x); r.v[2] = bf_lo(w.y); r.v[3] = bf_hi(w.y); r.v[4] = bf_lo(w.z); r.v[5] = bf_hi(w.z); r.v[6] = bf_lo(w.w); r.v[7] = bf_hi(w.w); return r; }
__device__ __forceinline__ F8 ldf8(const float* p) { const f32x4 a = *(const f32x4*)p, b = *(const f32x4*)(p + 4); F8 r; r.v[0] = a.x; r.v[1] = a.y; r.v[2] = a.z; r.v[3] = a.w; r.v[4] = b.x; r.v[5] = b.y; r.v[6] = b.z; r.v[7] = b.w; return r; }
__device__ __forceinline__ void st8(bf16_t* p, const F8& o) { u32x4 w; w.x = cvt_pk_bf16(o.v[0], o.v[1]); w.y = cvt_pk_bf16(o.v[2], o.v[3]); w.z = cvt_pk_bf16(o.v[4], o.v[5]); w.w = cvt_pk_bf16(o.v[6], o.v[7]); *(u32x4*)p = w; }
__device__ __forceinline__ F8 zero8() { F8 r;
#pragma unroll
    for (int e = 0; e < 8; ++e) r.v[e] = 0.f;
    return r; }

constexpr int RS = 8;
__device__ __forceinline__ F8 unpack8c(const u32x4 w) { F8 r; r.v[0] = bf_lo(w.x); r.v[1] = bf_hi(w.x); r.v[2] = bf_lo(w.y); r.v[3] = bf_hi(w.y); r.v[4] = bf_lo(w.z); r.v[5] = bf_hi(w.z); r.v[6] = bf_lo(w.w); r.v[7] = bf_hi(w.w); return r; }
__device__ __forceinline__ void convgate_phase(const Args& a, int tid, int bid, int G) {
    const bf16_t* BCX = (const bf16_t*)(a.ws + WS_BCX); bf16_t* A2 = (bf16_t*)(a.ws + WS_A2);
    const float* cw = a.in[11]; const float* cbias = a.in[12];
    constexpr int NITEM = (MT / RS) * (DM / 8); const int per = (NITEM + G - 1) / G;
    for (int j = tid; j < per; j += 512) {
        const int item = bid * per + j; if (item >= NITEM) break;
        const int strip = item >> 7, c = (item & 127) * 8, r0 = strip * RS;
        const int seqm = r0 < MP ? (SEQ_P - 1) : (SEQ_S - 1);
        const bool first = (r0 & seqm) == 0, last = ((r0 + RS) & seqm) == 0;
        const bf16_t* p = BCX + (size_t)r0 * (3 * DM) + c;
        u32x4 cr[RS + 2], xr[RS + 2], br[RS];
        const u32x4 z4 = (u32x4){0u, 0u, 0u, 0u};
        cr[0] = first ? z4 : *(const u32x4*)(p - 3 * DM + DM); xr[0] = first ? z4 : *(const u32x4*)(p - 3 * DM + 2 * DM);
#pragma unroll
        for (int i = 0; i < RS; ++i) { br[i] = *(const u32x4*)(p + (size_t)i * 3 * DM); cr[i + 1] = *(const u32x4*)(p + (size_t)i * 3 * DM + DM); xr[i + 1] = *(const u32x4*)(p + (size_t)i * 3 * DM + 2 * DM); }
        cr[RS + 1] = last ? z4 : *(const u32x4*)(p + (size_t)RS * 3 * DM + DM); xr[RS + 1] = last ? z4 : *(const u32x4*)(p + (size_t)RS * 3 * DM + 2 * DM);
        const F8 w0 = ldf8(cw + c), w1 = ldf8(cw + DM + c), w2 = ldf8(cw + 2 * DM + c), cb = ldf8(cbias + c);
        F8 prev, cur;
        { const F8 x = unpack8c(cr[0]), y = unpack8c(xr[0]);
#pragma unroll
            for (int e = 0; e < 8; ++e) prev.v[e] = x.v[e] * y.v[e]; }
        { const F8 x = unpack8c(cr[1]), y = unpack8c(xr[1]);
#pragma unroll
            for (int e = 0; e < 8; ++e) cur.v[e] = x.v[e] * y.v[e]; }
#pragma unroll
        for (int i = 0; i < RS; ++i) {
            F8 nxt; { const F8 x = unpack8c(cr[i + 2]), y = unpack8c(xr[i + 2]);
#pragma unroll
                for (int e = 0; e < 8; ++e) nxt.v[e] = x.v[e] * y.v[e]; }
            const F8 bg = unpack8c(br[i]); F8 o;
#pragma unroll
            for (int e = 0; e < 8; ++e) o.v[e] = bg.v[e] * (w0.v[e] * prev.v[e] + w1.v[e] * cur.v[e] + w2.v[e] * nxt.v[e] + cb.v[e]);
            st8(A2 + (size_t)(r0 + i) * DM + c, o);
            prev = cur; cur = nxt;
        }
    }
}
__device__ __forceinline__ float gelu_tanh(float x) {
    const float t = x * x; const float p = __builtin_fmaf(t, -0.10294324f, -2.3022082f);
    return x * __builtin_amdgcn_rcpf(1.0f + __builtin_amdgcn_exp2f(p * x));
}
__device__ __forceinline__ F8 unpack8(const u32x4 w) { F8 r; r.v[0] = bf_lo(w.x); r.v[1] = bf_hi(w.x); r.v[2] = bf_lo(w.y); r.v[3] = bf_hi(w.y); r.v[4] = bf_lo(w.z); r.v[5] = bf_hi(w.z); r.v[6] = bf_lo(w.w); r.v[7] = bf_hi(w.w); return r; }
template <bool BIAS>
__device__ __forceinline__ void attn_chunk(const bf16_t* Kp, int kpitch, const bf16_t* Vp, int vpitch, int tok0, int gstride,
                                           const bf16x8 qf0, const bf16x8 qf1, float& m_run, float& l_run, f32x4 (&o)[4],
                                           const float* rpb_h, int drow0, int kc0, int qc, int lane) {
    const int i = lane & 15, q = lane >> 4;
    f32x4 s[8];
#pragma unroll
    for (int kt = 0; kt < 8; ++kt) {
        const bf16_t* kp = Kp + (size_t)(tok0 + (kt >> 1) * gstride + (kt & 1) * 16 + i) * kpitch + 8 * q;
        const bf16x8 a0 = *(const bf16x8*)kp, a1 = *(const bf16x8*)(kp + 32);
        f32x4 z = (f32x4){0.f, 0.f, 0.f, 0.f};
        z = __builtin_amdgcn_mfma_f32_16x16x32_bf16(a0, qf0, z, 0, 0, 0);
        s[kt] = __builtin_amdgcn_mfma_f32_16x16x32_bf16(a1, qf1, z, 0, 0, 0);
    }
    if (BIAS) {
        const int cs = min(max(qc - 8, 0), 48);
#pragma unroll
        for (int kt = 0; kt < 8; ++kt) {
            const float* rp = rpb_h + ((kt >> 1) + drow0) * 31;
#pragma unroll
            for (int j = 0; j < 4; ++j) { const int kc = kc0 + (kt & 1) * 16 + 4 * q + j; const bool ok = (kc >= cs) && (kc < cs + 16);
                const int dc = min(max(kc - qc, -15), 15);
                s[kt][j] = ok ? s[kt][j] + rp[dc + 15] : -1e30f; }
        }
    }
    float mx = -1e30f;
#pragma unroll
    for (int kt = 0; kt < 8; ++kt) mx = fmaxf(mx, fmaxf(fmaxf(s[kt][0], s[kt][1]), fmaxf(s[kt][2], s[kt][3])));
    mx = fmaxf(mx, __shfl_xor(mx, 16)); mx = fmaxf(mx, __shfl_xor(mx, 32));
    const float m_new = fmaxf(m_run, mx), alpha = __expf(m_run - m_new);
    float ls = 0.f;
#pragma unroll
    for (int kt = 0; kt < 8; ++kt)
#pragma unroll
        for (int j = 0; j < 4; ++j) { const float p = __expf(s[kt][j] - m_new); s[kt][j] = p; ls += p; }
    ls += __shfl_xor(ls, 16); ls += __shfl_xor(ls, 32);
    l_run = l_run * alpha + ls; m_run = m_new;
#pragma unroll
    for (int dt = 0; dt < 4; ++dt) o[dt] = o[dt] * alpha;
#pragma unroll
    for (int g = 0; g < 4; ++g) {
        u32x4 pw; pw.x = cvt_pk_bf16(s[2 * g][0], s[2 * g][1]); pw.y = cvt_pk_bf16(s[2 * g][2], s[2 * g][3]);
        pw.z = cvt_pk_bf16(s[2 * g + 1][0], s[2 * g + 1][1]); pw.w = cvt_pk_bf16(s[2 * g + 1][2], s[2 * g + 1][3]);
        const bf16x8 pb = __builtin_bit_cast(bf16x8, pw);
#pragma unroll
        for (int dt = 0; dt < 4; ++dt) {
            const bf16_t* vp = Vp + (size_t)(16 * dt + i) * vpitch + tok0 + g * gstride + 4 * q;
            const u32x2 lo = *(const u32x2*)vp, hi = *(const u32x2*)(vp + 16);
            u32x4 vw; vw.x = lo.x; vw.y = lo.y; vw.z = hi.x; vw.w = hi.y;
            o[dt] = __builtin_amdgcn_mfma_f32_16x16x32_bf16(__builtin_bit_cast(bf16x8, vw), pb, o[dt], 0, 0, 0);
        }
    }
    asm volatile("" ::: "memory");
}

constexpr int KROWB = 144;
template <bool BIAS, bool RING = false>
__device__ __forceinline__ void attn_chunk_lds(const LAS unsigned char* Kl, const LAS unsigned char* Vl, int vpitchB, int tok0, int gstride,
                                               const bf16x8 qf0, const bf16x8 qf1, float& m_run, float& l_run, f32x4 (&o)[4],
                                               const float* rpb_h, int drow0, int kc0, int qc, int lane) {
    const int i = lane & 15, q = lane >> 4;
    f32x4 s[8];
#pragma unroll
    for (int kt = 0; kt < 8; ++kt) {
        const int tg = RING ? ((((gstride + (kt >> 1)) & 7) << 6) + tok0) : (tok0 + (kt >> 1) * gstride);
        const LAS unsigned char* kp = Kl + (tg + (kt & 1) * 16 + i) * KROWB + 16 * q;
        const bf16x8 a0 = *(const LAS bf16x8*)kp, a1 = *(const LAS bf16x8*)(kp + 64);
        f32x4 z = (f32x4){0.f, 0.f, 0.f, 0.f};
        z = __builtin_amdgcn_mfma_f32_16x16x32_bf16(a0, qf0, z, 0, 0, 0);
        s[kt] = __builtin_amdgcn_mfma_f32_16x16x32_bf16(a1, qf1, z, 0, 0, 0);
        if (kt & 1) asm volatile("" ::: "memory");
    }
    if (BIAS) {
        const int cs = min(max(qc - 8, 0), 48);
        int off[8]; bool ok[8];
#pragma unroll
        for (int ee = 0; ee < 8; ++ee) { const int kc = kc0 + (ee >> 2) * 16 + 4 * q + (ee & 3); ok[ee] = (unsigned)(kc - cs) < 16u; off[ee] = min(max(kc - qc + 15, 0), 30); }
#pragma unroll
        for (int g = 0; g < 4; ++g) {
            const float* rp = rpb_h + (g + drow0) * 31;
#pragma unroll
            for (int ee = 0; ee < 8; ++ee) { const float bv = rp[off[ee]]; const float sv = s[2 * g + (ee >> 2)][ee & 3]; s[2 * g + (ee >> 2)][ee & 3] = ok[ee] ? sv + bv : -1e30f; }
        }
    }
    float mx = -1e30f;
#pragma unroll
    for (int kt = 0; kt < 8; ++kt) mx = fmaxf(mx, fmaxf(fmaxf(s[kt][0], s[kt][1]), fmaxf(s[kt][2], s[kt][3])));
    mx = fmaxf(mx, __shfl_xor(mx, 16)); mx = fmaxf(mx, __shfl_xor(mx, 32));
    const float m_new = fmaxf(m_run, mx), alpha = __expf(m_run - m_new);
    float ls = 0.f;
#pragma unroll
    for (int kt = 0; kt < 8; ++kt)
#pragma unroll
        for (int j = 0; j < 4; ++j) { const float p = __expf(s[kt][j] - m_new); s[kt][j] = p; ls += p; }
    ls += __shfl_xor(ls, 16); ls += __shfl_xor(ls, 32);
    l_run = l_run * alpha + ls; m_run = m_new;
#pragma unroll
    for (int dt = 0; dt < 4; ++dt) o[dt] = o[dt] * alpha;
#pragma unroll
    for (int g = 0; g < 4; ++g) {
        u32x4 pw; pw.x = cvt_pk_bf16(s[2 * g][0], s[2 * g][1]); pw.y = cvt_pk_bf16(s[2 * g][2], s[2 * g][3]);
        pw.z = cvt_pk_bf16(s[2 * g + 1][0], s[2 * g + 1][1]); pw.w = cvt_pk_bf16(s[2 * g + 1][2], s[2 * g + 1][3]);
        const bf16x8 pb = __builtin_bit_cast(bf16x8, pw);
#pragma unroll
        for (int dt = 0; dt < 4; ++dt) {
            const int tgv = RING ? ((((gstride + g) & 7) << 6) + tok0) : (tok0 + g * gstride);
            const LAS unsigned char* vp = Vl + (16 * dt + i) * vpitchB + (tgv + 4 * q) * 2;
            const u32x2 lo = *(const LAS u32x2*)vp, hi = *(const LAS u32x2*)(vp + 32);
            u32x4 vw; vw.x = lo.x; vw.y = lo.y; vw.z = hi.x; vw.w = hi.y;
            o[dt] = __builtin_amdgcn_mfma_f32_16x16x32_bf16(__builtin_bit_cast(bf16x8, vw), pb, o[dt], 0, 0, 0);
        }
        asm volatile("" ::: "memory");
    }
}
__device__ __forceinline__ void attn_chunk_lds2(const LAS unsigned char* Kl, const LAS unsigned char* Vl, int vpitchB, int tok0, int gstride,
                                                const bf16x8 qa0, const bf16x8 qa1, const bf16x8 qb0, const bf16x8 qb1,
                                                float (&m_run)[2], float (&l_run)[2], f32x4 (&o)[2][4], int lane) {
    const int i = lane & 15, q = lane >> 4;
    f32x4 s[2][8];
#pragma unroll
    for (int kt = 0; kt < 8; ++kt) {
        const LAS unsigned char* kp = Kl + (tok0 + (kt >> 1) * gstride + (kt & 1) * 16 + i) * KROWB + 16 * q;
        const bf16x8 a0 = *(const LAS bf16x8*)kp, a1 = *(const LAS bf16x8*)(kp + 64);
        f32x4 za = (f32x4){0.f, 0.f, 0.f, 0.f}, zb = (f32x4){0.f, 0.f, 0.f, 0.f};
        za = __builtin_amdgcn_mfma_f32_16x16x32_bf16(a0, qa0, za, 0, 0, 0); zb = __builtin_amdgcn_mfma_f32_16x16x32_bf16(a0, qb0, zb, 0, 0, 0);
        s[0][kt] = __builtin_amdgcn_mfma_f32_16x16x32_bf16(a1, qa1, za, 0, 0, 0); s[1][kt] = __builtin_amdgcn_mfma_f32_16x16x32_bf16(a1, qb1, zb, 0, 0, 0);
        if (kt & 1) asm volatile("" ::: "memory");
    }
#pragma unroll
    for (int u = 0; u < 2; ++u) {
        float mx = -1e30f;
#pragma unroll
        for (int kt = 0; kt < 8; ++kt) mx = fmaxf(mx, fmaxf(fmaxf(s[u][kt][0], s[u][kt][1]), fmaxf(s[u][kt][2], s[u][kt][3])));
        mx = fmaxf(mx, __shfl_xor(mx, 16)); mx = fmaxf(mx, __shfl_xor(mx, 32));
        const float m_new = fmaxf(m_run[u], mx), alpha = __expf(m_run[u] - m_new);
        float ls = 0.f;
#pragma unroll
        for (int kt = 0; kt < 8; ++kt)
#pragma unroll
            for (int j = 0; j < 4; ++j) { const float p = __expf(s[u][kt][j] - m_new); s[u][kt][j] = p; ls += p; }
        ls += __shfl_xor(ls, 16); ls += __shfl_xor(ls, 32);
        l_run[u] = l_run[u] * alpha + ls; m_run[u] = m_new;
#pragma unroll
        for (int dt = 0; dt < 4; ++dt) o[u][dt] = o[u][dt] * alpha;
    }
#pragma unroll
    for (int g = 0; g < 4; ++g) {
        bf16x8 pb[2];
#pragma unroll
        for (int u = 0; u < 2; ++u) { u32x4 pw; pw.x = cvt_pk_bf16(s[u][2 * g][0], s[u][2 * g][1]); pw.y = cvt_pk_bf16(s[u][2 * g][2], s[u][2 * g][3]);
            pw.z = cvt_pk_bf16(s[u][2 * g + 1][0], s[u][2 * g + 1][1]); pw.w = cvt_pk_bf16(s[u][2 * g + 1][2], s[u][2 * g + 1][3]); pb[u] = __builtin_bit_cast(bf16x8, pw); }
#pragma unroll
        for (int dt = 0; dt < 4; ++dt) {
            const LAS unsigned char* vp = Vl + (16 * dt + i) * vpitchB + (tok0 + g * gstride + 4 * q) * 2;
            const u32x2 lo = *(const LAS u32x2*)vp, hi = *(const LAS u32x2*)(vp + 32);
            u32x4 vw; vw.x = lo.x; vw.y = lo.y; vw.z = hi.x; vw.w = hi.y;
            const bf16x8 va = __builtin_bit_cast(bf16x8, vw);
            o[0][dt] = __builtin_amdgcn_mfma_f32_16x16x32_bf16(va, pb[0], o[0][dt], 0, 0, 0);
            o[1][dt] = __builtin_amdgcn_mfma_f32_16x16x32_bf16(va, pb[1], o[1][dt], 0, 0, 0);
        }
        asm volatile("" ::: "memory");
    }
}
__device__ __forceinline__ void stage_k(const bf16_t* src, int pitch, int nkeys, LAS unsigned char* dst, int tid) {
    for (int idx = tid; idx < nkeys * 8; idx += 512) { const int row = idx >> 3, ch = idx & 7; const u32x4 v = *(const u32x4*)(src + (size_t)row * pitch + ch * 8); *(LAS u32x4*)(dst + row * KROWB + ch * 16) = v; }
}
__device__ __forceinline__ void stage_vt(const bf16_t* src, int pitch, int nkeys, LAS unsigned char* dst, int vpitchB, int tid) {
    const int nch = nkeys >> 3, sh = nkeys == 512 ? 6 : 5;
    for (int idx = tid; idx < 64 * nch; idx += 512) { const int d = idx >> sh, ch = idx & (nch - 1); const u32x4 v = *(const u32x4*)(src + (size_t)d * pitch + ch * 8); *(LAS u32x4*)(dst + d * vpitchB + ch * 16) = v; }
}

template <int NK> struct KVRegs { u32x4 k[NK / 64]; u32x4 v[NK / 64]; };
template <int NK> __device__ __forceinline__ void kv_load(KVRegs<NK>& R, const bf16_t* ksrc, int kpitch, const bf16_t* vsrc, int vpitch, int tid) {
    constexpr int NCH = NK / 8, SH = NK == 512 ? 6 : 5;
#pragma unroll
    for (int j = 0; j < NK / 64; ++j) { const int idx = tid + 512 * j; const int row = idx >> 3, ch = idx & 7; R.k[j] = *(const u32x4*)(ksrc + (size_t)row * kpitch + ch * 8);
        const int d = idx >> SH, c2 = idx & (NCH - 1); R.v[j] = *(const u32x4*)(vsrc + (size_t)d * vpitch + c2 * 8); }
}
template <int NK> __device__ __forceinline__ void kv_store(const KVRegs<NK>& R, LAS unsigned char* Kl, LAS unsigned char* Vl, int vpitchB, int tid) {
    constexpr int NCH = NK / 8, SH = NK == 512 ? 6 : 5;
#pragma unroll
    for (int j = 0; j < NK / 64; ++j) { const int idx = tid + 512 * j; const int row = idx >> 3, ch = idx & 7; *(LAS u32x4*)(Kl + row * KROWB + ch * 16) = R.k[j];
        const int d = idx >> SH, c2 = idx & (NCH - 1); *(LAS u32x4*)(Vl + d * vpitchB + c2 * 16) = R.v[j]; }
}

template <int NK> struct KRegs { u32x4 k[NK / 64]; };
template <int NK> __device__ __forceinline__ void k_load(KRegs<NK>& R, const bf16_t* ksrc, int kpitch, int tid) {
#pragma unroll
    for (int j = 0; j < NK / 64; ++j) { const int idx = tid + 512 * j; const int row = idx >> 3, ch = idx & 7; R.k[j] = *(const u32x4*)(ksrc + (size_t)row * kpitch + ch * 8); }
}
template <int NK> __device__ __forceinline__ void k_store(const KRegs<NK>& R, LAS unsigned char* Kl, int tid) {
#pragma unroll
    for (int j = 0; j < NK / 64; ++j) { const int idx = tid + 512 * j; const int row = idx >> 3, ch = idx & 7; *(LAS u32x4*)(Kl + row * KROWB + ch * 16) = R.k[j]; }
}
__device__ __forceinline__ void attn_phase(const Args& a, LAS unsigned char* lds, int tid, int wave, int lane, int bid, int G) {
    const bf16_t* Q = (const bf16_t*)(a.ws + WS_Q); const bf16_t* Kb = (const bf16_t*)(a.ws + WS_K); const bf16_t* Vt = (const bf16_t*)(a.ws + WS_VT);
    const bf16_t* Kc = (const bf16_t*)(a.ws + WS_KC); const bf16_t* Vtc = (const bf16_t*)(a.ws + WS_VTC);
    bf16_t* O = (bf16_t*)(a.ws + WS_A2);
    const int i = lane & 15, q = lane >> 4;
    LAS unsigned char* Kl = lds; LAS unsigned char* Vl = lds + 73728;
    LAS float* scr = (LAS float*)(lds + 36864);
    constexpr int VP256 = 528, VP512 = 1040;
    for (int bh = bid; bh < NB_P * NH; bh += G) {
        const int b = bh >> 4, h = bh & 15;
        __syncthreads();
        stage_k(Kb + (size_t)b * SEQ_P * DM + h * HD, DM, 256, Kl, tid);
        stage_vt(Vt + (size_t)bh * HD * SEQ_P, SEQ_P, 256, Vl, VP256, tid);
        __syncthreads();
        {
            const size_t qrow = (size_t)b * SEQ_P + wave * 32;
            const bf16_t* qp = Q + (qrow + i) * DM + h * HD + 8 * q;
            const bf16x8 qa0 = *(const bf16x8*)qp, qa1 = *(const bf16x8*)(qp + 32), qb0 = *(const bf16x8*)(qp + 16 * DM), qb1 = *(const bf16x8*)(qp + 16 * DM + 32);
            float m_run[2] = {-1e30f, -1e30f}, l_run[2] = {0.f, 0.f}; f32x4 o[2][4];
#pragma unroll
            for (int u = 0; u < 2; ++u)
#pragma unroll
                for (int dt = 0; dt < 4; ++dt) o[u][dt] = (f32x4){0.f, 0.f, 0.f, 0.f};
#pragma unroll 1
            for (int c = 0; c < 2; ++c) attn_chunk_lds2(Kl, Vl, VP256, c * 128, 32, qa0, qa1, qb0, qb1, m_run, l_run, o, lane);
#pragma unroll
            for (int u = 0; u < 2; ++u) { const float inv = 1.0f / l_run[u];
                bf16_t* op = O + (qrow + 16 * u + i) * DM + h * HD + 4 * q;
#pragma unroll
                for (int dt = 0; dt < 4; ++dt) { u32x2 w; w.x = cvt_pk_bf16(o[u][dt][0] * inv, o[u][dt][1] * inv); w.y = cvt_pk_bf16(o[u][dt][2] * inv, o[u][dt][3] * inv); *(u32x2*)(op + 16 * dt) = w; } }
        }
    }
    const int jb = wave & 3, half = wave >> 2;
    const int kb0 = min(max(jb * 16 - 8, 0), 32);
    for (int unit = bid; unit < NB_S * NH * 4; unit += G) {
        const int quad = unit & 3, bh = unit >> 2, b = bh >> 4, h = bh & 15;
        const float* rpb_h = a.in[15] + (size_t)h * 15 * 31;
        const bf16_t* Kg = Kb + ((size_t)MP + (size_t)b * SEQ_S) * DM + h * HD;
        const bf16_t* Vg = Vt + (size_t)MP * DM + (size_t)bh * HD * SEQ_S;
        float m_run[4], l_run[4]; f32x4 o[4][4];
        const int rfirst = 4 * quad, r0first = min(max(rfirst - 4, 0), 8);
        __syncthreads();
#pragma unroll
        for (int w8 = 0; w8 < 8; ++w8) { const int wrow = r0first + w8, slot = wrow & 7;
            { const int key = tid >> 3, ch = tid & 7; *(LAS u32x4*)(Kl + (slot * 64 + key) * KROWB + ch * 16) = *(const u32x4*)(Kg + (size_t)(wrow * 64 + key) * DM + ch * 8); }
            { const int d = tid >> 3, ch = tid & 7; *(LAS u32x4*)(Vl + d * VP512 + (slot * 64) * 2 + ch * 16) = *(const u32x4*)(Vg + (size_t)d * SEQ_S + wrow * 64 + ch * 8); } }
        __syncthreads();
#pragma unroll
        for (int k = 0; k < 4; ++k) {
            const int r = rfirst + k, r0 = min(max(r - 4, 0), 8);
            if (k > 0 && r0 != min(max(r - 5, 0), 8)) {
                __syncthreads();
                const int wrow = r0 + 7, slot = wrow & 7;
                { const int key = tid >> 3, ch = tid & 7; *(LAS u32x4*)(Kl + (slot * 64 + key) * KROWB + ch * 16) = *(const u32x4*)(Kg + (size_t)(wrow * 64 + key) * DM + ch * 8); }
                { const int d = tid >> 3, ch = tid & 7; *(LAS u32x4*)(Vl + d * VP512 + (slot * 64) * 2 + ch * 16) = *(const u32x4*)(Vg + (size_t)d * SEQ_S + wrow * 64 + ch * 8); }
                __syncthreads();
            }
            const size_t qrow = (size_t)MP + (size_t)b * SEQ_S + r * 64 + jb * 16;
            const bf16_t* qp = Q + (qrow + i) * DM + h * HD + 8 * q;
            const bf16x8 qf0 = *(const bf16x8*)qp, qf1 = *(const bf16x8*)(qp + 32);
            m_run[k] = -1e30f; l_run[k] = 0.f;
#pragma unroll
            for (int dt = 0; dt < 4; ++dt) o[k][dt] = (f32x4){0.f, 0.f, 0.f, 0.f};
            attn_chunk_lds<true, true>(Kl, Vl, VP512, kb0, r0 + 4 * half, qf0, qf1, m_run[k], l_run[k], o[k], rpb_h, r0 + 4 * half - r + 7, kb0, jb * 16 + i, lane);
        }
        __syncthreads();
        stage_k(Kc + (size_t)bh * PAST * HD, HD, 256, Kl, tid);
        stage_vt(Vtc + (size_t)bh * HD * PAST, PAST, 256, Vl, VP256, tid);
        __syncthreads();
#pragma unroll
        for (int k = 0; k < 4; ++k) {
            const int r = rfirst + k;
            const size_t qrow = (size_t)MP + (size_t)b * SEQ_S + r * 64 + jb * 16;
            const bf16_t* qp = Q + (qrow + i) * DM + h * HD + 8 * q;
            const bf16x8 qf0 = *(const bf16x8*)qp, qf1 = *(const bf16x8*)(qp + 32);
            attn_chunk_lds<false>(Kl, Vl, VP256, half * 128, 32, qf0, qf1, m_run[k], l_run[k], o[k], nullptr, 0, 0, 0, lane);
        }
#pragma unroll
        for (int rnd = 0; rnd < 2; ++rnd) {
            if (half == 1) {
#pragma unroll
                for (int kk = 0; kk < 2; ++kk) { const int k = 2 * rnd + kk; LAS float* sp = scr + (kk * 4 + jb) * 18 * 64 + lane;
                    sp[0] = m_run[k]; sp[64] = l_run[k];
#pragma unroll
                    for (int dt = 0; dt < 4; ++dt)
#pragma unroll
                        for (int j = 0; j < 4; ++j) sp[(2 + dt * 4 + j) * 64] = o[k][dt][j]; }
            }
            __syncthreads();
            if (half == 0) {
#pragma unroll
                for (int kk = 0; kk < 2; ++kk) { const int k = 2 * rnd + kk; const LAS float* sp = scr + (kk * 4 + jb) * 18 * 64 + lane;
                    const float m2 = sp[0], l2 = sp[64], mm = fmaxf(m_run[k], m2), a1 = __expf(m_run[k] - mm), a2 = __expf(m2 - mm);
                    const float inv = 1.0f / (l_run[k] * a1 + l2 * a2);
                    const size_t qrow = (size_t)MP + (size_t)b * SEQ_S + (rfirst + k) * 64 + jb * 16;
                    bf16_t* op = O + (qrow + i) * DM + h * HD + 4 * q;
#pragma unroll
                    for (int dt = 0; dt < 4; ++dt) { float v[4];
#pragma unroll
                        for (int j = 0; j < 4; ++j) v[j] = (o[k][dt][j] * a1 + sp[(2 + dt * 4 + j) * 64] * a2) * inv;
                        u32x2 w; w.x = cvt_pk_bf16(v[0], v[1]); w.y = cvt_pk_bf16(v[2], v[3]); *(u32x2*)(op + 16 * dt) = w; } }
            }
            __syncthreads();
        }
    }
    __syncthreads();
}

__device__ __forceinline__ void gate_fixup(const Args& a, int layer, int pm, int tid) {
    const float* SB = (const float*)(a.ws + WS_SB); bf16_t* A3 = (bf16_t*)(a.ws + WS_A3);
    const float* cw = a.in[18] + (size_t)layer * 3 * DFF; const float* cbias = a.in[19] + (size_t)layer * DFF;
    const int T = pm - 32, pos = T & 3;
    const float* sT = SB + (size_t)T * 6 * DFF;
    for (int c = tid; c < DFF; c += 512) {
        const float w0 = cw[c], w1 = cw[DFF + c], w2 = cw[2 * DFF + c], cb = cbias[c];
        if (pos > 0) { const float up = sT[c - 6 * DFF + 4 * DFF], uc = sT[c], dn = sT[DFF + c], g = sT[2 * DFF + c];
            A3[(size_t)(pm * 256) * DFF + c] = f2bf(pg8::gelu_tanh_f(w0 * up + w1 * uc + w2 * dn + cb) * g); }
        if (pos < 3) { const float up = sT[3 * DFF + c], uc = sT[4 * DFF + c], dn = sT[6 * DFF + c], g = sT[5 * DFF + c];
            A3[(size_t)(pm * 256 + 255) * DFF + c] = f2bf(pg8::gelu_tanh_f(w0 * up + w1 * uc + w2 * dn + cb) * g); }
    }
    asm volatile("s_waitcnt vmcnt(0)" ::: "memory");
    __syncthreads();
}

#define XB_TMO      128
#define XB_XCNT(j)  (256  + 64 * (j))
#define XB_XSUB(j)  (1280 + 64 * (j))
#define XB_XGEN(j)  (2304 + 64 * (j))
#define XB_TOP      3328
#define XB_TOPGEN   3392
#define XCD_BAR_WORDS 3456
#define XB_SPIN_CAP (1u << 22)
__device__ __forceinline__ unsigned xb_ld(unsigned* p)              { return __hip_atomic_load(p, __ATOMIC_RELAXED, __HIP_MEMORY_SCOPE_AGENT); }
__device__ __forceinline__ unsigned xb_add(unsigned* p, unsigned v) { return __hip_atomic_fetch_add(p, v, __ATOMIC_RELAXED, __HIP_MEMORY_SCOPE_AGENT); }
__device__ __forceinline__ unsigned xb_xcc_id() { return (unsigned)__builtin_amdgcn_s_getreg((3 << 11) | 20) & 0xFu; }
#define XB_SPIN(cond, bar) do { unsigned _sp = 0; while (cond) { __builtin_amdgcn_s_sleep(1); \
    if ((++_sp & 255u) == 0u) { if (xb_ld(&(bar)[XB_TMO])) break; if (_sp > XB_SPIN_CAP) { atomicAdd(&(bar)[XB_TMO], 1u); break; } } } } while (0)
struct XcdBarrier { unsigned* bar; unsigned x; volatile LAS unsigned* st; };
__device__ __forceinline__ void xcd_barrier_complete(unsigned* bar, unsigned x, unsigned G, unsigned& nloc, unsigned& nx) {
    unsigned sum, cnt, mine, sp = 0u;
    for (;;) {
        sum = 0u; cnt = 0u; mine = 0u;
#pragma unroll
        for (unsigned j = 0; j < 16; ++j) { const unsigned c = xb_ld(&bar[XB_XCNT(j)]); sum += c; cnt += (c > 0u) ? 1u : 0u; mine = (j == x) ? c : mine; }
        if (sum == G) break;
        __builtin_amdgcn_s_sleep(1);
        if ((++sp & 255u) == 0u) { if (xb_ld(&bar[XB_TMO])) break; if (sp > XB_SPIN_CAP) { atomicAdd(&bar[XB_TMO], 1u); break; } }
    }
    nloc = mine > 0u ? mine : 1u; nx = cnt > 0u ? cnt : 1u;
}
__device__ __forceinline__ void xcd_barrier(const XcdBarrier& b, int tid, unsigned G) {
    asm volatile("s_waitcnt vmcnt(0)" ::: "memory");
    __syncthreads();
    if (tid == 0) {
        unsigned* bar = b.bar;
        __builtin_amdgcn_s_waitcnt(0);
        unsigned nloc = b.st[0], nx = b.st[1];
        if (nloc == 0u) { xcd_barrier_complete(bar, b.x, G, nloc, nx); b.st[0] = nloc; b.st[1] = nx; }
        const unsigned old = xb_add(&bar[XB_XSUB(b.x)], 1u);
        const unsigned gen = old / nloc;
        if (old + 1u == (gen + 1u) * nloc) {
            __builtin_amdgcn_fence(__ATOMIC_RELEASE, "agent");
            asm volatile("s_waitcnt vmcnt(0)" ::: "memory");
            const unsigned og = xb_add(&bar[XB_TOP], 1u);
            const unsigned tg = og / nx;
            if (og + 1u == (tg + 1u) * nx) xb_add(&bar[XB_TOPGEN], 1u);
            else XB_SPIN(xb_ld(&bar[XB_TOPGEN]) == tg, bar);
            __builtin_amdgcn_fence(__ATOMIC_ACQUIRE, "agent");
            xb_add(&bar[XB_XGEN(b.x)], 1u);
            asm volatile("s_waitcnt vmcnt(0)" ::: "memory");
        } else {
            XB_SPIN(xb_ld(&bar[XB_XGEN(b.x)]) == gen, bar);
            __builtin_amdgcn_fence(__ATOMIC_ACQUIRE, "agent");
            asm volatile("s_waitcnt vmcnt(0)" ::: "memory");
        }
    }
    __syncthreads();
}

__global__ void __launch_bounds__(512, 2) fwd_kernel(Args a) {
    extern __shared__ __attribute__((aligned(16))) unsigned char lds_raw[];
    LAS unsigned char* lds = (LAS unsigned char*)lds_raw;
    unsigned char* ws = a.ws;
    XcdBarrier xb; xb.bar = (unsigned*)(ws + WS_CTL); xb.x = xb_xcc_id(); xb.st = (volatile LAS unsigned*)(lds + LDS_BYTES - 64);
    if (threadIdx.x == 0) { xb.st[0] = 0u; xb.st[1] = 0u; if (a.ph_hi - a.ph_lo > 1) (void)xb_add(&xb.bar[XB_XCNT(xb.x)], 1u); }
    __syncthreads();
#ifndef PROBE_MASK
#define PROBE_MASK 0
#endif
    for (int ph = a.ph_lo; ph < a.ph_hi; ++ph) {
      if (ph == 5 || ph == 9 || ph == 13 || ph == 17 || ph == 7 || ph == 15) continue;
      for (int rep = 0; rep < (((PROBE_MASK >> ph) & 1) ? 3 : 1); ++rep) {
        if (ph > a.ph_lo || rep > 0) { if (a.ph_hi > NPH + 1000) cg::this_grid().sync();
          xcd_barrier(xb, threadIdx.x, gridDim.x); }
        int tid = threadIdx.x, bid = blockIdx.x, G = gridDim.x;
        asm volatile("" : "+v"(tid)); asm volatile("" : "+s"(bid)); asm volatile("" : "+s"(G));
        const int lane = tid & 63, wave = __builtin_amdgcn_readfirstlane(tid >> 6);
        if (ph == 0) {
#ifndef DIS_P0
 prologue(a, lds, tid, wave, lane, bid, G);
#endif
 }
        else if (ph == 1 || ph == 5 || ph == 9 || ph == 13 || ph == 17) {
#ifndef DIS_NORM
 norm_phase(a, ph, wave, lane, bid, G);
#endif
 }
        else if (ph == 3) {
#ifndef DIS_CONV
 convgate_phase(a, tid, bid, G);
#endif
 }
        else if (ph == 11) {
#ifndef DIS_ATTN
 attn_phase(a, lds, tid, wave, lane, bid, G);
#endif
 }
        else if (ph == 2) {
            pg8::Gemm g{(const bf16_t*)(ws + WS_H), (const bf16_t*)(ws + WS_WIN), MT, 3 * DM, DM}; pg8::EpiBf16 E{(bf16_t*)(ws + WS_BCX), 3 * DM};
            pg8::StaticOrder S; S.init(g.M, g.N, G, bid);
            pg8::gemm_phase<pg8::EpiBf16, pg8::StaticOrder>(lds, g, S, E, tid);
        }
        else if (ph == 6 || ph == 14) {
            const int l = ph == 14 ? 1 : 0;
            pg8::Gemm g{(const bf16_t*)(ws + WS_H), (const bf16_t*)(ws + WS_WUP) + (size_t)l * DM * 2 * DFF, MT, 2 * DFF, DM};
            pg8::EpiGate E{(bf16_t*)(ws + WS_A3), a.in[18] + (size_t)l * 3 * DFF, a.in[19] + (size_t)l * DFF, (float*)(ws + WS_SB)};
            pg8::StaticOrder S; S.init(g.M, g.N, G, bid);
            pg8::gemm_phase<pg8::EpiGate, pg8::StaticOrder>(lds, g, S, E, tid);
        }
        else if (ph == 10) {
            pg8::Gemm g{(const bf16_t*)(ws + WS_HB), (const bf16_t*)(ws + WS_WQKV), MT, 3 * DM, DM};
            float* sk = a.out + (size_t)MT * DM; float* sv = sk + (size_t)NB_P * NH * SEQ_P * HD;
            pg8::EpiQKV E{(bf16_t*)(ws + WS_Q), (bf16_t*)(ws + WS_K), (bf16_t*)(ws + WS_VT), sk, sv};
            pg8::StaticOrder S; S.init(g.M, g.N, G, bid);
#ifndef DIS_G2
            pg8::gemm_phase<pg8::EpiQKV, pg8::StaticOrder>(lds, g, S, E, tid);
#endif
        }
        else {
            pg8::Gemm g; pg8::EpiResNorm E;
            const float* MOD0 = (const float*)(ws + WS_MOD); const float* MOD1 = MOD0 + (size_t)NCV * MODW;
            float* X = a.out; float* XS = a.out + (size_t)MP * DM;
            float* xch = (float*)(ws + WS_XCH); unsigned* cnt = (unsigned*)(ws + WS_CTL) + CW_CNT;
            bf16_t* HA = (bf16_t*)(ws + WS_H); bf16_t* HB = (bf16_t*)(ws + WS_HB);
            if (ph == 4) { g = pg8::Gemm{(const bf16_t*)(ws + WS_A2), (const bf16_t*)(ws + WS_WOUT), MT, DM, DM};
                E = pg8::EpiResNorm{a.in[0], a.in[1], X, MOD0 + 2 * DM, HA, a.in[9], MOD0 + 3 * DM, MOD0 + 4 * DM, xch, cnt, 0}; }
            else if (ph == 8) { g = pg8::Gemm{(const bf16_t*)(ws + WS_A3), (const bf16_t*)(ws + WS_WDN), MT, DM, DFF};
                E = pg8::EpiResNorm{X, XS, X, MOD0 + 5 * DM, HB, a.in[8] + DM, MOD1, MOD1 + DM, xch + (size_t)MT * 4, cnt + 48 * 16, 0}; }
            else if (ph == 12) { g = pg8::Gemm{(const bf16_t*)(ws + WS_A2), (const bf16_t*)(ws + WS_WO), MT, DM, DM};
                E = pg8::EpiResNorm{X, XS, X, MOD1 + 2 * DM, HA, a.in[9] + DM, MOD1 + 3 * DM, MOD1 + 4 * DM, xch + (size_t)2 * MT * 4, cnt + 2 * 48 * 16, 0}; }
            else { g = pg8::Gemm{(const bf16_t*)(ws + WS_A3), (const bf16_t*)(ws + WS_WDN) + (size_t)DM * DFF, MT, DM, DFF};
                E = pg8::EpiResNorm{X, XS, X, MOD1 + 5 * DM, HA, a.in[21], MOD1, MOD1, xch + (size_t)3 * MT * 4, cnt + 3 * 48 * 16, 1}; }
            pg8::StaticOrder S; S.init(g.M, g.N, G, bid);
            if (ph != 16 && bid >= 192) {
                const int nidle = G - 192; constexpr int TI_A = TI_R1 + 640, TI_B = TI_R2 - I_DN;
                if (ph == 4) transpose_items(a, lds, TI_R0, TI_A, (bid - 192) * 8 + wave, nidle * 8, wave, lane);
                else if (ph == 8) transpose_items(a, lds, TI_A, TI_B, (bid - 192) * 8 + wave, nidle * 8, wave, lane);
                else transpose_items(a, lds, TI_B, TI_R2, (bid - 192) * 8 + wave, nidle * 8, wave, lane);
            }
            if (ph == 8 || ph == 16) { pg8::Unit u0; if (S.next(0, u0) && u0.pm >= 32) gate_fixup(a, ph == 16 ? 1 : 0, u0.pm, tid); }
#ifndef DIS_G3
            pg8::gemm_phase<pg8::EpiResNorm, pg8::StaticOrder>(lds, g, S, E, tid);
#endif
        }
      }
    }
}

extern "C" void kernel_launch(void* const* d_in, const int* in_sizes, int n_in, void* d_out, int out_size, void* d_ws, size_t ws_size, hipStream_t stream) {
    static int grid = 0;
    if (grid == 0) {
        if (n_in != 22 || ws_size < WS_END) { fprintf(stderr, "kernel_launch: unexpected n_in %d / ws_size %zu\n", n_in, ws_size); grid = -1; return; }
        int dev = 0, cus = 0, per_cu = 0;
        hipGetDevice(&dev); hipDeviceGetAttribute(&cus, hipDeviceAttributeMultiprocessorCount, dev);
        if (hipFuncSetAttribute((const void*)fwd_kernel, hipFuncAttributeMaxDynamicSharedMemorySize, LDS_BYTES) != hipSuccess) { fprintf(stderr, "hipFuncSetAttribute failed\n"); grid = -1; return; }
        hipOccupancyMaxActiveBlocksPerMultiprocessor(&per_cu, (const void*)fwd_kernel, 512, LDS_BYTES);
        (void)hipGetLastError();
        if (per_cu < 1) { fprintf(stderr, "occupancy query says %d\n", per_cu); per_cu = 1; }
        grid = cus;
    }
    if (grid < 0) return;
    Args a{};
    for (int i = 0; i < 22; ++i) a.in[i] = (const float*)d_in[i];
    a.out = (float*)d_out; a.ws = (unsigned char*)d_ws;
    if (hipMemsetAsync((char*)d_ws + WS_CTL, 0, CTL_BYTES, stream) != hipSuccess) { fprintf(stderr, "memset failed\n"); return; }
#if MK_MULTI
    for (int ph = 0; ph < NPH; ++ph) { a.ph_lo = ph; a.ph_hi = ph + 1; hipLaunchKernelGGL(fwd_kernel, dim3(grid), dim3(512), LDS_BYTES, stream, a); }
#else
    a.ph_lo = 0; a.ph_hi = NPH;
    void* args[] = {&a};
    hipError_t e = hipLaunchCooperativeKernel((const void*)fwd_kernel, dim3(grid), dim3(512), args, LDS_BYTES, stream);
    if (e != hipSuccess) fprintf(stderr, "cooperative launch failed: %s (grid %d)\n", hipGetErrorString(e), grid);
#endif
}
```

```cpp
#include <hip/hip_runtime.h>
#include <hip/hip_cooperative_groups.h>
#include <cstdio>
#include <cstdint>
namespace cg = cooperative_groups;

#ifndef MK_MULTI
#define MK_MULTI 0
#endif

#define LAS __attribute__((address_space(3)))
typedef unsigned short bf16_t;
typedef short bf16x8 __attribute__((ext_vector_type(8)));
typedef float f32x4 __attribute__((ext_vector_type(4)));
typedef float f32x2 __attribute__((ext_vector_type(2)));
typedef unsigned u32x4 __attribute__((ext_vector_type(4)));
typedef unsigned u32x2 __attribute__((ext_vector_type(2)));

constexpr int DM = 1024, NB_P = 32, SEQ_P = 256, NB_S = 4, SEQ_S = 1024, PAST = 256;
constexpr int MP = NB_P * SEQ_P;
constexpr int MS = NB_S * SEQ_S;
constexpr int MT = MP + MS;
constexpr int NH = 16, HD = 64, DFF = 2816, NCV = 5, MODW = 6 * DM;
constexpr float EPS = 1e-6f;
constexpr int NPH = 18;

constexpr size_t MiB = 1u << 20;
constexpr size_t WS_WIN = 0, WS_WOUT = 6 * MiB, WS_WQKV = 8 * MiB, WS_WO = 14 * MiB, WS_WUP = 16 * MiB, WS_WDN = 38 * MiB;
constexpr size_t WS_MOD = 49 * MiB, WS_KC = 50 * MiB, WS_VTC = 52 * MiB;
constexpr size_t WS_A3 = 54 * MiB;
constexpr size_t WS_H = 120 * MiB, WS_HB = WS_H;
constexpr size_t WS_BCX = 144 * MiB, WS_A2 = 216 * MiB;
constexpr size_t WS_Q = 144 * MiB, WS_K = 168 * MiB, WS_VT = 192 * MiB;
constexpr size_t WS_CTL = 252 * MiB, CTL_BYTES = 32768;
constexpr size_t WS_XCH = 253 * MiB;
constexpr size_t WS_SB = 254 * MiB;
constexpr size_t WS_END = 256 * MiB;
constexpr int CW_MODCNT = 7900;
constexpr int CW_CNT = 4096;
constexpr int LDS_BYTES = 147456;

struct Args { const float* in[22]; float* out; unsigned char* ws; int ph_lo, ph_hi; };

__device__ __forceinline__ unsigned cvt_pk_bf16(float lo, float hi) { unsigned r; asm volatile("v_cvt_pk_bf16_f32 %0, %1, %2" : "=v"(r) : "v"(lo), "v"(hi)); return r; }
__device__ __forceinline__ float bf_lo(unsigned u) { return __uint_as_float(u << 16); }
__device__ __forceinline__ float bf_hi(unsigned u) { return __uint_as_float(u & 0xffff0000u); }
__device__ __forceinline__ unsigned short f2bf(float f) { return (unsigned short)(cvt_pk_bf16(f, 0.f) & 0xffffu); }

namespace pg8 {
constexpr int BM = 256, BK = 64, HALF = 128, HTB = HALF * BK * 2, STAGE_BYTES = 8 * HTB, NXCD = 8, WGM = 8;
__host__ __device__ __forceinline__ int lds_byte(int r, int c) { const int st = (r >> 4) * 2 + (c >> 5), rr = r & 15, cc = c & 31, ob = rr * 64 + cc * 2; return st * 1024 + (ob ^ (((ob >> 9) & 1) << 5)); }
__host__ __device__ __forceinline__ void stage_rc(int b, int& R, int& C) { const int st = b / 1024, sb = b % 1024, swz = sb ^ (((sb >> 9) & 1) << 5); R = (st >> 1) * 16 + swz / 64; C = (st & 1) * 32 + (swz % 64) / 2; }
__host__ __device__ __forceinline__ int perm32(int rho) { const int n = rho >> 4, i = rho & 15; return 8 * (i >> 2) + 4 * n + (i & 3); }

struct Unit { int pm, pn; };
struct Gemm { const bf16_t* A; const bf16_t* Bt; int M, N, K; };

struct StaticOrder {
    int nM, nN, nwg, G, c;
    __device__ void init(int M, int N, int G_, int c_) { nM = M / BM; nN = N / BM; nwg = nM * nN; G = G_; c = c_; }
    __device__ bool next(int i, Unit& u) const {
        const long L = (long)i * G + c; if (L >= nwg) return false;
        int wgid = (int)L; { const int q = nwg / NXCD, r = nwg % NXCD, xcd = wgid % NXCD, off = wgid / NXCD; wgid = (xcd < r ? xcd * (q + 1) : r * (q + 1) + (xcd - r) * q) + off; }
        const int nig = WGM * nN, gid = wgid / nig, fm = gid * WGM, gsz = (nM - fm) < WGM ? (nM - fm) : WGM;
        u.pm = fm + ((wgid % nig) % gsz); u.pn = (wgid % nig) / gsz; return true;
    }
};

struct EpiBf16 {
    static constexpr bool PERM = true, AFTER_DRAIN = false, NEEDS_LDS = false;
    bf16_t* O; int ldc;
    __device__ __forceinline__ void operator()(const f32x4 (&acc)[2][2][4][2], const Unit& u, int wr, int wc, int fr, int fq) const {
        const int row0 = u.pm * BM + wr * 64 + fr; const int col0 = u.pn * BM + wc * 32 + 8 * fq;
#pragma unroll
        for (int ai = 0; ai < 2; ++ai)
#pragma unroll
            for (int m = 0; m < 4; ++m) { bf16_t* rowp = O + (size_t)(row0 + ai * HALF + m * 16) * ldc + col0;
#pragma unroll
                for (int bj = 0; bj < 2; ++bj) { const f32x4 v0 = acc[ai][bj][m][0], v1 = acc[ai][bj][m][1];
                    u32x4 w; w.x = cvt_pk_bf16(v0[0], v0[1]); w.y = cvt_pk_bf16(v0[2], v0[3]); w.z = cvt_pk_bf16(v1[0], v1[1]); w.w = cvt_pk_bf16(v1[2], v1[3]);
                    *(u32x4*)(rowp + bj * HALF) = w; } }
    }
};

struct EpiRes {
    static constexpr bool PERM = false, AFTER_DRAIN = false, NEEDS_LDS = false;
    const float* base_p; const float* base_s; float* out; const float* gate;
    __device__ __forceinline__ void operator()(const f32x4 (&acc)[2][2][4][2], const Unit& u, int wr, int wc, int fr, int fq) const {
        const int cv = u.pm < 32 ? 0 : 1 + ((u.pm - 32) >> 2);
        const int col0 = u.pn * BM + wc * 32 + 4 * fq;
        const float* gp = gate + cv * MODW + col0;
        f32x4 gv[2][2];
#pragma unroll
        for (int bj = 0; bj < 2; ++bj)
#pragma unroll
            for (int n = 0; n < 2; ++n) gv[bj][n] = *(const f32x4*)(gp + bj * HALF + n * 16);
        const float* bb = u.pm < 32 ? base_p + (size_t)u.pm * BM * DM : base_s + (size_t)(u.pm - 32) * BM * DM;
        float* ob = out + (size_t)u.pm * BM * DM;
#pragma unroll
        for (int ai = 0; ai < 2; ++ai)
#pragma unroll
            for (int m = 0; m < 4; ++m) { const size_t off = (size_t)(ai * HALF + wr * 64 + m * 16 + fr) * DM + col0;
#pragma unroll
                for (int bj = 0; bj < 2; ++bj)
#pragma unroll
                    for (int n = 0; n < 2; ++n) { const f32x4 bs = *(const f32x4*)(bb + off + bj * HALF + n * 16);
                        *(f32x4*)(ob + off + bj * HALF + n * 16) = bs + gv[bj][n] * acc[ai][bj][m][n]; }
                asm volatile("" ::: "memory"); }
    }
};

struct EpiResNorm {
    static constexpr bool PERM = false, AFTER_DRAIN = true, NEEDS_LDS = false;
    const float* base_p; const float* base_s; float* out; const float* gate; bf16_t* H; const float* gn; const float* mod_sh; const float* mod_sc; float* xbuf; unsigned* cnt; int final_mode;
    __device__ __forceinline__ void fused(f32x4 (&acc)[2][2][4][2], const Unit& u, int wr, int wc, int fr, int fq, LAS unsigned char* lds, int wid, int lane) const {
        LAS float* P = (LAS float*)lds;
        LAS float* S = (LAS float*)(lds + 8192);
        const int cv = u.pm < 32 ? 0 : 1 + ((u.pm - 32) >> 2);
        const int col0 = u.pn * BM + wc * 32 + 4 * fq;
        const float* bb = u.pm < 32 ? base_p + (size_t)u.pm * BM * DM : base_s + (size_t)(u.pm - 32) * BM * DM;
        float* ob = out + (size_t)u.pm * BM * DM;
        {   const float* gp = gate + cv * MODW + col0;
            f32x4 gv[2][2];
#pragma unroll
            for (int bj = 0; bj < 2; ++bj)
#pragma unroll
                for (int n = 0; n < 2; ++n) gv[bj][n] = *(const f32x4*)(gp + bj * HALF + n * 16);
#pragma unroll
            for (int ai = 0; ai < 2; ++ai)
#pragma unroll
                for (int m = 0; m < 4; ++m) { const size_t off = (size_t)(ai * HALF + wr * 64 + m * 16 + fr) * DM + col0;
                    float ss = 0.f;
#pragma unroll
                    for (int bj = 0; bj < 2; ++bj)
#pragma unroll
                        for (int n = 0; n < 2; ++n) { const f32x4 bs = *(const f32x4*)(bb + off + bj * HALF + n * 16);
                            const f32x4 x = bs + gv[bj][n] * acc[ai][bj][m][n]; acc[ai][bj][m][n] = x;
                            if (!final_mode) *(f32x4*)(ob + off + bj * HALF + n * 16) = x;
                            ss += (x[0] * x[0] + x[1] * x[1]) + (x[2] * x[2] + x[3] * x[3]); }
                    ss += __shfl_xor(ss, 16); ss += __shfl_xor(ss, 32);
                    if (fq == 0) P[(ai * HALF + wr * 64 + m * 16 + fr) * 4 + wc] = ss;
                    asm volatile("" ::: "memory"); }
        }
        asm volatile("s_waitcnt lgkmcnt(0)" ::: "memory"); __builtin_amdgcn_s_barrier(); asm volatile("" ::: "memory");
        const int row = wid * 32 + (lane & 31);
        if (lane < 32) {
            const float tot = (P[row * 4 + 0] + P[row * 4 + 1]) + (P[row * 4 + 2] + P[row * 4 + 3]);
            __hip_atomic_store(xbuf + ((size_t)(u.pm * BM + row) * 4 + u.pn), tot, __ATOMIC_RELAXED, __HIP_MEMORY_SCOPE_AGENT);
        }
        asm volatile("s_waitcnt vmcnt(0)" ::: "memory");
        if (lane == 0) __hip_atomic_fetch_add(cnt + 16 * u.pm, 1u, __ATOMIC_RELAXED, __HIP_MEMORY_SCOPE_AGENT);
        if (wid == 0) {
            unsigned sp = 0;
            while ((unsigned)__builtin_amdgcn_readfirstlane(__hip_atomic_load(cnt + 16 * u.pm, __ATOMIC_RELAXED, __HIP_MEMORY_SCOPE_AGENT)) < 32u) { __builtin_amdgcn_s_sleep(2); if (++sp > (1u << 22)) break; }
            __builtin_amdgcn_fence(__ATOMIC_ACQUIRE, "agent");
        }
        asm volatile("s_waitcnt vmcnt(0) lgkmcnt(0)" ::: "memory"); __builtin_amdgcn_s_barrier(); asm volatile("" ::: "memory");
        if (lane < 32) {
            const float* slot = xbuf + (size_t)(u.pm * BM + row) * 4; float t = 0.f;
#pragma unroll
            for (int k = 0; k < 4; ++k) t += __hip_atomic_load(slot + k, __ATOMIC_RELAXED, __HIP_MEMORY_SCOPE_AGENT);
            S[row] = 1.0f / sqrtf(t * (1.0f / DM) + EPS);
        }
        asm volatile("s_waitcnt vmcnt(0) lgkmcnt(0)" ::: "memory"); __builtin_amdgcn_s_barrier(); asm volatile("" ::: "memory");
        f32x4 ga[2][2], gb[2][2];
#pragma unroll
        for (int bj = 0; bj < 2; ++bj)
#pragma unroll
            for (int n = 0; n < 2; ++n) { const int c = col0 + bj * HALF + n * 16; const f32x4 g4 = *(const f32x4*)(gn + c);
                if (final_mode) { ga[bj][n] = g4; gb[bj][n] = (f32x4){0.f, 0.f, 0.f, 0.f}; }
                else { const f32x4 sc = *(const f32x4*)(mod_sc + cv * MODW + c), sh = *(const f32x4*)(mod_sh + cv * MODW + c); ga[bj][n] = g4 * (1.0f + sc); gb[bj][n] = sh; } }
#pragma unroll
        for (int ai = 0; ai < 2; ++ai)
#pragma unroll
            for (int m = 0; m < 4; ++m) { const int r = ai * HALF + wr * 64 + m * 16 + fr; const float rstd = S[r]; const size_t off = (size_t)r * DM + col0;
#pragma unroll
                for (int bj = 0; bj < 2; ++bj)
#pragma unroll
                    for (int n = 0; n < 2; ++n) { const f32x4 h = (acc[ai][bj][m][n] * rstd) * ga[bj][n] + gb[bj][n];
                        if (final_mode) *(f32x4*)(ob + off + bj * HALF + n * 16) = h;
                        else { u32x2 w; w.x = cvt_pk_bf16(h[0], h[1]); w.y = cvt_pk_bf16(h[2], h[3]); *(u32x2*)(H + (size_t)u.pm * BM * DM + off + bj * HALF + n * 16) = w; } }
            }
    }
};

__device__ __forceinline__ float gelu_tanh_f(float x) {
    const float t = x * x; const float p = __builtin_fmaf(t, -0.10294324f, -2.3022082f);
    return x * __builtin_amdgcn_rcpf(1.0f + __builtin_amdgcn_exp2f(p * x));
}
template <int CTRL> __device__ __forceinline__ float dppf(float oldv, float src) {
    return __int_as_float(__builtin_amdgcn_update_dpp(__float_as_int(oldv), __float_as_int(src), CTRL, 0xf, 0xf, false));
}
struct EpiGate {
    static constexpr bool PERM = true, AFTER_DRAIN = false, NEEDS_LDS = true;
    bf16_t* A3; const float* cw; const float* cbias; float* SB;
    __device__ __forceinline__ void operator()(f32x4 (&acc)[2][2][4][2], const Unit& u, int wr, int wc, int fr, int fq, LAS unsigned char* lds) const {
        LAS float* XU = (LAS float*)(lds + 131072);
        const int c8 = wc * 32 + 8 * fq, gc = u.pn * HALF + c8;
#ifndef NOXU
#pragma unroll
        for (int ai = 0; ai < 2; ++ai) { const int sidx = 2 * ai + wr;
            if (fr == 0)  { *(LAS f32x4*)(XU + (sidx * 2 + 0) * 128 + c8) = acc[ai][0][0][0]; *(LAS f32x4*)(XU + (sidx * 2 + 0) * 128 + c8 + 4) = acc[ai][0][0][1]; }
            if (fr == 15) { *(LAS f32x4*)(XU + (sidx * 2 + 1) * 128 + c8) = acc[ai][0][3][0]; *(LAS f32x4*)(XU + (sidx * 2 + 1) * 128 + c8 + 4) = acc[ai][0][3][1]; } }
#endif
        if (u.pm >= 32) {
            float* sb = SB + (size_t)(u.pm - 32) * 6 * DFF + gc;
            if (wr == 0 && fr < 2) { *(f32x4*)(sb + fr * DFF) = acc[0][0][0][0]; *(f32x4*)(sb + fr * DFF + 4) = acc[0][0][0][1];
                if (fr == 0) { *(f32x4*)(sb + 2 * DFF) = acc[0][1][0][0]; *(f32x4*)(sb + 2 * DFF + 4) = acc[0][1][0][1]; } }
            if (wr == 1 && fr >= 14) { *(f32x4*)(sb + (fr - 11) * DFF) = acc[1][0][3][0]; *(f32x4*)(sb + (fr - 11) * DFF + 4) = acc[1][0][3][1];
                if (fr == 15) { *(f32x4*)(sb + 5 * DFF) = acc[1][1][3][0]; *(f32x4*)(sb + 5 * DFF + 4) = acc[1][1][3][1]; } }
        }
        f32x4 w0[2], w1[2], w2[2], cb[2];
#pragma unroll
        for (int n = 0; n < 2; ++n) { w0[n] = *(const f32x4*)(cw + gc + 4 * n); w1[n] = *(const f32x4*)(cw + DFF + gc + 4 * n); w2[n] = *(const f32x4*)(cw + 2 * DFF + gc + 4 * n); cb[n] = *(const f32x4*)(cbias + gc + 4 * n); }
#ifndef NOXU
        asm volatile("s_waitcnt lgkmcnt(0)" ::: "memory"); __builtin_amdgcn_s_barrier(); asm volatile("" ::: "memory");
#endif
#pragma unroll
        for (int ai = 0; ai < 2; ++ai) { const int sidx = 2 * ai + wr;
            f32x4 top[2], bot[2];
#pragma unroll
            for (int n = 0; n < 2; ++n) {
#ifdef NOXU
                top[n] = (f32x4){0.f,0.f,0.f,0.f}; bot[n] = top[n];
#else
                top[n] = sidx > 0 ? *(const LAS f32x4*)(XU + ((sidx - 1) * 2 + 1) * 128 + c8 + 4 * n) : (f32x4){0.f, 0.f, 0.f, 0.f};
                bot[n] = sidx < 3 ? *(const LAS f32x4*)(XU + ((sidx + 1) * 2 + 0) * 128 + c8 + 4 * n) : (f32x4){0.f, 0.f, 0.f, 0.f};
#endif
            }
#pragma unroll
            for (int m = 0; m < 4; ++m) {
                u32x4 w;
#pragma unroll
                for (int n = 0; n < 2; ++n) { float ov[4];
#pragma unroll
                    for (int j = 0; j < 4; ++j) {
                        const float uc = acc[ai][0][m][n][j];
                        const float upo = m > 0 ? dppf<0x140>(0.f, acc[ai][0][m - 1][n][j]) : top[n][j];
                        const float up = dppf<0x111>(upo, uc);
                        const float dno = m < 3 ? dppf<0x140>(0.f, acc[ai][0][m + 1][n][j]) : bot[n][j];
                        const float dn = dppf<0x101>(dno, uc);
                        const float cv = __builtin_fmaf(w0[n][j], up, __builtin_fmaf(w1[n][j], uc, __builtin_fmaf(w2[n][j], dn, cb[n][j])));
                        ov[j] = gelu_tanh_f(cv) * acc[ai][1][m][n][j]; }
                    if (n == 0) { w.x = cvt_pk_bf16(ov[0], ov[1]); w.y = cvt_pk_bf16(ov[2], ov[3]); } else { w.z = cvt_pk_bf16(ov[0], ov[1]); w.w = cvt_pk_bf16(ov[2], ov[3]); } }
                *(u32x4*)(A3 + (size_t)(u.pm * BM + ai * HALF + wr * 64 + m * 16 + fr) * DFF + gc) = w;
            }
        }
#ifndef NOXU
        asm volatile("s_waitcnt lgkmcnt(0)" ::: "memory"); __builtin_amdgcn_s_barrier(); asm volatile("" ::: "memory");
#endif
    }
};

struct EpiQKV {
    static constexpr bool PERM = false, AFTER_DRAIN = false, NEEDS_LDS = false;
    bf16_t* Q; bf16_t* Kb; bf16_t* Vt; float* sk; float* sv;
    __device__ __forceinline__ void operator()(const f32x4 (&acc)[2][2][4][2], const Unit& u, int wr, int wc, int fr, int fq) const {
        const int which = u.pn >> 2; const int cb = (u.pn & 3) * BM + wc * 32 + 4 * fq;
        const bool prompt = u.pm < 32;
        const int bidx = prompt ? u.pm : ((u.pm - 32) >> 2);
        const int tbase = (prompt ? 0 : ((u.pm - 32) & 3) * 256) + wr * 64 + fr;
        const int T = prompt ? SEQ_P : SEQ_S;
#pragma unroll
        for (int ai = 0; ai < 2; ++ai)
#pragma unroll
            for (int m = 0; m < 4; ++m) {
                const int t = tbase + ai * HALF + m * 16; const size_t row = (size_t)u.pm * BM + ai * HALF + wr * 64 + m * 16 + fr;
#pragma unroll
                for (int bj = 0; bj < 2; ++bj)
#pragma unroll
                    for (int n = 0; n < 2; ++n) { const int c = cb + bj * HALF + n * 16; const f32x4 v = acc[ai][bj][m][n];
                        if (which == 0) { u32x2 w; w.x = cvt_pk_bf16(v[0] * 0.125f, v[1] * 0.125f); w.y = cvt_pk_bf16(v[2] * 0.125f, v[3] * 0.125f); *(u32x2*)(Q + row * DM + c) = w; }
                        else if (which == 1) { u32x2 w; w.x = cvt_pk_bf16(v[0], v[1]); w.y = cvt_pk_bf16(v[2], v[3]); *(u32x2*)(Kb + row * DM + c) = w;
                            if (prompt) *(f32x4*)(sk + ((size_t)(bidx * NH + (c >> 6)) * SEQ_P + t) * HD + (c & 63)) = v; }
                        else { const int h = c >> 6, d = c & 63;
                            if (prompt) *(f32x4*)(sv + ((size_t)(bidx * NH + h) * SEQ_P + t) * HD + d) = v;
                            bf16_t* vp = Vt + (prompt ? 0 : (size_t)MP * DM) + ((size_t)(bidx * NH + h) * HD + d) * T + t;
                            vp[0] = f2bf(v[0]); vp[T] = f2bf(v[1]); vp[2 * T] = f2bf(v[2]); vp[3 * T] = f2bf(v[3]); }
                    }
            }
    }
};

template <class Epi, class Sched>
__device__ __forceinline__ void gemm_phase(LAS unsigned char* lds, const Gemm g, const Sched& S, const Epi& E, const int tid) {
    const int wid = __builtin_amdgcn_readfirstlane(tid >> 6), lane = tid & 63, wr = wid >> 2, wc = wid & 3, fr = lane & 15, fq = lane >> 4;
    const int K = g.K, nt = K / BK;
    unsigned voffA[2], voffB[2];
#pragma unroll
    for (int i = 0; i < 2; ++i) { int R, C; stage_rc(tid * 16 + i * 8192, R, C); const int Rb = Epi::PERM ? ((R & ~31) + perm32(R & 31)) : R;
        voffA[i] = (unsigned)(R * K + C) * 2u; voffB[i] = (unsigned)(Rb * K + C) * 2u; }
    const size_t kstep = (size_t)(BK * 2);
    const size_t hstep = (size_t)HALF * K * 2;
    const size_t tstep = 2 * hstep;
    const unsigned ldsw = (unsigned)wid * 1024u;
    const int aoff = lds_byte(wr * 64 + fr, fq * 8), boff = lds_byte(wc * 32 + fr, fq * 8);
#define PG8_SA(b, h) (((b) * 2 + (h)) * HTB)
#define PG8_SB(b, h) ((4 + (b) * 2 + (h)) * HTB)
#define PG8_STAGE(bufoff, gbase, voff) do { _Pragma("unroll") for (int _i = 0; _i < 2; ++_i) \
        __builtin_amdgcn_global_load_lds((const unsigned*)((const char*)(gbase) + (voff)[_i]), (LAS unsigned*)(lds + (bufoff) + ldsw + _i * 8192), 16, 0, 0); } while (0)
#define PG8_LDA(dst, b, h) do { _Pragma("unroll") for (int m = 0; m < 4; ++m) _Pragma("unroll") for (int k = 0; k < 2; ++k) dst[m][k] = *(const LAS bf16x8*)(lds + PG8_SA(b, h) + aoff + m * 2048 + k * 1024); } while (0)
#define PG8_LDB(dst, b, h) do { _Pragma("unroll") for (int n = 0; n < 2; ++n) _Pragma("unroll") for (int k = 0; k < 2; ++k) dst[n][k] = *(const LAS bf16x8*)(lds + PG8_SB(b, h) + boff + n * 2048 + k * 1024); } while (0)
#define PG8_MMA(ai, bj, At, Bt) do { __builtin_amdgcn_s_setprio(1); _Pragma("unroll") for (int m = 0; m < 4; ++m) _Pragma("unroll") for (int n = 0; n < 2; ++n) _Pragma("unroll") for (int k = 0; k < 2; ++k) \
        acc[ai][bj][m][n] = __builtin_amdgcn_mfma_f32_16x16x32_bf16(Bt[n][k], At[m][k], acc[ai][bj][m][n], 0, 0, 0); __builtin_amdgcn_s_setprio(0); } while (0)
#define PG8_WAIT_V(n) asm volatile("s_waitcnt vmcnt(" #n ")" ::: "memory")
#define PG8_WAIT_L(n) asm volatile("s_waitcnt lgkmcnt(" #n ")" ::: "memory")
#define PG8_BAR __builtin_amdgcn_s_barrier()
#define PG8_SCHED __builtin_amdgcn_sched_barrier(0)
    Unit cur, nxt; int ui = 0;
    if (!S.next(0, cur)) return;
    f32x4 acc[2][2][4][2];
#pragma unroll
    for (int a = 0; a < 2; ++a)
#pragma unroll
        for (int b = 0; b < 2; ++b)
#pragma unroll
            for (int m = 0; m < 4; ++m)
#pragma unroll
                for (int n = 0; n < 2; ++n) acc[a][b][m][n] = (f32x4){0.f, 0.f, 0.f, 0.f};
    bf16x8 At[4][2], B0[2][2], B1[2][2];
    const char* cA = (const char*)g.A + (size_t)cur.pm * tstep; const char* cB = (const char*)g.Bt + (size_t)cur.pn * tstep;
    PG8_STAGE(PG8_SB(0, 0), cB, voffB); PG8_STAGE(PG8_SB(0, 1), cB + hstep, voffB); PG8_STAGE(PG8_SA(0, 0), cA, voffA); PG8_STAGE(PG8_SA(0, 1), cA + hstep, voffA);
    if (wr == 1) PG8_BAR;
    PG8_WAIT_V(2); PG8_BAR;
    PG8_STAGE(PG8_SB(1, 0), cB + kstep, voffB); PG8_STAGE(PG8_SA(1, 0), cA + kstep, voffA); PG8_STAGE(PG8_SB(1, 1), cB + hstep + kstep, voffB);
    PG8_WAIT_V(6); PG8_BAR;
    for (;;) {
        const bool has_next = S.next(ui + 1, nxt);
        const char* nA = has_next ? (const char*)g.A + (size_t)nxt.pm * tstep : cA; const char* nB = has_next ? (const char*)g.Bt + (size_t)nxt.pn * tstep : cB;
        for (int t = 0; t < nt; t += 2) {
            const bool last = (t == nt - 2);
            const char* a1 = cA + (size_t)(t + 1) * kstep;
            const char* a2 = last ? nA : cA + (size_t)(t + 2) * kstep; const char* b2 = last ? nB : cB + (size_t)(t + 2) * kstep;
            const char* a3 = a2 + kstep; const char* b3 = b2 + kstep;
            PG8_LDB(B0, 0, 0); PG8_LDB(B1, 0, 1); PG8_SCHED; PG8_LDA(At, 0, 0); PG8_STAGE(PG8_SA(1, 1), a1 + hstep, voffA);
            PG8_WAIT_V(8); PG8_WAIT_L(0); PG8_BAR; PG8_MMA(0, 0, At, B0); PG8_MMA(0, 1, At, B1); PG8_BAR; PG8_SCHED;
            PG8_LDA(At, 0, 1); PG8_STAGE(PG8_SB(0, 0), b2, voffB); PG8_STAGE(PG8_SB(0, 1), b2 + hstep, voffB); PG8_STAGE(PG8_SA(0, 0), a2, voffA);
            PG8_WAIT_V(8); PG8_WAIT_L(0); PG8_BAR; PG8_MMA(1, 0, At, B0); PG8_MMA(1, 1, At, B1); PG8_BAR; PG8_SCHED;
            PG8_LDB(B0, 1, 0); PG8_LDB(B1, 1, 1); PG8_SCHED; PG8_LDA(At, 1, 0); PG8_STAGE(PG8_SA(0, 1), a2 + hstep, voffA);
            PG8_WAIT_V(8); PG8_WAIT_L(0); PG8_BAR; PG8_MMA(0, 0, At, B0); PG8_MMA(0, 1, At, B1); PG8_BAR; PG8_SCHED;
            PG8_LDA(At, 1, 1); PG8_STAGE(PG8_SB(1, 0), b3, voffB); PG8_STAGE(PG8_SB(1, 1), b3 + hstep, voffB); PG8_STAGE(PG8_SA(1, 0), a3, voffA);
            PG8_WAIT_V(8); PG8_WAIT_L(0); PG8_BAR; PG8_MMA(1, 0, At, B0); PG8_MMA(1, 1, At, B1); PG8_BAR; PG8_SCHED;
        }
        if (wr == 0) PG8_BAR;
        if constexpr (!Epi::AFTER_DRAIN) { if constexpr (Epi::NEEDS_LDS) E(acc, cur, wr, wc, fr, fq, lds); else E(acc, cur, wr, wc, fr, fq); }
        if (!has_next) break;
#pragma unroll
        for (int a = 0; a < 2; ++a)
#pragma unroll
            for (int b = 0; b < 2; ++b)
#pragma unroll
                for (int m = 0; m < 4; ++m)
#pragma unroll
                    for (int n = 0; n < 2; ++n) acc[a][b][m][n] = (f32x4){0.f, 0.f, 0.f, 0.f};
        cur = nxt; cA = nA; cB = nB; ++ui;
        if (wr == 1) PG8_BAR;
    }
    PG8_WAIT_V(0);
    PG8_BAR;
    if constexpr (Epi::AFTER_DRAIN) E.fused(acc, cur, wr, wc, fr, fq, lds, wid, lane);
#undef PG8_SA
#undef PG8_SB
#undef PG8_STAGE
#undef PG8_LDA
#undef PG8_LDB
#undef PG8_MMA
#undef PG8_WAIT_V
#undef PG8_WAIT_L
#undef PG8_BAR
#undef PG8_SCHED
}
}

__device__ __forceinline__ float wave_sum(float v) {
#pragma unroll
    for (int o = 1; o < 64; o <<= 1) v += __shfl_xor(v, o);
    return v;
}
#define LDS_WAIT() asm volatile("s_waitcnt lgkmcnt(0)" ::: "memory")

template <bool UPMAP = false>
__device__ __forceinline__ void p0_transpose_item(const float* W, int K, int N, bf16_t* WT, LAS float* scr, int item, int lane) {
    const int nblk = N / 32, kb = item / nblk, nb = item % nblk, k0 = 64 * kb, n0 = 32 * nb;
    int d0 = n0; if (UPMAP) { const int part = n0 >= DFF ? 1 : 0, cc = n0 - part * DFF; d0 = 256 * (cc >> 7) + 128 * part + (cc & 127); }
    {
        f32x4 v[8]; const int cq = 4 * (lane & 7), kr = lane >> 3;
#pragma unroll
        for (int i = 0; i < 8; ++i) v[i] = *(const f32x4*)(W + (size_t)(k0 + 8 * i + kr) * N + n0 + cq);
#pragma unroll
        for (int i = 0; i < 8; ++i) { LAS float* d = scr + (8 * i + kr) * 33 + cq; d[0] = v[i].x; d[1] = v[i].y; d[2] = v[i].z; d[3] = v[i].w; }
    }
    LDS_WAIT(); asm volatile("" ::: "memory");
    const int c = lane & 7;
#pragma unroll
    for (int j = 0; j < 4; ++j) { const int n = (lane >> 3) + 8 * j; const LAS float* s = scr + (8 * c) * 33 + n;
        u32x4 o; o.x = cvt_pk_bf16(s[0 * 33], s[1 * 33]); o.y = cvt_pk_bf16(s[2 * 33], s[3 * 33]); o.z = cvt_pk_bf16(s[4 * 33], s[5 * 33]); o.w = cvt_pk_bf16(s[6 * 33], s[7 * 33]);
        *(u32x4*)(WT + (size_t)(d0 + n) * K + k0 + 8 * c) = o; }
    LDS_WAIT(); asm volatile("" ::: "memory");
}

constexpr int I_IN = 16 * 96, I_OUT = 16 * 32, I_UP = 16 * 176, I_DN = 44 * 32;
constexpr int TI_R0 = I_IN + I_OUT + I_UP, TI_R1 = TI_R0 + I_DN, TI_R2 = TI_R1 + I_IN + I_OUT + I_UP + I_DN;
__device__ __forceinline__ void transpose_items(const Args& a, LAS unsigned char* lds, int lo, int hi, int worker, int nworkers, int wave, int lane) {
    unsigned char* ws = a.ws;
    LAS float* scr = (LAS float*)(lds + wave * 16384);
    for (int it = lo + worker; it < hi; it += nworkers) {
        int r = it;
        if (r < I_IN) { p0_transpose_item(a.in[10], DM, 3 * DM, (bf16_t*)(ws + WS_WIN), scr, r, lane); continue; } r -= I_IN;
        if (r < I_OUT) { p0_transpose_item(a.in[13], DM, DM, (bf16_t*)(ws + WS_WOUT), scr, r, lane); continue; } r -= I_OUT;
        if (r < I_UP) { p0_transpose_item<true>(a.in[17], DM, 2 * DFF, (bf16_t*)(ws + WS_WUP), scr, r, lane); continue; } r -= I_UP;
        if (r < I_DN) { p0_transpose_item(a.in[20], DFF, DM, (bf16_t*)(ws + WS_WDN), scr, r, lane); continue; } r -= I_DN;
        if (r < I_IN) { p0_transpose_item(a.in[14], DM, 3 * DM, (bf16_t*)(ws + WS_WQKV), scr, r, lane); continue; } r -= I_IN;
        if (r < I_OUT) { p0_transpose_item(a.in[16], DM, DM, (bf16_t*)(ws + WS_WO), scr, r, lane); continue; } r -= I_OUT;
        if (r < I_UP) { p0_transpose_item<true>(a.in[17] + (size_t)DM * 2 * DFF, DM, 2 * DFF, (bf16_t*)(ws + WS_WUP) + (size_t)DM * 2 * DFF, scr, r, lane); continue; } r -= I_UP;
        p0_transpose_item(a.in[20] + (size_t)DM * DFF, DFF, DM, (bf16_t*)(ws + WS_WDN) + (size_t)DM * DFF, scr, r, lane);
    }
}

__device__ __forceinline__ void prologue(const Args& a, LAS unsigned char* lds, int tid, int wave, int lane, int bid, int G) {
    unsigned char* ws = a.ws;
    float* MOD = (float*)(ws + WS_MOD);
    LAS float* sil = (LAS float*)lds;
    LAS float* red = (LAS float*)(lds + 5 * 1024 * 4);
    for (int i = tid; i < NCV * DM; i += 512) { const int cv = i >> 10, k = i & 1023; const float x = cv == 0 ? a.in[5][k] : a.in[4][(cv - 1) * DM + k]; sil[i] = x / (1.f + __expf(-x)); }
    __syncthreads();
    for (int item = bid; item < 2 * (MODW / 32); item += G) {
        const int l = item / (MODW / 32), col0 = (item % (MODW / 32)) * 32;
        const float* W = a.in[6] + (size_t)l * DM * MODW + col0 + 4 * (lane & 7);
        f32x4 acc[NCV];
#pragma unroll
        for (int cv = 0; cv < NCV; ++cv) acc[cv] = (f32x4){0.f, 0.f, 0.f, 0.f};
#pragma unroll 4
        for (int i = 0; i < 16; ++i) { const int k = 128 * wave + 8 * i + (lane >> 3); const f32x4 w = *(const f32x4*)(W + (size_t)k * MODW);
#pragma unroll
            for (int cv = 0; cv < NCV; ++cv) acc[cv] += sil[cv * DM + k] * w; }
#pragma unroll
        for (int cv = 0; cv < NCV; ++cv)
#pragma unroll
            for (int j = 0; j < 4; ++j) { float v = acc[cv][j]; v += __shfl_xor(v, 8); v += __shfl_xor(v, 16); v += __shfl_xor(v, 32); acc[cv][j] = v; }
        if (lane < 8) {
#pragma unroll
            for (int cv = 0; cv < NCV; ++cv)
#pragma unroll
                for (int j = 0; j < 4; ++j) red[(wave * NCV + cv) * 32 + 4 * lane + j] = acc[cv][j];
        }
        __syncthreads();
        if (tid < NCV * 32) { const int cv = tid >> 5, c = tid & 31; float s = 0.f;
#pragma unroll
            for (int w = 0; w < 8; ++w) s += red[(w * NCV + cv) * 32 + c];
            MOD[((size_t)l * NCV + cv) * MODW + col0 + c] = s + a.in[7][l * MODW + col0 + c]; }
        asm volatile("s_waitcnt vmcnt(0)" ::: "memory");
        __syncthreads();
        if (l == 0 && col0 < 2 * DM && tid == 0) {
            __builtin_amdgcn_fence(__ATOMIC_RELEASE, "agent");
            __hip_atomic_fetch_add((unsigned*)(ws + WS_CTL) + CW_MODCNT, 1u, __ATOMIC_RELAXED, __HIP_MEMORY_SCOPE_AGENT);
        }
    }
    __syncthreads();
    transpose_items(a, lds, 0, TI_R0, bid * 8 + wave, G * 8, wave, lane);
    const int gt = bid * 512 + tid, NGT = G * 512;
    bf16_t* Kc = (bf16_t*)(ws + WS_KC); bf16_t* Vtc = (bf16_t*)(ws + WS_VTC);
    for (int i = gt; i < NB_S * NH * PAST * HD; i += NGT) {
        Kc[i] = f2bf(a.in[2][i]);
        const int t = i & 255, d = (i >> 8) & 63, bh = i >> 14;
        Vtc[i] = f2bf(a.in[3][((size_t)bh * PAST + t) * HD + d]);
    }
}

__device__ __forceinline__ void norm_phase(const Args& a, int ph, int wave, int lane, int bid, int G) {
    const int gw = bid * 8 + wave, NGW = G * 8;
    const bool is_final = ph == 17, ffn = (ph == 5 || ph == 13); const int layer = ph >= 9 ? 1 : 0;
    const float* g = is_final ? a.in[21] : ((ffn ? a.in[9] : a.in[8]) + layer * DM);
    const float* mod = (const float*)(a.ws + WS_MOD) + (size_t)layer * NCV * MODW + (ffn ? 3 * DM : 0);
    bf16_t* H = (bf16_t*)(a.ws + WS_H);
    f32x4 gv[4];
#pragma unroll
    for (int j = 0; j < 4; ++j) gv[j] = *(const f32x4*)(g + 4 * lane + 256 * j);
    for (int row = gw; row < MT; row += NGW) {
        const float* xr = (ph == 1) ? (row < MP ? a.in[0] + (size_t)row * DM : a.in[1] + (size_t)(row - MP) * DM) : a.out + (size_t)row * DM;
        f32x4 v[4]; float s = 0.f;
#pragma unroll
        for (int j = 0; j < 4; ++j) { v[j] = *(const f32x4*)(xr + 4 * lane + 256 * j); s += (v[j].x * v[j].x + v[j].y * v[j].y) + (v[j].z * v[j].z + v[j].w * v[j].w); }
        const float rstd = 1.0f / sqrtf(wave_sum(s) * (1.f / DM) + EPS);
        if (is_final) {
#pragma unroll
            for (int j = 0; j < 4; ++j) *(f32x4*)(a.out + (size_t)row * DM + 4 * lane + 256 * j) = (v[j] * rstd) * gv[j];
        } else {
            const int cv = row < MP ? 0 : 1 + ((row - MP) >> 10);
            const float* mp = mod + (size_t)cv * MODW + 4 * lane;
#pragma unroll
            for (int j = 0; j < 4; ++j) { const f32x4 sh = *(const f32x4*)(mp + 256 * j), sc = *(const f32x4*)(mp + DM + 256 * j);
                const f32x4 h = ((v[j] * rstd) * gv[j]) * (1.0f + sc) + sh;
                u32x2 w; w.x = cvt_pk_bf16(h.x, h.y); w.y = cvt_pk_bf16(h.z, h.w);
                *(u32x2*)(H + (size_t)row * DM + 4 * lane + 256 * j) = w; }
        }
    }
}

struct F8 { float v[8]; };
__device__ __forceinline__ F8 ld8(const bf16_t* p) { const u32x4 w = *(const u32x4*)p; F8 r; r.v[0] = bf_lo(w.x); r.v[1] = bf_hi(w.x); r.v[2] = bf_lo(w.y); r.v[3] = bf_hi(w.y); r.v[4] = bf_lo(w.z); r.v[5] = bf_hi(w.z); r.v[6] = bf_lo(w.w); r.v[7] = bf_hi(w.w); return r; }
__device__ __forceinline__ F8 ldf8(const float* p) { const f32x4 a = *(const f32x4*)p, b = *(const f32x4*)(p + 4); F8 r; r.v[0] = a.x; r.v[1] = a.y; r.v[2] = a.z; r.v[3] = a.w; r.v[4] = b.x; r.v[5] = b.y; r.v[6] = b.z; r.v[7] = b.w; return r; }
__device__ __forceinline__ void st8(bf16_t* p, const F8& o) { u32x4 w; w.x = cvt_pk_bf16(o.v[0], o.v[1]); w.y = cvt_pk_bf16(o.v[2], o.v[3]); w.z = cvt_pk_bf16(o.v[4], o.v[5]); w.w = cvt_pk_bf16(o.v[6], o.v[7]); *(u32x4*)p = w; }
__device__ __forceinline__ F8 zero8() { F8 r;
#pragma unroll
    for (int e = 0; e < 8; ++e) r.v[e] = 0.f;
    return r; }

constexpr int RS = 8;
__device__ __forceinline__ F8 unpack8c(const u32x4 w) { F8 r; r.v[0] = bf_lo(w.x); r.v[1] = bf_hi(w.x); r.v[2] = bf_lo(w.y); r.v[3] = bf_hi(w.y); r.v[4] = bf_lo(w.z); r.v[5] = bf_hi(w.z); r.v[6] = bf_lo(w.w); r.v[7] = bf_hi(w.w); return r; }
__device__ __forceinline__ void convgate_phase(const Args& a, int tid, int bid, int G) {
    const bf16_t* BCX = (const bf16_t*)(a.ws + WS_BCX); bf16_t* A2 = (bf16_t*)(a.ws + WS_A2);
    const float* cw = a.in[11]; const float* cbias = a.in[12];
    constexpr int NITEM = (MT / RS) * (DM / 8); const int per = (NITEM + G - 1) / G;
    for (int j = tid; j < per; j += 512) {
        const int item = bid * per + j; if (item >= NITEM) break;
        const int strip = item >> 7, c = (item & 127) * 8, r0 = strip * RS;
        const int seqm = r0 < MP ? (SEQ_P - 1) : (SEQ_S - 1);
        const bool first = (r0 & seqm) == 0, last = ((r0 + RS) & seqm) == 0;
        const bf16_t* p = BCX + (size_t)r0 * (3 * DM) + c;
        u32x4 cr[RS + 2], xr[RS + 2], br[RS];
        const u32x4 z4 = (u32x4){0u, 0u, 0u, 0u};
        cr[0] = first ? z4 : *(const u32x4*)(p - 3 * DM + DM); xr[0] = first ? z4 : *(const u32x4*)(p - 3 * DM + 2 * DM);
#pragma unroll
        for (int i = 0; i < RS; ++i) { br[i] = *(const u32x4*)(p + (size_t)i * 3 * DM); cr[i + 1] = *(const u32x4*)(p + (size_t)i * 3 * DM + DM); xr[i + 1] = *(const u32x4*)(p + (size_t)i * 3 * DM + 2 * DM); }
        cr[RS + 1] = last ? z4 : *(const u32x4*)(p + (size_t)RS * 3 * DM + DM); xr[RS + 1] = last ? z4 : *(const u32x4*)(p + (size_t)RS * 3 * DM + 2 * DM);
        const F8 w0 = ldf8(cw + c), w1 = ldf8(cw + DM + c), w2 = ldf8(cw + 2 * DM + c), cb = ldf8(cbias + c);
        F8 prev, cur;
        { const F8 x = unpack8c(cr[0]), y = unpack8c(xr[0]);
#pragma unroll
            for (int e = 0; e < 8; ++e) prev.v[e] = x.v[e] * y.v[e]; }
        { const F8 x = unpack8c(cr[1]), y = unpack8c(xr[1]);
#pragma unroll
            for (int e = 0; e < 8; ++e) cur.v[e] = x.v[e] * y.v[e]; }
#pragma unroll
        for (int i = 0; i < RS; ++i) {
            F8 nxt; { const F8 x = unpack8c(cr[i + 2]), y = unpack8c(xr[i + 2]);
#pragma unroll
                for (int e = 0; e < 8; ++e) nxt.v[e] = x.v[e] * y.v[e]; }
            const F8 bg = unpack8c(br[i]); F8 o;
#pragma unroll
            for (int e = 0; e < 8; ++e) o.v[e] = bg.v[e] * (w0.v[e] * prev.v[e] + w1.v[e] * cur.v[e] + w2.v[e] * nxt.v[e] + cb.v[e]);
            st8(A2 + (size_t)(r0 + i) * DM + c, o);
            prev = cur; cur = nxt;
        }
    }
}
__device__ __forceinline__ float gelu_tanh(float x) {
    const float t = x * x; const float p = __builtin_fmaf(t, -0.10294324f, -2.3022082f);
    return x * __builtin_amdgcn_rcpf(1.0f + __builtin_amdgcn_exp2f(p * x));
}
__device__ __forceinline__ F8 unpack8(const u32x4 w) { F8 r; r.v[0] = bf_lo(w.x); r.v[1] = bf_hi(w.x); r.v[2] = bf_lo(w.y); r.v[3] = bf_hi(w.y); r.v[4] = bf_lo(w.z); r.v[5] = bf_hi(w.z); r.v[6] = bf_lo(w.w); r.v[7] = bf_hi(w.w); return r; }
template <bool BIAS>
__device__ __forceinline__ void attn_chunk(const bf16_t* Kp, int kpitch, const bf16_t* Vp, int vpitch, int tok0, int gstride,
                                           const bf16x8 qf0, const bf16x8 qf1, float& m_run, float& l_run, f32x4 (&o)[4],
                                           const float* rpb_h, int drow0, int kc0, int qc, int lane) {
    const int i = lane & 15, q = lane >> 4;
    f32x4 s[8];
#pragma unroll
    for (int kt = 0; kt < 8; ++kt) {
        const bf16_t* kp = Kp + (size_t)(tok0 + (kt >> 1) * gstride + (kt & 1) * 16 + i) * kpitch + 8 * q;
        const bf16x8 a0 = *(const bf16x8*)kp, a1 = *(const bf16x8*)(kp + 32);
        f32x4 z = (f32x4){0.f, 0.f, 0.f, 0.f};
        z = __builtin_amdgcn_mfma_f32_16x16x32_bf16(a0, qf0, z, 0, 0, 0);
        s[kt] = __builtin_amdgcn_mfma_f32_16x16x32_bf16(a1, qf1, z, 0, 0, 0);
    }
    if (BIAS) {
        const int cs = min(max(qc - 8, 0), 48);
#pragma unroll
        for (int kt = 0; kt < 8; ++kt) {
            const float* rp = rpb_h + ((kt >> 1) + drow0) * 31;
#pragma unroll
            for (int j = 0; j < 4; ++j) { const int kc = kc0 + (kt & 1) * 16 + 4 * q + j; const bool ok = (kc >= cs) && (kc < cs + 16);
                const int dc = min(max(kc - qc, -15), 15);
                s[kt][j] = ok ? s[kt][j] + rp[dc + 15] : -1e30f; }
        }
    }
    float mx = -1e30f;
#pragma unroll
    for (int kt = 0; kt < 8; ++kt) mx = fmaxf(mx, fmaxf(fmaxf(s[kt][0], s[kt][1]), fmaxf(s[kt][2], s[kt][3])));
    mx = fmaxf(mx, __shfl_xor(mx, 16)); mx = fmaxf(mx, __shfl_xor(mx, 32));
    const float m_new = fmaxf(m_run, mx), alpha = __expf(m_run - m_new);
    float ls = 0.f;
#pragma unroll
    for (int kt = 0; kt < 8; ++kt)
#pragma unroll
        for (int j = 0; j < 4; ++j) { const float p = __expf(s[kt][j] - m_new); s[kt][j] = p; ls += p; }
    ls += __shfl_xor(ls, 16); ls += __shfl_xor(ls, 32);
    l_run = l_run * alpha + ls; m_run = m_new;
#pragma unroll
    for (int dt = 0; dt < 4; ++dt) o[dt] = o[dt] * alpha;
#pragma unroll
    for (int g = 0; g < 4; ++g) {
        u32x4 pw; pw.x = cvt_pk_bf16(s[2 * g][0], s[2 * g][1]); pw.y = cvt_pk_bf16(s[2 * g][2], s[2 * g][3]);
        pw.z = cvt_pk_bf16(s[2 * g + 1][0], s[2 * g + 1][1]); pw.w = cvt_pk_bf16(s[2 * g + 1][2], s[2 * g + 1][3]);
        const bf16x8 pb = __builtin_bit_cast(bf16x8, pw);
#pragma unroll
        for (int dt = 0; dt < 4; ++dt) {
            const bf16_t* vp = Vp + (size_t)(16 * dt + i) * vpitch + tok0 + g * gstride + 4 * q;
            const u32x2 lo = *(const u32x2*)vp, hi = *(const u32x2*)(vp + 16);
            u32x4 vw; vw.x = lo.x; vw.y = lo.y; vw.z = hi.x; vw.w = hi.y;
            o[dt] = __builtin_amdgcn_mfma_f32_16x16x32_bf16(__builtin_bit_cast(bf16x8, vw), pb, o[dt], 0, 0, 0);
        }
    }
    asm volatile("" ::: "memory");
}

constexpr int KROWB = 144;
template <bool BIAS, bool RING = false>
__device__ __forceinline__ void attn_chunk_lds(const LAS unsigned char* Kl, const LAS unsigned char* Vl, int vpitchB, int tok0, int gstride,
                                               const bf16x8 qf0, const bf16x8 qf1, float& m_run, float& l_run, f32x4 (&o)[4],
                                               const float* rpb_h, int drow0, int kc0, int qc, int lane) {
    const int i = lane & 15, q = lane >> 4;
    f32x4 s[8];
#pragma unroll
    for (int kt = 0; kt < 8; ++kt) {
        const int tg = RING ? ((((gstride + (kt >> 1)) & 7) << 6) + tok0) : (tok0 + (kt >> 1) * gstride);
        const LAS unsigned char* kp = Kl + (tg + (kt & 1) * 16 + i) * KROWB + 16 * q;
        const bf16x8 a0 = *(const LAS bf16x8*)kp, a1 = *(const LAS bf16x8*)(kp + 64);
        f32x4 z = (f32x4){0.f, 0.f, 0.f, 0.f};
        z = __builtin_amdgcn_mfma_f32_16x16x32_bf16(a0, qf0, z, 0, 0, 0);
        s[kt] = __builtin_amdgcn_mfma_f32_16x16x32_bf16(a1, qf1, z, 0, 0, 0);
        if (kt & 1) asm volatile("" ::: "memory");
    }
    if (BIAS) {
        const int cs = min(max(qc - 8, 0), 48);
        int off[8]; bool ok[8];
#pragma unroll
        for (int ee = 0; ee < 8; ++ee) { const int kc = kc0 + (ee >> 2) * 16 + 4 * q + (ee & 3); ok[ee] = (unsigned)(kc - cs) < 16u; off[ee] = min(max(kc - qc + 15, 0), 30); }
#pragma unroll
        for (int g = 0; g < 4; ++g) {
            const float* rp = rpb_h + (g + drow0) * 31;
#pragma unroll
            for (int ee = 0; ee < 8; ++ee) { const float bv = rp[off[ee]]; const float sv = s[2 * g + (ee >> 2)][ee & 3]; s[2 * g + (ee >> 2)][ee & 3] = ok[ee] ? sv + bv : -1e30f; }
        }
    }
    float mx = -1e30f;
#pragma unroll
    for (int kt = 0; kt < 8; ++kt) mx = fmaxf(mx, fmaxf(fmaxf(s[kt][0], s[kt][1]), fmaxf(s[kt][2], s[kt][3])));
    mx = fmaxf(mx, __shfl_xor(mx, 16)); mx = fmaxf(mx, __shfl_xor(mx, 32));
    const float m_new = fmaxf(m_run, mx), alpha = __expf(m_run - m_new);
    float ls = 0.f;
#pragma unroll
    for (int kt = 0; kt < 8; ++kt)
#pragma unroll
        for (int j = 0; j < 4; ++j) { const float p = __expf(s[kt][j] - m_new); s[kt][j] = p; ls += p; }
    ls += __shfl_xor(ls, 16); ls += __shfl_xor(ls, 32);
    l_run = l_run * alpha + ls; m_run = m_new;
#pragma unroll
    for (int dt = 0; dt < 4; ++dt) o[dt] = o[dt] * alpha;
#pragma unroll
    for (int g = 0; g < 4; ++g) {
        u32x4 pw; pw.x = cvt_pk_bf16(s[2 * g][0], s[2 * g][1]); pw.y = cvt_pk_bf16(s[2 * g][2], s[2 * g][3]);
        pw.z = cvt_pk_bf16(s[2 * g + 1][0], s[2 * g + 1][1]); pw.w = cvt_pk_bf16(s[2 * g + 1][2], s[2 * g + 1][3]);
        const bf16x8 pb = __builtin_bit_cast(bf16x8, pw);
#pragma unroll
        for (int dt = 0; dt < 4; ++dt) {
            const int tgv = RING ? ((((gstride + g) & 7) << 6) + tok0) : (tok0 + g * gstride);
            const LAS unsigned char* vp = Vl + (16 * dt + i) * vpitchB + (tgv + 4 * q) * 2;
            const u32x2 lo = *(const LAS u32x2*)vp, hi = *(const LAS u32x2*)(vp + 32);
            u32x4 vw; vw.x = lo.x; vw.y = lo.y; vw.z = hi.x; vw.w = hi.y;
            o[dt] = __builtin_amdgcn_mfma_f32_16x16x32_bf16(__builtin_bit_cast(bf16x8, vw), pb, o[dt], 0, 0, 0);
        }
        asm volatile("" ::: "memory");
    }
}
__device__ __forceinline__ void attn_chunk_lds2(const LAS unsigned char* Kl, const LAS unsigned char* Vl, int vpitchB, int tok0, int gstride,
                                                const bf16x8 qa0, const bf16x8 qa1, const bf16x8 qb0, const bf16x8 qb1,
                                                float (&m_run)[2], float (&l_run)[2], f32x4 (&o)[2][4], int lane) {
    const int i = lane & 15, q = lane >> 4;
    f32x4 s[2][8];
#pragma unroll
    for (int kt = 0; kt < 8; ++kt) {
        const LAS unsigned char* kp = Kl + (tok0 + (kt >> 1) * gstride + (kt & 1) * 16 + i) * KROWB + 16 * q;
        const bf16x8 a0 = *(const LAS bf16x8*)kp, a1 = *(const LAS bf16x8*)(kp + 64);
        f32x4 za = (f32x4){0.f, 0.f, 0.f, 0.f}, zb = (f32x4){0.f, 0.f, 0.f, 0.f};
        za = __builtin_amdgcn_mfma_f32_16x16x32_bf16(a0, qa0, za, 0, 0, 0); zb = __builtin_amdgcn_mfma_f32_16x16x32_bf16(a0, qb0, zb, 0, 0, 0);
        s[0][kt] = __builtin_amdgcn_mfma_f32_16x16x32_bf16(a1, qa1, za, 0, 0, 0); s[1][kt] = __builtin_amdgcn_mfma_f32_16x16x32_bf16(a1, qb1, zb, 0, 0, 0);
        if (kt & 1) asm volatile("" ::: "memory");
    }
#pragma unroll
    for (int u = 0; u < 2; ++u) {
        float mx = -1e30f;
#pragma unroll
        for (int kt = 0; kt < 8; ++kt) mx = fmaxf(mx, fmaxf(fmaxf(s[u][kt][0], s[u][kt][1]), fmaxf(s[u][kt][2], s[u][kt][3])));
        mx = fmaxf(mx, __shfl_xor(mx, 16)); mx = fmaxf(mx, __shfl_xor(mx, 32));
        const float m_new = fmaxf(m_run[u], mx), alpha = __expf(m_run[u] - m_new);
        float ls = 0.f;
#pragma unroll
        for (int kt = 0; kt < 8; ++kt)
#pragma unroll
            for (int j = 0; j < 4; ++j) { const float p = __expf(s[u][kt][j] - m_new); s[u][kt][j] = p; ls += p; }
        ls += __shfl_xor(ls, 16); ls += __shfl_xor(ls, 32);
        l_run[u] = l_run[u] * alpha + ls; m_run[u] = m_new;
#pragma unroll
        for (int dt = 0; dt < 4; ++dt) o[u][dt] = o[u][dt] * alpha;
    }
#pragma unroll
    for (int g = 0; g < 4; ++g) {
        bf16x8 pb[2];
#pragma unroll
        for (int u = 0; u < 2; ++u) { u32x4 pw; pw.x = cvt_pk_bf16(s[u][2 * g][0], s[u][2 * g][1]); pw.y = cvt_pk_bf16(s[u][2 * g][2], s[u][2 * g][3]);
            pw.z = cvt_pk_bf16(s[u][2 * g + 1][0], s[u][2 * g + 1][1]); pw.w = cvt_pk_bf16(s[u][2 * g + 1][2], s[u][2 * g + 1][3]); pb[u] = __builtin_bit_cast(bf16x8, pw); }
#pragma unroll
        for (int dt = 0; dt < 4; ++dt) {
            const LAS unsigned char* vp = Vl + (16 * dt + i) * vpitchB + (tok0 + g * gstride + 4 * q) * 2;
            const u32x2 lo = *(const LAS u32x2*)vp, hi = *(const LAS u32x2*)(vp + 32);
            u32x4 vw; vw.x = lo.x; vw.y = lo.y; vw.z = hi.x; vw.w = hi.y;
            const bf16x8 va = __builtin_bit_cast(bf16x8, vw);
            o[0][dt] = __builtin_amdgcn_mfma_f32_16x16x32_bf16(va, pb[0], o[0][dt], 0, 0, 0);
            o[1][dt] = __builtin_amdgcn_mfma_f32_16x16x32_bf16(va, pb[1], o[1][dt], 0, 0, 0);
        }
        asm volatile("" ::: "memory");
    }
}
__device__ __forceinline__ void stage_k(const bf16_t* src, int pitch, int nkeys, LAS unsigned char* dst, int tid) {
    for (int idx = tid; idx < nkeys * 8; idx += 512) { const int row = idx >> 3, ch = idx & 7; const u32x4 v = *(const u32x4*)(src + (size_t)row * pitch + ch * 8); *(LAS u32x4*)(dst + row * KROWB + ch * 16) = v; }
}
__device__ __forceinline__ void stage_vt(const bf16_t* src, int pitch, int nkeys, LAS unsigned char* dst, int vpitchB, int tid) {
    const int nch = nkeys >> 3, sh = nkeys == 512 ? 6 : 5;
    for (int idx = tid; idx < 64 * nch; idx += 512) { const int d = idx >> sh, ch = idx & (nch - 1); const u32x4 v = *(const u32x4*)(src + (size_t)d * pitch + ch * 8); *(LAS u32x4*)(dst + d * vpitchB + ch * 16) = v; }
}

template <int NK> struct KVRegs { u32x4 k[NK / 64]; u32x4 v[NK / 64]; };
template <int NK> __device__ __forceinline__ void kv_load(KVRegs<NK>& R, const bf16_t* ksrc, int kpitch, const bf16_t* vsrc, int vpitch, int tid) {
    constexpr int NCH = NK / 8, SH = NK == 512 ? 6 : 5;
#pragma unroll
    for (int j = 0; j < NK / 64; ++j) { const int idx = tid + 512 * j; const int row = idx >> 3, ch = idx & 7; R.k[j] = *(const u32x4*)(ksrc + (size_t)row * kpitch + ch * 8);
        const int d = idx >> SH, c2 = idx & (NCH - 1); R.v[j] = *(const u32x4*)(vsrc + (size_t)d * vpitch + c2 * 8); }
}
template <int NK> __device__ __forceinline__ void kv_store(const KVRegs<NK>& R, LAS unsigned char* Kl, LAS unsigned char* Vl, int vpitchB, int tid) {
    constexpr int NCH = NK / 8, SH = NK == 512 ? 6 : 5;
#pragma unroll
    for (int j = 0; j < NK / 64; ++j) { const int idx = tid + 512 * j; const int row = idx >> 3, ch = idx & 7; *(LAS u32x4*)(Kl + row * KROWB + ch * 16) = R.k[j];
        const int d = idx >> SH, c2 = idx & (NCH - 1); *(LAS u32x4*)(Vl + d * vpitchB + c2 * 16) = R.v[j]; }
}

template <int NK> struct KRegs { u32x4 k[NK / 64]; };
template <int NK> __device__ __forceinline__ void k_load(KRegs<NK>& R, const bf16_t* ksrc, int kpitch, int tid) {
#pragma unroll
    for (int j = 0; j < NK / 64; ++j) { const int idx = tid + 512 * j; const int row = idx >> 3, ch = idx & 7; R.k[j] = *(const u32x4*)(ksrc + (size_t)row * kpitch + ch * 8); }
}
template <int NK> __device__ __forceinline__ void k_store(const KRegs<NK>& R, LAS unsigned char* Kl, int tid) {
#pragma unroll
    for (int j = 0; j < NK / 64; ++j) { const int idx = tid + 512 * j; const int row = idx >> 3, ch = idx & 7; *(LAS u32x4*)(Kl + row * KROWB + ch * 16) = R.k[j]; }
}
__device__ __forceinline__ void attn_phase(const Args& a, LAS unsigned char* lds, int tid, int wave, int lane, int bid, int G) {
    const bf16_t* Q = (const bf16_t*)(a.ws + WS_Q); const bf16_t* Kb = (const bf16_t*)(a.ws + WS_K); const bf16_t* Vt = (const bf16_t*)(a.ws + WS_VT);
    const bf16_t* Kc = (const bf16_t*)(a.ws + WS_KC); const bf16_t* Vtc = (const bf16_t*)(a.ws + WS_VTC);
    bf16_t* O = (bf16_t*)(a.ws + WS_A2);
    const int i = lane & 15, q = lane >> 4;
    LAS unsigned char* Kl = lds; LAS unsigned char* Vl = lds + 73728;
    LAS float* scr = (LAS float*)(lds + 36864);
    constexpr int VP256 = 528, VP512 = 1040;
    for (int bh = bid; bh < NB_P * NH; bh += G) {
        const int b = bh >> 4, h = bh & 15;
        __syncthreads();
        stage_k(Kb + (size_t)b * SEQ_P * DM + h * HD, DM, 256, Kl, tid);
        stage_vt(Vt + (size_t)bh * HD * SEQ_P, SEQ_P, 256, Vl, VP256, tid);
        __syncthreads();
        {
            const size_t qrow = (size_t)b * SEQ_P + wave * 32;
            const bf16_t* qp = Q + (qrow + i) * DM + h * HD + 8 * q;
            const bf16x8 qa0 = *(const bf16x8*)qp, qa1 = *(const bf16x8*)(qp + 32), qb0 = *(const bf16x8*)(qp + 16 * DM), qb1 = *(const bf16x8*)(qp + 16 * DM + 32);
            float m_run[2] = {-1e30f, -1e30f}, l_run[2] = {0.f, 0.f}; f32x4 o[2][4];
#pragma unroll
            for (int u = 0; u < 2; ++u)
#pragma unroll
                for (int dt = 0; dt < 4; ++dt) o[u][dt] = (f32x4){0.f, 0.f, 0.f, 0.f};
#pragma unroll 1
            for (int c = 0; c < 2; ++c) attn_chunk_lds2(Kl, Vl, VP256, c * 128, 32, qa0, qa1, qb0, qb1, m_run, l_run, o, lane);
#pragma unroll
            for (int u = 0; u < 2; ++u) { const float inv = 1.0f / l_run[u];
                bf16_t* op = O + (qrow + 16 * u + i) * DM + h * HD + 4 * q;
#pragma unroll
                for (int dt = 0; dt < 4; ++dt) { u32x2 w; w.x = cvt_pk_bf16(o[u][dt][0] * inv, o[u][dt][1] * inv); w.y = cvt_pk_bf16(o[u][dt][2] * inv, o[u][dt][3] * inv); *(u32x2*)(op + 16 * dt) = w; } }
        }
    }
    const int jb = wave & 3, half = wave >> 2;
    const int kb0 = min(max(jb * 16 - 8, 0), 32);
    for (int unit = bid; unit < NB_S * NH * 4; unit += G) {
        const int quad = unit & 3, bh = unit >> 2, b = bh >> 4, h = bh & 15;
        const float* rpb_h = a.in[15] + (size_t)h * 15 * 31;
        const bf16_t* Kg = Kb + ((size_t)MP + (size_t)b * SEQ_S) * DM + h * HD;
        const bf16_t* Vg = Vt + (size_t)MP * DM + (size_t)bh * HD * SEQ_S;
        float m_run[4], l_run[4]; f32x4 o[4][4];
        const int rfirst = 4 * quad, r0first = min(max(rfirst - 4, 0), 8);
        __syncthreads();
#pragma unroll
        for (int w8 = 0; w8 < 8; ++w8) { const int wrow = r0first + w8, slot = wrow & 7;
            { const int key = tid >> 3, ch = tid & 7; *(LAS u32x4*)(Kl + (slot * 64 + key) * KROWB + ch * 16) = *(const u32x4*)(Kg + (size_t)(wrow * 64 + key) * DM + ch * 8); }
            { const int d = tid >> 3, ch = tid & 7; *(LAS u32x4*)(Vl + d * VP512 + (slot * 64) * 2 + ch * 16) = *(const u32x4*)(Vg + (size_t)d * SEQ_S + wrow * 64 + ch * 8); } }
        __syncthreads();
#pragma unroll
        for (int k = 0; k < 4; ++k) {
            const int r = rfirst + k, r0 = min(max(r - 4, 0), 8);
            if (k > 0 && r0 != min(max(r - 5, 0), 8)) {
                __syncthreads();
                const int wrow = r0 + 7, slot = wrow & 7;
                { const int key = tid >> 3, ch = tid & 7; *(LAS u32x4*)(Kl + (slot * 64 + key) * KROWB + ch * 16) = *(const u32x4*)(Kg + (size_t)(wrow * 64 + key) * DM + ch * 8); }
                { const int d = tid >> 3, ch = tid & 7; *(LAS u32x4*)(Vl + d * VP512 + (slot * 64) * 2 + ch * 16) = *(const u32x4*)(Vg + (size_t)d * SEQ_S + wrow * 64 + ch * 8); }
                __syncthreads();
            }
            const size_t qrow = (size_t)MP + (size_t)b * SEQ_S + r * 64 + jb * 16;
            const bf16_t* qp = Q + (qrow + i) * DM + h * HD + 8 * q;
            const bf16x8 qf0 = *(const bf16x8*)qp, qf1 = *(const bf16x8*)(qp + 32);
            m_run[k] = -1e30f; l_run[k] = 0.f;
#pragma unroll
            for (int dt = 0; dt < 4; ++dt) o[k][dt] = (f32x4){0.f, 0.f, 0.f, 0.f};
            attn_chunk_lds<true, true>(Kl, Vl, VP512, kb0, r0 + 4 * half, qf0, qf1, m_run[k], l_run[k], o[k], rpb_h, r0 + 4 * half - r + 7, kb0, jb * 16 + i, lane);
        }
        __syncthreads();
        stage_k(Kc + (size_t)bh * PAST * HD, HD, 256, Kl, tid);
        stage_vt(Vtc + (size_t)bh * HD * PAST, PAST, 256, Vl, VP256, tid);
        __syncthreads();
#pragma unroll
        for (int k = 0; k < 4; ++k) {
            const int r = rfirst + k;
            const size_t qrow = (size_t)MP + (size_t)b * SEQ_S + r * 64 + jb * 16;
            const bf16_t* qp = Q + (qrow + i) * DM + h * HD + 8 * q;
            const bf16x8 qf0 = *(const bf16x8*)qp, qf1 = *(const bf16x8*)(qp + 32);
            attn_chunk_lds<false>(Kl, Vl, VP256, half * 128, 32, qf0, qf1, m_run[k], l_run[k], o[k], nullptr, 0, 0, 0, lane);
        }
#pragma unroll
        for (int rnd = 0; rnd < 2; ++rnd) {
            if (half == 1) {
#pragma unroll
                for (int kk = 0; kk < 2; ++kk) { const int k = 2 * rnd + kk; LAS float* sp = scr + (kk * 4 + jb) * 18 * 64 + lane;
                    sp[0] = m_run[k]; sp[64] = l_run[k];
#pragma unroll
                    for (int dt = 0; dt < 4; ++dt)
#pragma unroll
                        for (int j = 0; j < 4; ++j) sp[(2 + dt * 4 + j) * 64] = o[k][dt][j]; }
            }
            __syncthreads();
            if (half == 0) {
#pragma unroll
                for (int kk = 0; kk < 2; ++kk) { const int k = 2 * rnd + kk; const LAS float* sp = scr + (kk * 4 + jb) * 18 * 64 + lane;
                    const float m2 = sp[0], l2 = sp[64], mm = fmaxf(m_run[k], m2), a1 = __expf(m_run[k] - mm), a2 = __expf(m2 - mm);
                    const float inv = 1.0f / (l_run[k] * a1 + l2 * a2);
                    const size_t qrow = (size_t)MP + (size_t)b * SEQ_S + (rfirst + k) * 64 + jb * 16;
                    bf16_t* op = O + (qrow + i) * DM + h * HD + 4 * q;
#pragma unroll
                    for (int dt = 0; dt < 4; ++dt) { float v[4];
#pragma unroll
                        for (int j = 0; j < 4; ++j) v[j] = (o[k][dt][j] * a1 + sp[(2 + dt * 4 + j) * 64] * a2) * inv;
                        u32x2 w; w.x = cvt_pk_bf16(v[0], v[1]); w.y = cvt_pk_bf16(v[2], v[3]); *(u32x2*)(op + 16 * dt) = w; } }
            }
            __syncthreads();
        }
    }
    __syncthreads();
}

__device__ __forceinline__ void gate_fixup(const Args& a, int layer, int pm, int tid) {
    const float* SB = (const float*)(a.ws + WS_SB); bf16_t* A3 = (bf16_t*)(a.ws + WS_A3);
    const float* cw = a.in[18] + (size_t)layer * 3 * DFF; const float* cbias = a.in[19] + (size_t)layer * DFF;
    const int T = pm - 32, pos = T & 3;
    const float* sT = SB + (size_t)T * 6 * DFF;
    for (int c = tid; c < DFF; c += 512) {
        const float w0 = cw[c], w1 = cw[DFF + c], w2 = cw[2 * DFF + c], cb = cbias[c];
        if (pos > 0) { const float up = sT[c - 6 * DFF + 4 * DFF], uc = sT[c], dn = sT[DFF + c], g = sT[2 * DFF + c];
            A3[(size_t)(pm * 256) * DFF + c] = f2bf(pg8::gelu_tanh_f(w0 * up + w1 * uc + w2 * dn + cb) * g); }
        if (pos < 3) { const float up = sT[3 * DFF + c], uc = sT[4 * DFF + c], dn = sT[6 * DFF + c], g = sT[5 * DFF + c];
            A3[(size_t)(pm * 256 + 255) * DFF + c] = f2bf(pg8::gelu_tanh_f(w0 * up + w1 * uc + w2 * dn + cb) * g); }
    }
    asm volatile("s_waitcnt vmcnt(0)" ::: "memory");
    __syncthreads();
}

#define XB_TMO      128
#define XB_XCNT(j)  (256  + 64 * (j))
#define XB_XSUB(j)  (1280 + 64 * (j))
#define XB_XGEN(j)  (2304 + 64 * (j))
#define XB_TOP      3328
#define XB_TOPGEN   3392
#define XCD_BAR_WORDS 3456
#define XB_SPIN_CAP (1u << 22)
__device__ __forceinline__ unsigned xb_ld(unsigned* p)              { return __hip_atomic_load(p, __ATOMIC_RELAXED, __HIP_MEMORY_SCOPE_AGENT); }
__device__ __forceinline__ unsigned xb_add(unsigned* p, unsigned v) { return __hip_atomic_fetch_add(p, v, __ATOMIC_RELAXED, __HIP_MEMORY_SCOPE_AGENT); }
__device__ __forceinline__ unsigned xb_xcc_id() { return (unsigned)__builtin_amdgcn_s_getreg((3 << 11) | 20) & 0xFu; }
#define XB_SPIN(cond, bar) do { unsigned _sp = 0; while (cond) { __builtin_amdgcn_s_sleep(1); \
    if ((++_sp & 255u) == 0u) { if (xb_ld(&(bar)[XB_TMO])) break; if (_sp > XB_SPIN_CAP) { atomicAdd(&(bar)[XB_TMO], 1u); break; } } } } while (0)
struct XcdBarrier { unsigned* bar; unsigned x; volatile LAS unsigned* st; };
__device__ __forceinline__ void xcd_barrier_complete(unsigned* bar, unsigned x, unsigned G, unsigned& nloc, unsigned& nx) {
    unsigned sum, cnt, mine, sp = 0u;
    for (;;) {
        sum = 0u; cnt = 0u; mine = 0u;
#pragma unroll
        for (unsigned j = 0; j < 16; ++j) { const unsigned c = xb_ld(&bar[XB_XCNT(j)]); sum += c; cnt += (c > 0u) ? 1u : 0u; mine = (j == x) ? c : mine; }
        if (sum == G) break;
        __builtin_amdgcn_s_sleep(1);
        if ((++sp & 255u) == 0u) { if (xb_ld(&bar[XB_TMO])) break; if (sp > XB_SPIN_CAP) { atomicAdd(&bar[XB_TMO], 1u); break; } }
    }
    nloc = mine > 0u ? mine : 1u; nx = cnt > 0u ? cnt : 1u;
}
__device__ __forceinline__ void xcd_barrier(const XcdBarrier& b, int tid, unsigned G) {
    asm volatile("s_waitcnt vmcnt(0)" ::: "memory");
    __syncthreads();
    if (tid == 0) {
        unsigned* bar = b.bar;
        __builtin_amdgcn_s_waitcnt(0);
        unsigned nloc = b.st[0], nx = b.st[1];
        if (nloc == 0u) { xcd_barrier_complete(bar, b.x, G, nloc, nx); b.st[0] = nloc; b.st[1] = nx; }
        const unsigned old = xb_add(&bar[XB_XSUB(b.x)], 1u);
        const unsigned gen = old / nloc;
        if (old + 1u == (gen + 1u) * nloc) {
            __builtin_amdgcn_fence(__ATOMIC_RELEASE, "agent");
            asm volatile("s_waitcnt vmcnt(0)" ::: "memory");
            const unsigned og = xb_add(&bar[XB_TOP], 1u);
            const unsigned tg = og / nx;
            if (og + 1u == (tg + 1u) * nx) xb_add(&bar[XB_TOPGEN], 1u);
            else XB_SPIN(xb_ld(&bar[XB_TOPGEN]) == tg, bar);
            __builtin_amdgcn_fence(__ATOMIC_ACQUIRE, "agent");
            xb_add(&bar[XB_XGEN(b.x)], 1u);
            asm volatile("s_waitcnt vmcnt(0)" ::: "memory");
        } else {
            XB_SPIN(xb_ld(&bar[XB_XGEN(b.x)]) == gen, bar);
            __builtin_amdgcn_fence(__ATOMIC_ACQUIRE, "agent");
            asm volatile("s_waitcnt vmcnt(0)" ::: "memory");
        }
    }
    __syncthreads();
}

__global__ void __launch_bounds__(512, 2) fwd_kernel(Args a) {
    extern __shared__ __attribute__((aligned(16))) unsigned char lds_raw[];
    LAS unsigned char* lds = (LAS unsigned char*)lds_raw;
    unsigned char* ws = a.ws;
    XcdBarrier xb; xb.bar = (unsigned*)(ws + WS_CTL); xb.x = xb_xcc_id(); xb.st = (volatile LAS unsigned*)(lds + LDS_BYTES - 64);
    if (threadIdx.x == 0) { xb.st[0] = 0u; xb.st[1] = 0u; if (a.ph_hi - a.ph_lo > 1) (void)xb_add(&xb.bar[XB_XCNT(xb.x)], 1u); }
    __syncthreads();
#ifndef PROBE_MASK
#define PROBE_MASK 0
#endif
    for (int ph = a.ph_lo; ph < a.ph_hi; ++ph) {
      if (ph == 5 || ph == 9 || ph == 13 || ph == 17 || ph == 7 || ph == 15) continue;
      if (ph == 1 && a.ph_lo == 0) continue;
      for (int rep = 0; rep < (((PROBE_MASK >> ph) & 1) ? 3 : 1); ++rep) {
        if (ph > a.ph_lo || rep > 0) { if (a.ph_hi > NPH + 1000) cg::this_grid().sync();
          xcd_barrier(xb, threadIdx.x, gridDim.x); }
        int tid = threadIdx.x, bid = blockIdx.x, G = gridDim.x;
        asm volatile("" : "+v"(tid)); asm volatile("" : "+s"(bid)); asm volatile("" : "+s"(G));
        const int lane = tid & 63, wave = __builtin_amdgcn_readfirstlane(tid >> 6);
        if (ph == 0) {
#ifndef DIS_P0
 prologue(a, lds, tid, wave, lane, bid, G);
            if (a.ph_hi > 1) {
                if (tid == 0) { unsigned sp = 0; unsigned* mc = (unsigned*)(ws + WS_CTL) + CW_MODCNT;
                    while (__hip_atomic_load(mc, __ATOMIC_RELAXED, __HIP_MEMORY_SCOPE_AGENT) < 2u * (DM / 32)) { __builtin_amdgcn_s_sleep(2); if (++sp > (1u << 22)) break; }
                    __builtin_amdgcn_fence(__ATOMIC_ACQUIRE, "agent"); asm volatile("s_waitcnt vmcnt(0)" ::: "memory"); }
                __syncthreads();
                norm_phase(a, 1, wave, lane, bid, G);
            }
#endif
 }
        else if (ph == 1 || ph == 5 || ph == 9 || ph == 13 || ph == 17) {
#ifndef DIS_NORM
 norm_phase(a, ph, wave, lane, bid, G);
#endif
 }
        else if (ph == 3) {
#ifndef DIS_CONV
 convgate_phase(a, tid, bid, G);
#endif
 }
        else if (ph == 11) {
#ifndef DIS_ATTN
 attn_phase(a, lds, tid, wave, lane, bid, G);
#endif
 }
        else if (ph == 2) {
            pg8::Gemm g{(const bf16_t*)(ws + WS_H), (const bf16_t*)(ws + WS_WIN), MT, 3 * DM, DM}; pg8::EpiBf16 E{(bf16_t*)(ws + WS_BCX), 3 * DM};
            pg8::StaticOrder S; S.init(g.M, g.N, G, bid);
            pg8::gemm_phase<pg8::EpiBf16, pg8::StaticOrder>(lds, g, S, E, tid);
        }
        else if (ph == 6 || ph == 14) {
            const int l = ph == 14 ? 1 : 0;
            pg8::Gemm g{(const bf16_t*)(ws + WS_H), (const bf16_t*)(ws + WS_WUP) + (size_t)l * DM * 2 * DFF, MT, 2 * DFF, DM};
            pg8::EpiGate E{(bf16_t*)(ws + WS_A3), a.in[18] + (size_t)l * 3 * DFF, a.in[19] + (size_t)l * DFF, (float*)(ws + WS_SB)};
            pg8::StaticOrder S; S.init(g.M, g.N, G, bid);
            pg8::gemm_phase<pg8::EpiGate, pg8::StaticOrder>(lds, g, S, E, tid);
        }
        else if (ph == 10) {
            pg8::Gemm g{(const bf16_t*)(ws + WS_HB), (const bf16_t*)(ws + WS_WQKV), MT, 3 * DM, DM};
            float* sk = a.out + (size_t)MT * DM; float* sv = sk + (size_t)NB_P * NH * SEQ_P * HD;
            pg8::EpiQKV E{(bf16_t*)(ws + WS_Q), (bf16_t*)(ws + WS_K), (bf16_t*)(ws + WS_VT), sk, sv};
            pg8::StaticOrder S; S.init(g.M, g.N, G, bid);
#ifndef DIS_G2
            pg8::gemm_phase<pg8::EpiQKV, pg8::StaticOrder>(lds, g, S, E, tid);
#endif
        }
        else {
            pg8::Gemm g; pg8::EpiResNorm E;
            const float* MOD0 = (const float*)(ws + WS_MOD); const float* MOD1 = MOD0 + (size_t)NCV * MODW;
            float* X = a.out; float* XS = a.out + (size_t)MP * DM;
            float* xch = (float*)(ws + WS_XCH); unsigned* cnt = (unsigned*)(ws + WS_CTL) + CW_CNT;
            bf16_t* HA = (bf16_t*)(ws + WS_H); bf16_t* HB = (bf16_t*)(ws + WS_HB);
            if (ph == 4) { g = pg8::Gemm{(const bf16_t*)(ws + WS_A2), (const bf16_t*)(ws + WS_WOUT), MT, DM, DM};
                E = pg8::EpiResNorm{a.in[0], a.in[1], X, MOD0 + 2 * DM, HA, a.in[9], MOD0 + 3 * DM, MOD0 + 4 * DM, xch, cnt, 0}; }
            else if (ph == 8) { g = pg8::Gemm{(const bf16_t*)(ws + WS_A3), (const bf16_t*)(ws + WS_WDN), MT, DM, DFF};
                E = pg8::EpiResNorm{X, XS, X, MOD0 + 5 * DM, HB, a.in[8] + DM, MOD1, MOD1 + DM, xch + (size_t)MT * 4, cnt + 48 * 16, 0}; }
            else if (ph == 12) { g = pg8::Gemm{(const bf16_t*)(ws + WS_A2), (const bf16_t*)(ws + WS_WO), MT, DM, DM};
                E = pg8::EpiResNorm{X, XS, X, MOD1 + 2 * DM, HA, a.in[9] + DM, MOD1 + 3 * DM, MOD1 + 4 * DM, xch + (size_t)2 * MT * 4, cnt + 2 * 48 * 16, 0}; }
            else { g = pg8::Gemm{(const bf16_t*)(ws + WS_A3), (const bf16_t*)(ws + WS_WDN) + (size_t)DM * DFF, MT, DM, DFF};
                E = pg8::EpiResNorm{X, XS, X, MOD1 + 5 * DM, HA, a.in[21], MOD1, MOD1, xch + (size_t)3 * MT * 4, cnt + 3 * 48 * 16, 1}; }
            pg8::StaticOrder S; S.init(g.M, g.N, G, bid);
            if (ph != 16 && bid >= 192) {
                const int nidle = G - 192; constexpr int TI_A = TI_R1 + 640, TI_B = TI_R2 - I_DN;
                if (ph == 4) transpose_items(a, lds, TI_R0, TI_A, (bid - 192) * 8 + wave, nidle * 8, wave, lane);
                else if (ph == 8) transpose_items(a, lds, TI_A, TI_B, (bid - 192) * 8 + wave, nidle * 8, wave, lane);
                else transpose_items(a, lds, TI_B, TI_R2, (bid - 192) * 8 + wave, nidle * 8, wave, lane);
            }
            if (ph == 8 || ph == 16) { pg8::Unit u0; if (S.next(0, u0) && u0.pm >= 32) gate_fixup(a, ph == 16 ? 1 : 0, u0.pm, tid); }
#ifndef DIS_G3
            pg8::gemm_phase<pg8::EpiResNorm, pg8::StaticOrder>(lds, g, S, E, tid);
#endif
        }
      }
    }
}

extern "C" void kernel_launch(void* const* d_in, const int* in_sizes, int n_in, void* d_out, int out_size, void* d_ws, size_t ws_size, hipStream_t stream) {
    static int grid = 0;
    if (grid == 0) {
        if (n_in != 22 || ws_size < WS_END) { fprintf(stderr, "kernel_launch: unexpected n_in %d / ws_size %zu\n", n_in, ws_size); grid = -1; return; }
        int dev = 0, cus = 0, per_cu = 0;
        hipGetDevice(&dev); hipDeviceGetAttribute(&cus, hipDeviceAttributeMultiprocessorCount, dev);
        if (hipFuncSetAttribute((const void*)fwd_kernel, hipFuncAttributeMaxDynamicSharedMemorySize, LDS_BYTES) != hipSuccess) { fprintf(stderr, "hipFuncSetAttribute failed\n"); grid = -1; return; }
        hipOccupancyMaxActiveBlocksPerMultiprocessor(&per_cu, (const void*)fwd_kernel, 512, LDS_BYTES);
        (void)hipGetLastError();
        if (per_cu < 1) { fprintf(stderr, "occupancy query says %d\n", per_cu); per_cu = 1; }
        grid = cus;
    }
    if (grid < 0) return;
    Args a{};
    for (int i = 0; i < 22; ++i) a.in[i] = (const float*)d_in[i];
    a.out = (float*)d_out; a.ws = (unsigned char*)d_ws;
    if (hipMemsetAsync((char*)d_ws + WS_CTL, 0, CTL_BYTES, stream) != hipSuccess) { fprintf(stderr, "memset failed\n"); return; }
#if MK_MULTI
    for (int ph = 0; ph < NPH; ++ph) { a.ph_lo = ph; a.ph_hi = ph + 1; hipLaunchKernelGGL(fwd_kernel, dim3(grid), dim3(512), LDS_BYTES, stream, a); }
#else
    a.ph_lo = 0; a.ph_hi = NPH;
    void* args[] = {&a};
    hipError_t e = hipLaunchCooperativeKernel((const void*)fwd_kernel, dim3(grid), dim3(512), args, LDS_BYTES, stream);
    if (e != hipSuccess) fprintf(stderr, "cooperative launch failed: %s (grid %d)\n", hipGetErrorString(e), grid);
#endif
}
```

```cpp
#include <hip/hip_runtime.h>
#include <hip/hip_cooperative_groups.h>
#include <cstdio>
#include <cstdint>
namespace cg = cooperative_groups;

#ifndef MK_MULTI
#define MK_MULTI 0
#endif

#define LAS __attribute__((address_space(3)))
typedef unsigned short bf16_t;
typedef short bf16x8 __attribute__((ext_vector_type(8)));
typedef float f32x4 __attribute__((ext_vector_type(4)));
typedef float f32x2 __attribute__((ext_vector_type(2)));
typedef unsigned u32x4 __attribute__((ext_vector_type(4)));
typedef unsigned u32x2 __attribute__((ext_vector_type(2)));

constexpr int DM = 1024, NB_P = 32, SEQ_P = 256, NB_S = 4, SEQ_S = 1024, PAST = 256;
constexpr int MP = NB_P * SEQ_P;
constexpr int MS = NB_S * SEQ_S;
constexpr int MT = MP + MS;
constexpr int NH = 16, HD = 64, DFF = 2816, NCV = 5, MODW = 6 * DM;
constexpr float EPS = 1e-6f;
constexpr int NPH = 18;

constexpr size_t MiB = 1u << 20;
constexpr size_t WS_WIN = 0, WS_WOUT = 6 * MiB, WS_WQKV = 8 * MiB, WS_WO = 14 * MiB, WS_WUP = 16 * MiB, WS_WDN = 38 * MiB;
constexpr size_t WS_MOD = 49 * MiB, WS_KC = 50 * MiB, WS_VTC = 52 * MiB;
constexpr size_t WS_A3 = 54 * MiB;
constexpr size_t WS_H = 120 * MiB, WS_HB = WS_H;
constexpr size_t WS_BCX = 144 * MiB, WS_A2 = 216 * MiB;
constexpr size_t WS_Q = 144 * MiB, WS_K = 168 * MiB, WS_VT = 192 * MiB;
constexpr size_t WS_CTL = 252 * MiB, CTL_BYTES = 32768;
constexpr size_t WS_XCH = 253 * MiB;
constexpr size_t WS_SB = 254 * MiB;
constexpr size_t WS_END = 256 * MiB;
constexpr int CW_MODCNT = 7900;
constexpr int CW_CNT = 4096;
constexpr int LDS_BYTES = 147456;

struct Args { const float* in[22]; float* out; unsigned char* ws; int ph_lo, ph_hi; };

__device__ __forceinline__ unsigned cvt_pk_bf16(float lo, float hi) { unsigned r; asm volatile("v_cvt_pk_bf16_f32 %0, %1, %2" : "=v"(r) : "v"(lo), "v"(hi)); return r; }
__device__ __forceinline__ float bf_lo(unsigned u) { return __uint_as_float(u << 16); }
__device__ __forceinline__ float bf_hi(unsigned u) { return __uint_as_float(u & 0xffff0000u); }
__device__ __forceinline__ unsigned short f2bf(float f) { return (unsigned short)(cvt_pk_bf16(f, 0.f) & 0xffffu); }

namespace pg8 {
constexpr int BM = 256, BK = 64, HALF = 128, HTB = HALF * BK * 2, STAGE_BYTES = 8 * HTB, NXCD = 8, WGM = 8;
__host__ __device__ __forceinline__ int lds_byte(int r, int c) { const int st = (r >> 4) * 2 + (c >> 5), rr = r & 15, cc = c & 31, ob = rr * 64 + cc * 2; return st * 1024 + (ob ^ (((ob >> 9) & 1) << 5)); }
__host__ __device__ __forceinline__ void stage_rc(int b, int& R, int& C) { const int st = b / 1024, sb = b % 1024, swz = sb ^ (((sb >> 9) & 1) << 5); R = (st >> 1) * 16 + swz / 64; C = (st & 1) * 32 + (swz % 64) / 2; }
__host__ __device__ __forceinline__ int perm32(int rho) { const int n = rho >> 4, i = rho & 15; return 8 * (i >> 2) + 4 * n + (i & 3); }

struct Unit { int pm, pn; };
struct Gemm { const bf16_t* A; const bf16_t* Bt; int M, N, K; };

struct StaticOrder {
    int nM, nN, nwg, G, c;
    __device__ void init(int M, int N, int G_, int c_) { nM = M / BM; nN = N / BM; nwg = nM * nN; G = G_; c = c_; }
    __device__ bool next(int i, Unit& u) const {
        const long L = (long)i * G + c; if (L >= nwg) return false;
        int wgid = (int)L; { const int q = nwg / NXCD, r = nwg % NXCD, xcd = wgid % NXCD, off = wgid / NXCD; wgid = (xcd < r ? xcd * (q + 1) : r * (q + 1) + (xcd - r) * q) + off; }
        const int nig = WGM * nN, gid = wgid / nig, fm = gid * WGM, gsz = (nM - fm) < WGM ? (nM - fm) : WGM;
        u.pm = fm + ((wgid % nig) % gsz); u.pn = (wgid % nig) / gsz; return true;
    }
};

struct EpiBf16 {
    static constexpr bool PERM = true, AFTER_DRAIN = false, NEEDS_LDS = false;
    bf16_t* O; int ldc;
    __device__ __forceinline__ void operator()(const f32x4 (&acc)[2][2][4][2], const Unit& u, int wr, int wc, int fr, int fq) const {
        const int row0 = u.pm * BM + wr * 64 + fr; const int col0 = u.pn * BM + wc * 32 + 8 * fq;
#pragma unroll
        for (int ai = 0; ai < 2; ++ai)
#pragma unroll
            for (int m = 0; m < 4; ++m) { bf16_t* rowp = O + (size_t)(row0 + ai * HALF + m * 16) * ldc + col0;
#pragma unroll
                for (int bj = 0; bj < 2; ++bj) { const f32x4 v0 = acc[ai][bj][m][0], v1 = acc[ai][bj][m][1];
                    u32x4 w; w.x = cvt_pk_bf16(v0[0], v0[1]); w.y = cvt_pk_bf16(v0[2], v0[3]); w.z = cvt_pk_bf16(v1[0], v1[1]); w.w = cvt_pk_bf16(v1[2], v1[3]);
                    *(u32x4*)(rowp + bj * HALF) = w; } }
    }
};

struct EpiRes {
    static constexpr bool PERM = false, AFTER_DRAIN = false, NEEDS_LDS = false;
    const float* base_p; const float* base_s; float* out; const float* gate;
    __device__ __forceinline__ void operator()(const f32x4 (&acc)[2][2][4][2], const Unit& u, int wr, int wc, int fr, int fq) const {
        const int cv = u.pm < 32 ? 0 : 1 + ((u.pm - 32) >> 2);
        const int col0 = u.pn * BM + wc * 32 + 4 * fq;
        const float* gp = gate + cv * MODW + col0;
        f32x4 gv[2][2];
#pragma unroll
        for (int bj = 0; bj < 2; ++bj)
#pragma unroll
            for (int n = 0; n < 2; ++n) gv[bj][n] = *(const f32x4*)(gp + bj * HALF + n * 16);
        const float* bb = u.pm < 32 ? base_p + (size_t)u.pm * BM * DM : base_s + (size_t)(u.pm - 32) * BM * DM;
        float* ob = out + (size_t)u.pm * BM * DM;
#pragma unroll
        for (int ai = 0; ai < 2; ++ai)
#pragma unroll
            for (int m = 0; m < 4; ++m) { const size_t off = (size_t)(ai * HALF + wr * 64 + m * 16 + fr) * DM + col0;
#pragma unroll
                for (int bj = 0; bj < 2; ++bj)
#pragma unroll
                    for (int n = 0; n < 2; ++n) { const f32x4 bs = *(const f32x4*)(bb + off + bj * HALF + n * 16);
                        *(f32x4*)(ob + off + bj * HALF + n * 16) = bs + gv[bj][n] * acc[ai][bj][m][n]; }
                asm volatile("" ::: "memory"); }
    }
};

struct EpiResNorm {
    static constexpr bool PERM = false, AFTER_DRAIN = true, NEEDS_LDS = false;
    const float* base_p; const float* base_s; float* out; const float* gate; bf16_t* H; const float* gn; const float* mod_sh; const float* mod_sc; float* xbuf; unsigned* cnt; int final_mode;
    __device__ __forceinline__ void fused(f32x4 (&acc)[2][2][4][2], const Unit& u, int wr, int wc, int fr, int fq, LAS unsigned char* lds, int wid, int lane) const {
        LAS float* P = (LAS float*)lds;
        LAS float* S = (LAS float*)(lds + 8192);
        const int cv = u.pm < 32 ? 0 : 1 + ((u.pm - 32) >> 2);
        const int col0 = u.pn * BM + wc * 32 + 4 * fq;
        const float* bb = u.pm < 32 ? base_p + (size_t)u.pm * BM * DM : base_s + (size_t)(u.pm - 32) * BM * DM;
        float* ob = out + (size_t)u.pm * BM * DM;
        {   const float* gp = gate + cv * MODW + col0;
            f32x4 gv[2][2];
#pragma unroll
            for (int bj = 0; bj < 2; ++bj)
#pragma unroll
                for (int n = 0; n < 2; ++n) gv[bj][n] = *(const f32x4*)(gp + bj * HALF + n * 16);
#pragma unroll
            for (int ai = 0; ai < 2; ++ai)
#pragma unroll
                for (int m = 0; m < 4; ++m) { const size_t off = (size_t)(ai * HALF + wr * 64 + m * 16 + fr) * DM + col0;
                    float ss = 0.f;
#pragma unroll
                    for (int bj = 0; bj < 2; ++bj)
#pragma unroll
                        for (int n = 0; n < 2; ++n) { const f32x4 bs = *(const f32x4*)(bb + off + bj * HALF + n * 16);
                            const f32x4 x = bs + gv[bj][n] * acc[ai][bj][m][n]; acc[ai][bj][m][n] = x;
                            if (!final_mode) *(f32x4*)(ob + off + bj * HALF + n * 16) = x;
                            ss += (x[0] * x[0] + x[1] * x[1]) + (x[2] * x[2] + x[3] * x[3]); }
                    ss += __shfl_xor(ss, 16); ss += __shfl_xor(ss, 32);
                    if (fq == 0) P[(ai * HALF + wr * 64 + m * 16 + fr) * 4 + wc] = ss;
                    asm volatile("" ::: "memory"); }
        }
        asm volatile("s_waitcnt lgkmcnt(0)" ::: "memory"); __builtin_amdgcn_s_barrier(); asm volatile("" ::: "memory");
        const int row = wid * 32 + (lane & 31);
        if (lane < 32) {
            const float tot = (P[row * 4 + 0] + P[row * 4 + 1]) + (P[row * 4 + 2] + P[row * 4 + 3]);
            __hip_atomic_store(xbuf + ((size_t)(u.pm * BM + row) * 4 + u.pn), tot, __ATOMIC_RELAXED, __HIP_MEMORY_SCOPE_AGENT);
        }
        asm volatile("s_waitcnt vmcnt(0)" ::: "memory");
        if (lane == 0) __hip_atomic_fetch_add(cnt + 16 * u.pm, 1u, __ATOMIC_RELAXED, __HIP_MEMORY_SCOPE_AGENT);
        if (wid == 0) {
            unsigned sp = 0;
            while ((unsigned)__builtin_amdgcn_readfirstlane(__hip_atomic_load(cnt + 16 * u.pm, __ATOMIC_RELAXED, __HIP_MEMORY_SCOPE_AGENT)) < 32u) { __builtin_amdgcn_s_sleep(2); if (++sp > (1u << 22)) break; }
            __builtin_amdgcn_fence(__ATOMIC_ACQUIRE, "agent");
        }
        asm volatile("s_waitcnt vmcnt(0) lgkmcnt(0)" ::: "memory"); __builtin_amdgcn_s_barrier(); asm volatile("" ::: "memory");
        if (lane < 32) {
            const float* slot = xbuf + (size_t)(u.pm * BM + row) * 4; float t = 0.f;
#pragma unroll
            for (int k = 0; k < 4; ++k) t += __hip_atomic_load(slot + k, __ATOMIC_RELAXED, __HIP_MEMORY_SCOPE_AGENT);
            S[row] = 1.0f / sqrtf(t * (1.0f / DM) + EPS);
        }
        asm volatile("s_waitcnt vmcnt(0) lgkmcnt(0)" ::: "memory"); __builtin_amdgcn_s_barrier(); asm volatile("" ::: "memory");
        f32x4 ga[2][2], gb[2][2];
#pragma unroll
        for (int bj = 0; bj < 2; ++bj)
#pragma unroll
            for (int n = 0; n < 2; ++n) { const int c = col0 + bj * HALF + n * 16; const f32x4 g4 = *(const f32x4*)(gn + c);
                if (final_mode) { ga[bj][n] = g4; gb[bj][n] = (f32x4){0.f, 0.f, 0.f, 0.f}; }
                else { const f32x4 sc = *(const f32x4*)(mod_sc + cv * MODW + c), sh = *(const f32x4*)(mod_sh + cv * MODW + c); ga[bj][n] = g4 * (1.0f + sc); gb[bj][n] = sh; } }
#pragma unroll
        for (int ai = 0; ai < 2; ++ai)
#pragma unroll
            for (int m = 0; m < 4; ++m) { const int r = ai * HALF + wr * 64 + m * 16 + fr; const float rstd = S[r]; const size_t off = (size_t)r * DM + col0;
#pragma unroll
                for (int bj = 0; bj < 2; ++bj)
#pragma unroll
                    for (int n = 0; n < 2; ++n) { const f32x4 h = (acc[ai][bj][m][n] * rstd) * ga[bj][n] + gb[bj][n];
                        if (final_mode) __builtin_nontemporal_store(h, (f32x4*)(ob + off + bj * HALF + n * 16));
                        else { u32x2 w; w.x = cvt_pk_bf16(h[0], h[1]); w.y = cvt_pk_bf16(h[2], h[3]); *(u32x2*)(H + (size_t)u.pm * BM * DM + off + bj * HALF + n * 16) = w; } }
            }
    }
};

__device__ __forceinline__ float gelu_tanh_f(float x) {
    const float t = x * x; const float p = __builtin_fmaf(t, -0.10294324f, -2.3022082f);
    return x * __builtin_amdgcn_rcpf(1.0f + __builtin_amdgcn_exp2f(p * x));
}
template <int CTRL> __device__ __forceinline__ float dppf(float oldv, float src) {
    return __int_as_float(__builtin_amdgcn_update_dpp(__float_as_int(oldv), __float_as_int(src), CTRL, 0xf, 0xf, false));
}
struct EpiGate {
    static constexpr bool PERM = true, AFTER_DRAIN = false, NEEDS_LDS = true;
    bf16_t* A3; const float* cw; const float* cbias; float* SB;
    __device__ __forceinline__ void operator()(f32x4 (&acc)[2][2][4][2], const Unit& u, int wr, int wc, int fr, int fq, LAS unsigned char* lds) const {
        LAS float* XU = (LAS float*)(lds + 131072);
        const int c8 = wc * 32 + 8 * fq, gc = u.pn * HALF + c8;
#ifndef NOXU
#pragma unroll
        for (int ai = 0; ai < 2; ++ai) { const int sidx = 2 * ai + wr;
            if (fr == 0)  { *(LAS f32x4*)(XU + (sidx * 2 + 0) * 128 + c8) = acc[ai][0][0][0]; *(LAS f32x4*)(XU + (sidx * 2 + 0) * 128 + c8 + 4) = acc[ai][0][0][1]; }
            if (fr == 15) { *(LAS f32x4*)(XU + (sidx * 2 + 1) * 128 + c8) = acc[ai][0][3][0]; *(LAS f32x4*)(XU + (sidx * 2 + 1) * 128 + c8 + 4) = acc[ai][0][3][1]; } }
#endif
        if (u.pm >= 32) {
            float* sb = SB + (size_t)(u.pm - 32) * 6 * DFF + gc;
            if (wr == 0 && fr < 2) { *(f32x4*)(sb + fr * DFF) = acc[0][0][0][0]; *(f32x4*)(sb + fr * DFF + 4) = acc[0][0][0][1];
                if (fr == 0) { *(f32x4*)(sb + 2 * DFF) = acc[0][1][0][0]; *(f32x4*)(sb + 2 * DFF + 4) = acc[0][1][0][1]; } }
            if (wr == 1 && fr >= 14) { *(f32x4*)(sb + (fr - 11) * DFF) = acc[1][0][3][0]; *(f32x4*)(sb + (fr - 11) * DFF + 4) = acc[1][0][3][1];
                if (fr == 15) { *(f32x4*)(sb + 5 * DFF) = acc[1][1][3][0]; *(f32x4*)(sb + 5 * DFF + 4) = acc[1][1][3][1]; } }
        }
        f32x4 w0[2], w1[2], w2[2], cb[2];
#pragma unroll
        for (int n = 0; n < 2; ++n) { w0[n] = *(const f32x4*)(cw + gc + 4 * n); w1[n] = *(const f32x4*)(cw + DFF + gc + 4 * n); w2[n] = *(const f32x4*)(cw + 2 * DFF + gc + 4 * n); cb[n] = *(const f32x4*)(cbias + gc + 4 * n); }
#ifndef NOXU
        asm volatile("s_waitcnt lgkmcnt(0)" ::: "memory"); __builtin_amdgcn_s_barrier(); asm volatile("" ::: "memory");
#endif
#pragma unroll
        for (int ai = 0; ai < 2; ++ai) { const int sidx = 2 * ai + wr;
            f32x4 top[2], bot[2];
#pragma unroll
            for (int n = 0; n < 2; ++n) {
#ifdef NOXU
                top[n] = (f32x4){0.f,0.f,0.f,0.f}; bot[n] = top[n];
#else
                top[n] = sidx > 0 ? *(const LAS f32x4*)(XU + ((sidx - 1) * 2 + 1) * 128 + c8 + 4 * n) : (f32x4){0.f, 0.f, 0.f, 0.f};
                bot[n] = sidx < 3 ? *(const LAS f32x4*)(XU + ((sidx + 1) * 2 + 0) * 128 + c8 + 4 * n) : (f32x4){0.f, 0.f, 0.f, 0.f};
#endif
            }
#pragma unroll
            for (int m = 0; m < 4; ++m) {
                u32x4 w;
#pragma unroll
                for (int n = 0; n < 2; ++n) { float ov[4];
#pragma unroll
                    for (int j = 0; j < 4; ++j) {
                        const float uc = acc[ai][0][m][n][j];
                        const float upo = m > 0 ? dppf<0x140>(0.f, acc[ai][0][m - 1][n][j]) : top[n][j];
                        const float up = dppf<0x111>(upo, uc);
                        const float dno = m < 3 ? dppf<0x140>(0.f, acc[ai][0][m + 1][n][j]) : bot[n][j];
                        const float dn = dppf<0x101>(dno, uc);
                        const float cv = __builtin_fmaf(w0[n][j], up, __builtin_fmaf(w1[n][j], uc, __builtin_fmaf(w2[n][j], dn, cb[n][j])));
                        ov[j] = gelu_tanh_f(cv) * acc[ai][1][m][n][j]; }
                    if (n == 0) { w.x = cvt_pk_bf16(ov[0], ov[1]); w.y = cvt_pk_bf16(ov[2], ov[3]); } else { w.z = cvt_pk_bf16(ov[0], ov[1]); w.w = cvt_pk_bf16(ov[2], ov[3]); } }
                *(u32x4*)(A3 + (size_t)(u.pm * BM + ai * HALF + wr * 64 + m * 16 + fr) * DFF + gc) = w;
            }
        }
#ifndef NOXU
        asm volatile("s_waitcnt lgkmcnt(0)" ::: "memory"); __builtin_amdgcn_s_barrier(); asm volatile("" ::: "memory");
#endif
    }
};

struct EpiQKV {
    static constexpr bool PERM = false, AFTER_DRAIN = false, NEEDS_LDS = false;
    bf16_t* Q; bf16_t* Kb; bf16_t* Vt; float* sk; float* sv;
    __device__ __forceinline__ void operator()(const f32x4 (&acc)[2][2][4][2], const Unit& u, int wr, int wc, int fr, int fq) const {
        const int which = u.pn >> 2; const int cb = (u.pn & 3) * BM + wc * 32 + 4 * fq;
        const bool prompt = u.pm < 32;
        const int bidx = prompt ? u.pm : ((u.pm - 32) >> 2);
        const int tbase = (prompt ? 0 : ((u.pm - 32) & 3) * 256) + wr * 64 + fr;
        const int T = prompt ? SEQ_P : SEQ_S;
#pragma unroll
        for (int ai = 0; ai < 2; ++ai)
#pragma unroll
            for (int m = 0; m < 4; ++m) {
                const int t = tbase + ai * HALF + m * 16; const size_t row = (size_t)u.pm * BM + ai * HALF + wr * 64 + m * 16 + fr;
#pragma unroll
                for (int bj = 0; bj < 2; ++bj)
#pragma unroll
                    for (int n = 0; n < 2; ++n) { const int c = cb + bj * HALF + n * 16; const f32x4 v = acc[ai][bj][m][n];
                        if (which == 0) { u32x2 w; w.x = cvt_pk_bf16(v[0] * 0.125f, v[1] * 0.125f); w.y = cvt_pk_bf16(v[2] * 0.125f, v[3] * 0.125f); *(u32x2*)(Q + row * DM + c) = w; }
                        else if (which == 1) { u32x2 w; w.x = cvt_pk_bf16(v[0], v[1]); w.y = cvt_pk_bf16(v[2], v[3]); *(u32x2*)(Kb + row * DM + c) = w;
                            if (prompt) __builtin_nontemporal_store(v, (f32x4*)(sk + ((size_t)(bidx * NH + (c >> 6)) * SEQ_P + t) * HD + (c & 63))); }
                        else { const int h = c >> 6, d = c & 63;
                            if (prompt) __builtin_nontemporal_store(v, (f32x4*)(sv + ((size_t)(bidx * NH + h) * SEQ_P + t) * HD + d));
                            bf16_t* vp = Vt + (prompt ? 0 : (size_t)MP * DM) + ((size_t)(bidx * NH + h) * HD + d) * T + t;
                            vp[0] = f2bf(v[0]); vp[T] = f2bf(v[1]); vp[2 * T] = f2bf(v[2]); vp[3 * T] = f2bf(v[3]); }
                    }
            }
    }
};

template <class Epi, class Sched>
__device__ __forceinline__ void gemm_phase(LAS unsigned char* lds, const Gemm g, const Sched& S, const Epi& E, const int tid) {
    const int wid = __builtin_amdgcn_readfirstlane(tid >> 6), lane = tid & 63, wr = wid >> 2, wc = wid & 3, fr = lane & 15, fq = lane >> 4;
    const int K = g.K, nt = K / BK;
    unsigned voffA[2], voffB[2];
#pragma unroll
    for (int i = 0; i < 2; ++i) { int R, C; stage_rc(tid * 16 + i * 8192, R, C); const int Rb = Epi::PERM ? ((R & ~31) + perm32(R & 31)) : R;
        voffA[i] = (unsigned)(R * K + C) * 2u; voffB[i] = (unsigned)(Rb * K + C) * 2u; }
    const size_t kstep = (size_t)(BK * 2);
    const size_t hstep = (size_t)HALF * K * 2;
    const size_t tstep = 2 * hstep;
    const unsigned ldsw = (unsigned)wid * 1024u;
    const int aoff = lds_byte(wr * 64 + fr, fq * 8), boff = lds_byte(wc * 32 + fr, fq * 8);
#define PG8_SA(b, h) (((b) * 2 + (h)) * HTB)
#define PG8_SB(b, h) ((4 + (b) * 2 + (h)) * HTB)
#define PG8_STAGE(bufoff, gbase, voff) do { _Pragma("unroll") for (int _i = 0; _i < 2; ++_i) \
        __builtin_amdgcn_global_load_lds((const unsigned*)((const char*)(gbase) + (voff)[_i]), (LAS unsigned*)(lds + (bufoff) + ldsw + _i * 8192), 16, 0, 0); } while (0)
#define PG8_LDA(dst, b, h) do { _Pragma("unroll") for (int m = 0; m < 4; ++m) _Pragma("unroll") for (int k = 0; k < 2; ++k) dst[m][k] = *(const LAS bf16x8*)(lds + PG8_SA(b, h) + aoff + m * 2048 + k * 1024); } while (0)
#define PG8_LDB(dst, b, h) do { _Pragma("unroll") for (int n = 0; n < 2; ++n) _Pragma("unroll") for (int k = 0; k < 2; ++k) dst[n][k] = *(const LAS bf16x8*)(lds + PG8_SB(b, h) + boff + n * 2048 + k * 1024); } while (0)
#define PG8_MMA(ai, bj, At, Bt) do { __builtin_amdgcn_s_setprio(1); _Pragma("unroll") for (int m = 0; m < 4; ++m) _Pragma("unroll") for (int n = 0; n < 2; ++n) _Pragma("unroll") for (int k = 0; k < 2; ++k) \
        acc[ai][bj][m][n] = __builtin_amdgcn_mfma_f32_16x16x32_bf16(Bt[n][k], At[m][k], acc[ai][bj][m][n], 0, 0, 0); __builtin_amdgcn_s_setprio(0); } while (0)
#define PG8_WAIT_V(n) asm volatile("s_waitcnt vmcnt(" #n ")" ::: "memory")
#define PG8_WAIT_L(n) asm volatile("s_waitcnt lgkmcnt(" #n ")" ::: "memory")
#define PG8_BAR __builtin_amdgcn_s_barrier()
#define PG8_SCHED __builtin_amdgcn_sched_barrier(0)
    Unit cur, nxt; int ui = 0;
    if (!S.next(0, cur)) return;
    f32x4 acc[2][2][4][2];
#pragma unroll
    for (int a = 0; a < 2; ++a)
#pragma unroll
        for (int b = 0; b < 2; ++b)
#pragma unroll
            for (int m = 0; m < 4; ++m)
#pragma unroll
                for (int n = 0; n < 2; ++n) acc[a][b][m][n] = (f32x4){0.f, 0.f, 0.f, 0.f};
    bf16x8 At[4][2], B0[2][2], B1[2][2];
    const char* cA = (const char*)g.A + (size_t)cur.pm * tstep; const char* cB = (const char*)g.Bt + (size_t)cur.pn * tstep;
    PG8_STAGE(PG8_SB(0, 0), cB, voffB); PG8_STAGE(PG8_SB(0, 1), cB + hstep, voffB); PG8_STAGE(PG8_SA(0, 0), cA, voffA); PG8_STAGE(PG8_SA(0, 1), cA + hstep, voffA);
    if (wr == 1) PG8_BAR;
    PG8_WAIT_V(2); PG8_BAR;
    PG8_STAGE(PG8_SB(1, 0), cB + kstep, voffB); PG8_STAGE(PG8_SA(1, 0), cA + kstep, voffA); PG8_STAGE(PG8_SB(1, 1), cB + hstep + kstep, voffB);
    PG8_WAIT_V(6); PG8_BAR;
    for (;;) {
        const bool has_next = S.next(ui + 1, nxt);
        const char* nA = has_next ? (const char*)g.A + (size_t)nxt.pm * tstep : cA; const char* nB = has_next ? (const char*)g.Bt + (size_t)nxt.pn * tstep : cB;
        for (int t = 0; t < nt; t += 2) {
            const bool last = (t == nt - 2);
            const char* a1 = cA + (size_t)(t + 1) * kstep;
            const char* a2 = last ? nA : cA + (size_t)(t + 2) * kstep; const char* b2 = last ? nB : cB + (size_t)(t + 2) * kstep;
            const char* a3 = a2 + kstep; const char* b3 = b2 + kstep;
            PG8_LDB(B0, 0, 0); PG8_LDB(B1, 0, 1); PG8_SCHED; PG8_LDA(At, 0, 0); PG8_STAGE(PG8_SA(1, 1), a1 + hstep, voffA);
            PG8_WAIT_V(8); PG8_WAIT_L(0); PG8_BAR; PG8_MMA(0, 0, At, B0); PG8_MMA(0, 1, At, B1); PG8_BAR; PG8_SCHED;
            PG8_LDA(At, 0, 1); PG8_STAGE(PG8_SB(0, 0), b2, voffB); PG8_STAGE(PG8_SB(0, 1), b2 + hstep, voffB); PG8_STAGE(PG8_SA(0, 0), a2, voffA);
            PG8_WAIT_V(8); PG8_WAIT_L(0); PG8_BAR; PG8_MMA(1, 0, At, B0); PG8_MMA(1, 1, At, B1); PG8_BAR; PG8_SCHED;
            PG8_LDB(B0, 1, 0); PG8_LDB(B1, 1, 1); PG8_SCHED; PG8_LDA(At, 1, 0); PG8_STAGE(PG8_SA(0, 1), a2 + hstep, voffA);
            PG8_WAIT_V(8); PG8_WAIT_L(0); PG8_BAR; PG8_MMA(0, 0, At, B0); PG8_MMA(0, 1, At, B1); PG8_BAR; PG8_SCHED;
            PG8_LDA(At, 1, 1); PG8_STAGE(PG8_SB(1, 0), b3, voffB); PG8_STAGE(PG8_SB(1, 1), b3 + hstep, voffB); PG8_STAGE(PG8_SA(1, 0), a3, voffA);
            PG8_WAIT_V(8); PG8_WAIT_L(0); PG8_BAR; PG8_MMA(1, 0, At, B0); PG8_MMA(1, 1, At, B1); PG8_BAR; PG8_SCHED;
        }
        if (wr == 0) PG8_BAR;
        if constexpr (!Epi::AFTER_DRAIN) { if constexpr (Epi::NEEDS_LDS) E(acc, cur, wr, wc, fr, fq, lds); else E(acc, cur, wr, wc, fr, fq); }
        if (!has_next) break;
#pragma unroll
        for (int a = 0; a < 2; ++a)
#pragma unroll
            for (int b = 0; b < 2; ++b)
#pragma unroll
                for (int m = 0; m < 4; ++m)
#pragma unroll
                    for (int n = 0; n < 2; ++n) acc[a][b][m][n] = (f32x4){0.f, 0.f, 0.f, 0.f};
        cur = nxt; cA = nA; cB = nB; ++ui;
        if (wr == 1) PG8_BAR;
    }
    PG8_WAIT_V(0);
    PG8_BAR;
    if constexpr (Epi::AFTER_DRAIN) E.fused(acc, cur, wr, wc, fr, fq, lds, wid, lane);
#undef PG8_SA
#undef PG8_SB
#undef PG8_STAGE
#undef PG8_LDA
#undef PG8_LDB
#undef PG8_MMA
#undef PG8_WAIT_V
#undef PG8_WAIT_L
#undef PG8_BAR
#undef PG8_SCHED
}
}

__device__ __forceinline__ float wave_sum(float v) {
#pragma unroll
    for (int o = 1; o < 64; o <<= 1) v += __shfl_xor(v, o);
    return v;
}
#define LDS_WAIT() asm volatile("s_waitcnt lgkmcnt(0)" ::: "memory")

template <bool UPMAP = false>
__device__ __forceinline__ void p0_transpose_item(const float* W, int K, int N, bf16_t* WT, LAS float* scr, int item, int lane) {
    const int nblk = N / 32, kb = item / nblk, nb = item % nblk, k0 = 64 * kb, n0 = 32 * nb;
    int d0 = n0; if (UPMAP) { const int part = n0 >= DFF ? 1 : 0, cc = n0 - part * DFF; d0 = 256 * (cc >> 7) + 128 * part + (cc & 127); }
    {
        f32x4 v[8]; const int cq = 4 * (lane & 7), kr = lane >> 3;
#pragma unroll
        for (int i = 0; i < 8; ++i) v[i] = *(const f32x4*)(W + (size_t)(k0 + 8 * i + kr) * N + n0 + cq);
#pragma unroll
        for (int i = 0; i < 8; ++i) { LAS float* d = scr + (8 * i + kr) * 33 + cq; d[0] = v[i].x; d[1] = v[i].y; d[2] = v[i].z; d[3] = v[i].w; }
    }
    LDS_WAIT(); asm volatile("" ::: "memory");
    const int c = lane & 7;
#pragma unroll
    for (int j = 0; j < 4; ++j) { const int n = (lane >> 3) + 8 * j; const LAS float* s = scr + (8 * c) * 33 + n;
        u32x4 o; o.x = cvt_pk_bf16(s[0 * 33], s[1 * 33]); o.y = cvt_pk_bf16(s[2 * 33], s[3 * 33]); o.z = cvt_pk_bf16(s[4 * 33], s[5 * 33]); o.w = cvt_pk_bf16(s[6 * 33], s[7 * 33]);
        *(u32x4*)(WT + (size_t)(d0 + n) * K + k0 + 8 * c) = o; }
    LDS_WAIT(); asm volatile("" ::: "memory");
}

constexpr int I_IN = 16 * 96, I_OUT = 16 * 32, I_UP = 16 * 176, I_DN = 44 * 32;
constexpr int TI_R0 = I_IN + I_OUT + I_UP, TI_R1 = TI_R0 + I_DN, TI_R2 = TI_R1 + I_IN + I_OUT + I_UP + I_DN;
__device__ __forceinline__ void transpose_items(const Args& a, LAS unsigned char* lds, int lo, int hi, int worker, int nworkers, int wave, int lane) {
    unsigned char* ws = a.ws;
    LAS float* scr = (LAS float*)(lds + wave * 16384);
    for (int it = lo + worker; it < hi; it += nworkers) {
        int r = it;
        if (r < I_IN) { p0_transpose_item(a.in[10], DM, 3 * DM, (bf16_t*)(ws + WS_WIN), scr, r, lane); continue; } r -= I_IN;
        if (r < I_OUT) { p0_transpose_item(a.in[13], DM, DM, (bf16_t*)(ws + WS_WOUT), scr, r, lane); continue; } r -= I_OUT;
        if (r < I_UP) { p0_transpose_item<true>(a.in[17], DM, 2 * DFF, (bf16_t*)(ws + WS_WUP), scr, r, lane); continue; } r -= I_UP;
        if (r < I_DN) { p0_transpose_item(a.in[20], DFF, DM, (bf16_t*)(ws + WS_WDN), scr, r, lane); continue; } r -= I_DN;
        if (r < I_IN) { p0_transpose_item(a.in[14], DM, 3 * DM, (bf16_t*)(ws + WS_WQKV), scr, r, lane); continue; } r -= I_IN;
        if (r < I_OUT) { p0_transpose_item(a.in[16], DM, DM, (bf16_t*)(ws + WS_WO), scr, r, lane); continue; } r -= I_OUT;
        if (r < I_UP) { p0_transpose_item<true>(a.in[17] + (size_t)DM * 2 * DFF, DM, 2 * DFF, (bf16_t*)(ws + WS_WUP) + (size_t)DM * 2 * DFF, scr, r, lane); continue; } r -= I_UP;
        p0_transpose_item(a.in[20] + (size_t)DM * DFF, DFF, DM, (bf16_t*)(ws + WS_WDN) + (size_t)DM * DFF, scr, r, lane);
    }
}

__device__ __forceinline__ void prologue(const Args& a, LAS unsigned char* lds, int tid, int wave, int lane, int bid, int G) {
    unsigned char* ws = a.ws;
    float* MOD = (float*)(ws + WS_MOD);
    LAS float* sil = (LAS float*)lds;
    LAS float* red = (LAS float*)(lds + 5 * 1024 * 4);
    for (int i = tid; i < NCV * DM; i += 512) { const int cv = i >> 10, k = i & 1023; const float x = cv == 0 ? a.in[5][k] : a.in[4][(cv - 1) * DM + k]; sil[i] = x / (1.f + __expf(-x)); }
    __syncthreads();
    for (int item = bid; item < 2 * (MODW / 32); item += G) {
        const int l = item / (MODW / 32), col0 = (item % (MODW / 32)) * 32;
        const float* W = a.in[6] + (size_t)l * DM * MODW + col0 + 4 * (lane & 7);
        f32x4 acc[NCV];
#pragma unroll
        for (int cv = 0; cv < NCV; ++cv) acc[cv] = (f32x4){0.f, 0.f, 0.f, 0.f};
#pragma unroll 4
        for (int i = 0; i < 16; ++i) { const int k = 128 * wave + 8 * i + (lane >> 3); const f32x4 w = *(const f32x4*)(W + (size_t)k * MODW);
#pragma unroll
            for (int cv = 0; cv < NCV; ++cv) acc[cv] += sil[cv * DM + k] * w; }
#pragma unroll
        for (int cv = 0; cv < NCV; ++cv)
#pragma unroll
            for (int j = 0; j < 4; ++j) { float v = acc[cv][j]; v += __shfl_xor(v, 8); v += __shfl_xor(v, 16); v += __shfl_xor(v, 32); acc[cv][j] = v; }
        if (lane < 8) {
#pragma unroll
            for (int cv = 0; cv < NCV; ++cv)
#pragma unroll
                for (int j = 0; j < 4; ++j) red[(wave * NCV + cv) * 32 + 4 * lane + j] = acc[cv][j];
        }
        __syncthreads();
        if (tid < NCV * 32) { const int cv = tid >> 5, c = tid & 31; float s = 0.f;
#pragma unroll
            for (int w = 0; w < 8; ++w) s += red[(w * NCV + cv) * 32 + c];
            MOD[((size_t)l * NCV + cv) * MODW + col0 + c] = s + a.in[7][l * MODW + col0 + c]; }
        asm volatile("s_waitcnt vmcnt(0)" ::: "memory");
        __syncthreads();
        if (l == 0 && col0 < 2 * DM && tid == 0) {
            __builtin_amdgcn_fence(__ATOMIC_RELEASE, "agent");
            __hip_atomic_fetch_add((unsigned*)(ws + WS_CTL) + CW_MODCNT, 1u, __ATOMIC_RELAXED, __HIP_MEMORY_SCOPE_AGENT);
        }
    }
    __syncthreads();
    transpose_items(a, lds, 0, TI_R0, bid * 8 + wave, G * 8, wave, lane);
    const int gt = bid * 512 + tid, NGT = G * 512;
    bf16_t* Kc = (bf16_t*)(ws + WS_KC); bf16_t* Vtc = (bf16_t*)(ws + WS_VTC);
    for (int i = gt; i < NB_S * NH * PAST * HD; i += NGT) {
        Kc[i] = f2bf(a.in[2][i]);
        const int t = i & 255, d = (i >> 8) & 63, bh = i >> 14;
        Vtc[i] = f2bf(a.in[3][((size_t)bh * PAST + t) * HD + d]);
    }
}

__device__ __forceinline__ void norm_phase(const Args& a, int ph, int wave, int lane, int bid, int G) {
    const int gw = bid * 8 + wave, NGW = G * 8;
    const bool is_final = ph == 17, ffn = (ph == 5 || ph == 13); const int layer = ph >= 9 ? 1 : 0;
    const float* g = is_final ? a.in[21] : ((ffn ? a.in[9] : a.in[8]) + layer * DM);
    const float* mod = (const float*)(a.ws + WS_MOD) + (size_t)layer * NCV * MODW + (ffn ? 3 * DM : 0);
    bf16_t* H = (bf16_t*)(a.ws + WS_H);
    f32x4 gv[4];
#pragma unroll
    for (int j = 0; j < 4; ++j) gv[j] = *(const f32x4*)(g + 4 * lane + 256 * j);
    for (int row = gw; row < MT; row += NGW) {
        const float* xr = (ph == 1) ? (row < MP ? a.in[0] + (size_t)row * DM : a.in[1] + (size_t)(row - MP) * DM) : a.out + (size_t)row * DM;
        f32x4 v[4]; float s = 0.f;
#pragma unroll
        for (int j = 0; j < 4; ++j) { v[j] = *(const f32x4*)(xr + 4 * lane + 256 * j); s += (v[j].x * v[j].x + v[j].y * v[j].y) + (v[j].z * v[j].z + v[j].w * v[j].w); }
        const float rstd = 1.0f / sqrtf(wave_sum(s) * (1.f / DM) + EPS);
        if (is_final) {
#pragma unroll
            for (int j = 0; j < 4; ++j) *(f32x4*)(a.out + (size_t)row * DM + 4 * lane + 256 * j) = (v[j] * rstd) * gv[j];
        } else {
            const int cv = row < MP ? 0 : 1 + ((row - MP) >> 10);
            const float* mp = mod + (size_t)cv * MODW + 4 * lane;
#pragma unroll
            for (int j = 0; j < 4; ++j) { const f32x4 sh = *(const f32x4*)(mp + 256 * j), sc = *(const f32x4*)(mp + DM + 256 * j);
                const f32x4 h = ((v[j] * rstd) * gv[j]) * (1.0f + sc) + sh;
                u32x2 w; w.x = cvt_pk_bf16(h.x, h.y); w.y = cvt_pk_bf16(h.z, h.w);
                *(u32x2*)(H + (size_t)row * DM + 4 * lane + 256 * j) = w; }
        }
    }
}

struct F8 { float v[8]; };
__device__ __forceinline__ F8 ld8(const bf16_t* p) { const u32x4 w = *(const u32x4*)p; F8 r; r.v[0] = bf_lo(w.x); r.v[1] = bf_hi(w.x); r.v[2] = bf_lo(w.y); r.v[3] = bf_hi(w.y); r.v[4] = bf_lo(w.z); r.v[5] = bf_hi(w.z); r.v[6] = bf_lo(w.w); r.v[7] = bf_hi(w.w); return r; }
__device__ __forceinline__ F8 ldf8(const float* p) { const f32x4 a = *(const f32x4*)p, b = *(const f32x4*)(p + 4); F8 r; r.v[0] = a.x; r.v[1] = a.y; r.v[2] = a.z; r.v[3] = a.w; r.v[4] = b.x; r.v[5] = b.y; r.v[6] = b.z; r.v[7] = b.w; return r; }
__device__ __forceinline__ void st8(bf16_t* p, const F8& o) { u32x4 w; w.x = cvt_pk_bf16(o.v[0], o.v[1]); w.y = cvt_pk_bf16(o.v[2], o.v[3]); w.z = cvt_pk_bf16(o.v[4], o.v[5]); w.w = cvt_pk_bf16(o.v[6], o.v[7]); *(u32x4*)p = w; }
__device__ __forceinline__ F8 zero8() { F8 r;
#pragma unroll
    for (int e = 0; e < 8; ++e) r.v[e] = 0.f;
    return r; }

constexpr int RS = 8;
__device__ __forceinline__ F8 unpack8c(const u32x4 w) { F8 r; r.v[0] = bf_lo(w.x); r.v[1] = bf_hi(w.x); r.v[2] = bf_lo(w.y); r.v[3] = bf_hi(w.y); r.v[4] = bf_lo(w.z); r.v[5] = bf_hi(w.z); r.v[6] = bf_lo(w.w); r.v[7] = bf_hi(w.w); return r; }
__device__ __forceinline__ void convgate_phase(const Args& a, int tid, int bid, int G) {
    const bf16_t* BCX = (const bf16_t*)(a.ws + WS_BCX); bf16_t* A2 = (bf16_t*)(a.ws + WS_A2);
    const float* cw = a.in[11]; const float* cbias = a.in[12];
    constexpr int NITEM = (MT / RS) * (DM / 8); const int per = (NITEM + G - 1) / G;
    for (int j = tid; j < per; j += 512) {
        const int item = bid * per + j; if (item >= NITEM) break;
        const int strip = item >> 7, c = (item & 127) * 8, r0 = strip * RS;
        const int seqm = r0 < MP ? (SEQ_P - 1) : (SEQ_S - 1);
        const bool first = (r0 & seqm) == 0, last = ((r0 + RS) & seqm) == 0;
        const bf16_t* p = BCX + (size_t)r0 * (3 * DM) + c;
        u32x4 cr[RS + 2], xr[RS + 2], br[RS];
        const u32x4 z4 = (u32x4){0u, 0u, 0u, 0u};
        cr[0] = first ? z4 : *(const u32x4*)(p - 3 * DM + DM); xr[0] = first ? z4 : *(const u32x4*)(p - 3 * DM + 2 * DM);
#pragma unroll
        for (int i = 0; i < RS; ++i) { br[i] = *(const u32x4*)(p + (size_t)i * 3 * DM); cr[i + 1] = *(const u32x4*)(p + (size_t)i * 3 * DM + DM); xr[i + 1] = *(const u32x4*)(p + (size_t)i * 3 * DM + 2 * DM); }
        cr[RS + 1] = last ? z4 : *(const u32x4*)(p + (size_t)RS * 3 * DM + DM); xr[RS + 1] = last ? z4 : *(const u32x4*)(p + (size_t)RS * 3 * DM + 2 * DM);
        const F8 w0 = ldf8(cw + c), w1 = ldf8(cw + DM + c), w2 = ldf8(cw + 2 * DM + c), cb = ldf8(cbias + c);
        F8 prev, cur;
        { const F8 x = unpack8c(cr[0]), y = unpack8c(xr[0]);
#pragma unroll
            for (int e = 0; e < 8; ++e) prev.v[e] = x.v[e] * y.v[e]; }
        { const F8 x = unpack8c(cr[1]), y = unpack8c(xr[1]);
#pragma unroll
            for (int e = 0; e < 8; ++e) cur.v[e] = x.v[e] * y.v[e]; }
#pragma unroll
        for (int i = 0; i < RS; ++i) {
            F8 nxt; { const F8 x = unpack8c(cr[i + 2]), y = unpack8c(xr[i + 2]);
#pragma unroll
                for (int e = 0; e < 8; ++e) nxt.v[e] = x.v[e] * y.v[e]; }
            const F8 bg = unpack8c(br[i]); F8 o;
#pragma unroll
            for (int e = 0; e < 8; ++e) o.v[e] = bg.v[e] * (w0.v[e] * prev.v[e] + w1.v[e] * cur.v[e] + w2.v[e] * nxt.v[e] + cb.v[e]);
            st8(A2 + (size_t)(r0 + i) * DM + c, o);
            prev = cur; cur = nxt;
        }
    }
}
__device__ __forceinline__ float gelu_tanh(float x) {
    const float t = x * x; const float p = __builtin_fmaf(t, -0.10294324f, -2.3022082f);
    return x * __builtin_amdgcn_rcpf(1.0f + __builtin_amdgcn_exp2f(p * x));
}
__device__ __forceinline__ F8 unpack8(const u32x4 w) { F8 r; r.v[0] = bf_lo(w.x); r.v[1] = bf_hi(w.x); r.v[2] = bf_lo(w.y); r.v[3] = bf_hi(w.y); r.v[4] = bf_lo(w.z); r.v[5] = bf_hi(w.z); r.v[6] = bf_lo(w.w); r.v[7] = bf_hi(w.w); return r; }
template <bool BIAS>
__device__ __forceinline__ void attn_chunk(const bf16_t* Kp, int kpitch, const bf16_t* Vp, int vpitch, int tok0, int gstride,
                                           const bf16x8 qf0, const bf16x8 qf1, float& m_run, float& l_run, f32x4 (&o)[4],
                                           const float* rpb_h, int drow0, int kc0, int qc, int lane) {
    const int i = lane & 15, q = lane >> 4;
    f32x4 s[8];
#pragma unroll
    for (int kt = 0; kt < 8; ++kt) {
        const bf16_t* kp = Kp + (size_t)(tok0 + (kt >> 1) * gstride + (kt & 1) * 16 + i) * kpitch + 8 * q;
        const bf16x8 a0 = *(const bf16x8*)kp, a1 = *(const bf16x8*)(kp + 32);
        f32x4 z = (f32x4){0.f, 0.f, 0.f, 0.f};
        z = __builtin_amdgcn_mfma_f32_16x16x32_bf16(a0, qf0, z, 0, 0, 0);
        s[kt] = __builtin_amdgcn_mfma_f32_16x16x32_bf16(a1, qf1, z, 0, 0, 0);
    }
    if (BIAS) {
        const int cs = min(max(qc - 8, 0), 48);
#pragma unroll
        for (int kt = 0; kt < 8; ++kt) {
            const float* rp = rpb_h + ((kt >> 1) + drow0) * 31;
#pragma unroll
            for (int j = 0; j < 4; ++j) { const int kc = kc0 + (kt & 1) * 16 + 4 * q + j; const bool ok = (kc >= cs) && (kc < cs + 16);
                const int dc = min(max(kc - qc, -15), 15);
                s[kt][j] = ok ? s[kt][j] + rp[dc + 15] : -1e30f; }
        }
    }
    float mx = -1e30f;
#pragma unroll
    for (int kt = 0; kt < 8; ++kt) mx = fmaxf(mx, fmaxf(fmaxf(s[kt][0], s[kt][1]), fmaxf(s[kt][2], s[kt][3])));
    mx = fmaxf(mx, __shfl_xor(mx, 16)); mx = fmaxf(mx, __shfl_xor(mx, 32));
    const float m_new = fmaxf(m_run, mx), alpha = __expf(m_run - m_new);
    float ls = 0.f;
#pragma unroll
    for (int kt = 0; kt < 8; ++kt)
#pragma unroll
        for (int j = 0; j < 4; ++j) { const float p = __expf(s[kt][j] - m_new); s[kt][j] = p; ls += p; }
    ls += __shfl_xor(ls, 16); ls += __shfl_xor(ls, 32);
    l_run = l_run * alpha + ls; m_run = m_new;
#pragma unroll
    for (int dt = 0; dt < 4; ++dt) o[dt] = o[dt] * alpha;
#pragma unroll
    for (int g = 0; g < 4; ++g) {
        u32x4 pw; pw.x = cvt_pk_bf16(s[2 * g][0], s[2 * g][1]); pw.y = cvt_pk_bf16(s[2 * g][2], s[2 * g][3]);
        pw.z = cvt_pk_bf16(s[2 * g + 1][0], s[2 * g + 1][1]); pw.w = cvt_pk_bf16(s[2 * g + 1][2], s[2 * g + 1][3]);
        const bf16x8 pb = __builtin_bit_cast(bf16x8, pw);
#pragma unroll
        for (int dt = 0; dt < 4; ++dt) {
            const bf16_t* vp = Vp + (size_t)(16 * dt + i) * vpitch + tok0 + g * gstride + 4 * q;
            const u32x2 lo = *(const u32x2*)vp, hi = *(const u32x2*)(vp + 16);
            u32x4 vw; vw.x = lo.x; vw.y = lo.y; vw.z = hi.x; vw.w = hi.y;
            o[dt] = __builtin_amdgcn_mfma_f32_16x16x32_bf16(__builtin_bit_cast(bf16x8, vw), pb, o[dt], 0, 0, 0);
        }
    }
    asm volatile("" ::: "memory");
}

constexpr int KROWB = 144;
template <bool BIAS, bool RING = false>
__device__ __forceinline__ void attn_chunk_lds(const LAS unsigned char* Kl, const LAS unsigned char* Vl, int vpitchB, int tok0, int gstride,
                                               const bf16x8 qf0, const bf16x8 qf1, float& m_run, float& l_run, f32x4 (&o)[4],
                                               const float* rpb_h, int drow0, int kc0, int qc, int lane) {
    const int i = lane & 15, q = lane >> 4;
    f32x4 s[8];
#pragma unroll
    for (int kt = 0; kt < 8; ++kt) {
        const int tg = RING ? ((((gstride + (kt >> 1)) & 7) << 6) + tok0) : (tok0 + (kt >> 1) * gstride);
        const LAS unsigned char* kp = Kl + (tg + (kt & 1) * 16 + i) * KROWB + 16 * q;
        const bf16x8 a0 = *(const LAS bf16x8*)kp, a1 = *(const LAS bf16x8*)(kp + 64);
        f32x4 z = (f32x4){0.f, 0.f, 0.f, 0.f};
        z = __builtin_amdgcn_mfma_f32_16x16x32_bf16(a0, qf0, z, 0, 0, 0);
        s[kt] = __builtin_amdgcn_mfma_f32_16x16x32_bf16(a1, qf1, z, 0, 0, 0);
        if (kt & 1) asm volatile("" ::: "memory");
    }
    if (BIAS) {
        const int cs = min(max(qc - 8, 0), 48);
        int off[8]; bool ok[8];
#pragma unroll
        for (int ee = 0; ee < 8; ++ee) { const int kc = kc0 + (ee >> 2) * 16 + 4 * q + (ee & 3); ok[ee] = (unsigned)(kc - cs) < 16u; off[ee] = min(max(kc - qc + 15, 0), 30); }
#pragma unroll
        for (int g = 0; g < 4; ++g) {
            const float* rp = rpb_h + (g + drow0) * 31;
#pragma unroll
            for (int ee = 0; ee < 8; ++ee) { const float bv = rp[off[ee]]; const float sv = s[2 * g + (ee >> 2)][ee & 3]; s[2 * g + (ee >> 2)][ee & 3] = ok[ee] ? sv + bv : -1e30f; }
        }
    }
    float mx = -1e30f;
#pragma unroll
    for (int kt = 0; kt < 8; ++kt) mx = fmaxf(mx, fmaxf(fmaxf(s[kt][0], s[kt][1]), fmaxf(s[kt][2], s[kt][3])));
    mx = fmaxf(mx, __shfl_xor(mx, 16)); mx = fmaxf(mx, __shfl_xor(mx, 32));
    const float m_new = fmaxf(m_run, mx), alpha = __expf(m_run - m_new);
    float ls = 0.f;
#pragma unroll
    for (int kt = 0; kt < 8; ++kt)
#pragma unroll
        for (int j = 0; j < 4; ++j) { const float p = __expf(s[kt][j] - m_new); s[kt][j] = p; ls += p; }
    ls += __shfl_xor(ls, 16); ls += __shfl_xor(ls, 32);
    l_run = l_run * alpha + ls; m_run = m_new;
#pragma unroll
    for (int dt = 0; dt < 4; ++dt) o[dt] = o[dt] * alpha;
#pragma unroll
    for (int g = 0; g < 4; ++g) {
        u32x4 pw; pw.x = cvt_pk_bf16(s[2 * g][0], s[2 * g][1]); pw.y = cvt_pk_bf16(s[2 * g][2], s[2 * g][3]);
        pw.z = cvt_pk_bf16(s[2 * g + 1][0], s[2 * g + 1][1]); pw.w = cvt_pk_bf16(s[2 * g + 1][2], s[2 * g + 1][3]);
        const bf16x8 pb = __builtin_bit_cast(bf16x8, pw);
#pragma unroll
        for (int dt = 0; dt < 4; ++dt) {
            const int tgv = RING ? ((((gstride + g) & 7) << 6) + tok0) : (tok0 + g * gstride);
            const LAS unsigned char* vp = Vl + (16 * dt + i) * vpitchB + (tgv + 4 * q) * 2;
            const u32x2 lo = *(const LAS u32x2*)vp, hi = *(const LAS u32x2*)(vp + 32);
            u32x4 vw; vw.x = lo.x; vw.y = lo.y; vw.z = hi.x; vw.w = hi.y;
            o[dt] = __builtin_amdgcn_mfma_f32_16x16x32_bf16(__builtin_bit_cast(bf16x8, vw), pb, o[dt], 0, 0, 0);
        }
        asm volatile("" ::: "memory");
    }
}
__device__ __forceinline__ void attn_chunk_lds2(const LAS unsigned char* Kl, const LAS unsigned char* Vl, int vpitchB, int tok0, int gstride,
                                                const bf16x8 qa0, const bf16x8 qa1, const bf16x8 qb0, const bf16x8 qb1,
                                                float (&m_run)[2], float (&l_run)[2], f32x4 (&o)[2][4], int lane) {
    const int i = lane & 15, q = lane >> 4;
    f32x4 s[2][8];
#pragma unroll
    for (int kt = 0; kt < 8; ++kt) {
        const LAS unsigned char* kp = Kl + (tok0 + (kt >> 1) * gstride + (kt & 1) * 16 + i) * KROWB + 16 * q;
        const bf16x8 a0 = *(const LAS bf16x8*)kp, a1 = *(const LAS bf16x8*)(kp + 64);
        f32x4 za = (f32x4){0.f, 0.f, 0.f, 0.f}, zb = (f32x4){0.f, 0.f, 0.f, 0.f};
        za = __builtin_amdgcn_mfma_f32_16x16x32_bf16(a0, qa0, za, 0, 0, 0); zb = __builtin_amdgcn_mfma_f32_16x16x32_bf16(a0, qb0, zb, 0, 0, 0);
        s[0][kt] = __builtin_amdgcn_mfma_f32_16x16x32_bf16(a1, qa1, za, 0, 0, 0); s[1][kt] = __builtin_amdgcn_mfma_f32_16x16x32_bf16(a1, qb1, zb, 0, 0, 0);
        if (kt & 1) asm volatile("" ::: "memory");
    }
#pragma unroll
    for (int u = 0; u < 2; ++u) {
        float mx = -1e30f;
#pragma unroll
        for (int kt = 0; kt < 8; ++kt) mx = fmaxf(mx, fmaxf(fmaxf(s[u][kt][0], s[u][kt][1]), fmaxf(s[u][kt][2], s[u][kt][3])));
        mx = fmaxf(mx, __shfl_xor(mx, 16)); mx = fmaxf(mx, __shfl_xor(mx, 32));
        const float m_new = fmaxf(m_run[u], mx), alpha = __expf(m_run[u] - m_new);
        float ls = 0.f;
#pragma unroll
        for (int kt = 0; kt < 8; ++kt)
#pragma unroll
            for (int j = 0; j < 4; ++j) { const float p = __expf(s[u][kt][j] - m_new); s[u][kt][j] = p; ls += p; }
        ls += __shfl_xor(ls, 16); ls += __shfl_xor(ls, 32);
        l_run[u] = l_run[u] * alpha + ls; m_run[u] = m_new;
#pragma unroll
        for (int dt = 0; dt < 4; ++dt) o[u][dt] = o[u][dt] * alpha;
    }
#pragma unroll
    for (int g = 0; g < 4; ++g) {
        bf16x8 pb[2];
#pragma unroll
        for (int u = 0; u < 2; ++u) { u32x4 pw; pw.x = cvt_pk_bf16(s[u][2 * g][0], s[u][2 * g][1]); pw.y = cvt_pk_bf16(s[u][2 * g][2], s[u][2 * g][3]);
            pw.z = cvt_pk_bf16(s[u][2 * g + 1][0], s[u][2 * g + 1][1]); pw.w = cvt_pk_bf16(s[u][2 * g + 1][2], s[u][2 * g + 1][3]); pb[u] = __builtin_bit_cast(bf16x8, pw); }
#pragma unroll
        for (int dt = 0; dt < 4; ++dt) {
            const LAS unsigned char* vp = Vl + (16 * dt + i) * vpitchB + (tok0 + g * gstride + 4 * q) * 2;
            const u32x2 lo = *(const LAS u32x2*)vp, hi = *(const LAS u32x2*)(vp + 32);
            u32x4 vw; vw.x = lo.x; vw.y = lo.y; vw.z = hi.x; vw.w = hi.y;
            const bf16x8 va = __builtin_bit_cast(bf16x8, vw);
            o[0][dt] = __builtin_amdgcn_mfma_f32_16x16x32_bf16(va, pb[0], o[0][dt], 0, 0, 0);
            o[1][dt] = __builtin_amdgcn_mfma_f32_16x16x32_bf16(va, pb[1], o[1][dt], 0, 0, 0);
        }
        asm volatile("" ::: "memory");
    }
}
__device__ __forceinline__ void stage_k(const bf16_t* src, int pitch, int nkeys, LAS unsigned char* dst, int tid) {
    for (int idx = tid; idx < nkeys * 8; idx += 512) { const int row = idx >> 3, ch = idx & 7; const u32x4 v = *(const u32x4*)(src + (size_t)row * pitch + ch * 8); *(LAS u32x4*)(dst + row * KROWB + ch * 16) = v; }
}
__device__ __forceinline__ void stage_vt(const bf16_t* src, int pitch, int nkeys, LAS unsigned char* dst, int vpitchB, int tid) {
    const int nch = nkeys >> 3, sh = nkeys == 512 ? 6 : 5;
    for (int idx = tid; idx < 64 * nch; idx += 512) { const int d = idx >> sh, ch = idx & (nch - 1); const u32x4 v = *(const u32x4*)(src + (size_t)d * pitch + ch * 8); *(LAS u32x4*)(dst + d * vpitchB + ch * 16) = v; }
}

template <int NK> struct KVRegs { u32x4 k[NK / 64]; u32x4 v[NK / 64]; };
template <int NK> __device__ __forceinline__ void kv_load(KVRegs<NK>& R, const bf16_t* ksrc, int kpitch, const bf16_t* vsrc, int vpitch, int tid) {
    constexpr int NCH = NK / 8, SH = NK == 512 ? 6 : 5;
#pragma unroll
    for (int j = 0; j < NK / 64; ++j) { const int idx = tid + 512 * j; const int row = idx >> 3, ch = idx & 7; R.k[j] = *(const u32x4*)(ksrc + (size_t)row * kpitch + ch * 8);
        const int d = idx >> SH, c2 = idx & (NCH - 1); R.v[j] = *(const u32x4*)(vsrc + (size_t)d * vpitch + c2 * 8); }
}
template <int NK> __device__ __forceinline__ void kv_store(const KVRegs<NK>& R, LAS unsigned char* Kl, LAS unsigned char* Vl, int vpitchB, int tid) {
    constexpr int NCH = NK / 8, SH = NK == 512 ? 6 : 5;
#pragma unroll
    for (int j = 0; j < NK / 64; ++j) { const int idx = tid + 512 * j; const int row = idx >> 3, ch = idx & 7; *(LAS u32x4*)(Kl + row * KROWB + ch * 16) = R.k[j];
        const int d = idx >> SH, c2 = idx & (NCH - 1); *(LAS u32x4*)(Vl + d * vpitchB + c2 * 16) = R.v[j]; }
}

template <int NK> struct KRegs { u32x4 k[NK / 64]; };
template <int NK> __device__ __forceinline__ void k_load(KRegs<NK>& R, const bf16_t* ksrc, int kpitch, int tid) {
#pragma unroll
    for (int j = 0; j < NK / 64; ++j) { const int idx = tid + 512 * j; const int row = idx >> 3, ch = idx & 7; R.k[j] = *(const u32x4*)(ksrc + (size_t)row * kpitch + ch * 8); }
}
template <int NK> __device__ __forceinline__ void k_store(const KRegs<NK>& R, LAS unsigned char* Kl, int tid) {
#pragma unroll
    for (int j = 0; j < NK / 64; ++j) { const int idx = tid + 512 * j; const int row = idx >> 3, ch = idx & 7; *(LAS u32x4*)(Kl + row * KROWB + ch * 16) = R.k[j]; }
}
__device__ __forceinline__ void attn_phase(const Args& a, LAS unsigned char* lds, int tid, int wave, int lane, int bid, int G) {
    const bf16_t* Q = (const bf16_t*)(a.ws + WS_Q); const bf16_t* Kb = (const bf16_t*)(a.ws + WS_K); const bf16_t* Vt = (const bf16_t*)(a.ws + WS_VT);
    const bf16_t* Kc = (const bf16_t*)(a.ws + WS_KC); const bf16_t* Vtc = (const bf16_t*)(a.ws + WS_VTC);
    bf16_t* O = (bf16_t*)(a.ws + WS_A2);
    const int i = lane & 15, q = lane >> 4;
    LAS unsigned char* Kl = lds; LAS unsigned char* Vl = lds + 73728;
    LAS float* scr = (LAS float*)(lds + 36864);
    constexpr int VP256 = 528, VP512 = 1040;
    for (int bh = bid; bh < NB_P * NH; bh += G) {
        const int b = bh >> 4, h = bh & 15;
        __syncthreads();
        stage_k(Kb + (size_t)b * SEQ_P * DM + h * HD, DM, 256, Kl, tid);
        stage_vt(Vt + (size_t)bh * HD * SEQ_P, SEQ_P, 256, Vl, VP256, tid);
        __syncthreads();
        {
            const size_t qrow = (size_t)b * SEQ_P + wave * 32;
            const bf16_t* qp = Q + (qrow + i) * DM + h * HD + 8 * q;
            const bf16x8 qa0 = *(const bf16x8*)qp, qa1 = *(const bf16x8*)(qp + 32), qb0 = *(const bf16x8*)(qp + 16 * DM), qb1 = *(const bf16x8*)(qp + 16 * DM + 32);
            float m_run[2] = {-1e30f, -1e30f}, l_run[2] = {0.f, 0.f}; f32x4 o[2][4];
#pragma unroll
            for (int u = 0; u < 2; ++u)
#pragma unroll
                for (int dt = 0; dt < 4; ++dt) o[u][dt] = (f32x4){0.f, 0.f, 0.f, 0.f};
#pragma unroll 1
            for (int c = 0; c < 2; ++c) attn_chunk_lds2(Kl, Vl, VP256, c * 128, 32, qa0, qa1, qb0, qb1, m_run, l_run, o, lane);
#pragma unroll
            for (int u = 0; u < 2; ++u) { const float inv = 1.0f / l_run[u];
                bf16_t* op = O + (qrow + 16 * u + i) * DM + h * HD + 4 * q;
#pragma unroll
                for (int dt = 0; dt < 4; ++dt) { u32x2 w; w.x = cvt_pk_bf16(o[u][dt][0] * inv, o[u][dt][1] * inv); w.y = cvt_pk_bf16(o[u][dt][2] * inv, o[u][dt][3] * inv); *(u32x2*)(op + 16 * dt) = w; } }
        }
    }
    const int jb = wave & 3, half = wave >> 2;
    const int kb0 = min(max(jb * 16 - 8, 0), 32);
    for (int unit = bid; unit < NB_S * NH * 4; unit += G) {
        const int quad = unit & 3, bh = unit >> 2, b = bh >> 4, h = bh & 15;
        const float* rpb_h = a.in[15] + (size_t)h * 15 * 31;
        const bf16_t* Kg = Kb + ((size_t)MP + (size_t)b * SEQ_S) * DM + h * HD;
        const bf16_t* Vg = Vt + (size_t)MP * DM + (size_t)bh * HD * SEQ_S;
        float m_run[4], l_run[4]; f32x4 o[4][4];
        const int rfirst = 4 * quad, r0first = min(max(rfirst - 4, 0), 8);
        __syncthreads();
#pragma unroll
        for (int w8 = 0; w8 < 8; ++w8) { const int wrow = r0first + w8, slot = wrow & 7;
            { const int key = tid >> 3, ch = tid & 7; *(LAS u32x4*)(Kl + (slot * 64 + key) * KROWB + ch * 16) = *(const u32x4*)(Kg + (size_t)(wrow * 64 + key) * DM + ch * 8); }
            { const int d = tid >> 3, ch = tid & 7; *(LAS u32x4*)(Vl + d * VP512 + (slot * 64) * 2 + ch * 16) = *(const u32x4*)(Vg + (size_t)d * SEQ_S + wrow * 64 + ch * 8); } }
        __syncthreads();
#pragma unroll
        for (int k = 0; k < 4; ++k) {
            const int r = rfirst + k, r0 = min(max(r - 4, 0), 8);
            if (k > 0 && r0 != min(max(r - 5, 0), 8)) {
                __syncthreads();
                const int wrow = r0 + 7, slot = wrow & 7;
                { const int key = tid >> 3, ch = tid & 7; *(LAS u32x4*)(Kl + (slot * 64 + key) * KROWB + ch * 16) = *(const u32x4*)(Kg + (size_t)(wrow * 64 + key) * DM + ch * 8); }
                { const int d = tid >> 3, ch = tid & 7; *(LAS u32x4*)(Vl + d * VP512 + (slot * 64) * 2 + ch * 16) = *(const u32x4*)(Vg + (size_t)d * SEQ_S + wrow * 64 + ch * 8); }
                __syncthreads();
            }
            const size_t qrow = (size_t)MP + (size_t)b * SEQ_S + r * 64 + jb * 16;
            const bf16_t* qp = Q + (qrow + i) * DM + h * HD + 8 * q;
            const bf16x8 qf0 = *(const bf16x8*)qp, qf1 = *(const bf16x8*)(qp + 32);
            m_run[k] = -1e30f; l_run[k] = 0.f;
#pragma unroll
            for (int dt = 0; dt < 4; ++dt) o[k][dt] = (f32x4){0.f, 0.f, 0.f, 0.f};
            attn_chunk_lds<true, true>(Kl, Vl, VP512, kb0, r0 + 4 * half, qf0, qf1, m_run[k], l_run[k], o[k], rpb_h, r0 + 4 * half - r + 7, kb0, jb * 16 + i, lane);
        }
        __syncthreads();
        stage_k(Kc + (size_t)bh * PAST * HD, HD, 256, Kl, tid);
        stage_vt(Vtc + (size_t)bh * HD * PAST, PAST, 256, Vl, VP256, tid);
        __syncthreads();
#pragma unroll
        for (int k = 0; k < 4; ++k) {
            const int r = rfirst + k;
            const size_t qrow = (size_t)MP + (size_t)b * SEQ_S + r * 64 + jb * 16;
            const bf16_t* qp = Q + (qrow + i) * DM + h * HD + 8 * q;
            const bf16x8 qf0 = *(const bf16x8*)qp, qf1 = *(const bf16x8*)(qp + 32);
            attn_chunk_lds<false>(Kl, Vl, VP256, half * 128, 32, qf0, qf1, m_run[k], l_run[k], o[k], nullptr, 0, 0, 0, lane);
        }
#pragma unroll
        for (int rnd = 0; rnd < 2; ++rnd) {
            if (half == 1) {
#pragma unroll
                for (int kk = 0; kk < 2; ++kk) { const int k = 2 * rnd + kk; LAS float* sp = scr + (kk * 4 + jb) * 18 * 64 + lane;
                    sp[0] = m_run[k]; sp[64] = l_run[k];
#pragma unroll
                    for (int dt = 0; dt < 4; ++dt)
#pragma unroll
                        for (int j = 0; j < 4; ++j) sp[(2 + dt * 4 + j) * 64] = o[k][dt][j]; }
            }
            __syncthreads();
            if (half == 0) {
#pragma unroll
                for (int kk = 0; kk < 2; ++kk) { const int k = 2 * rnd + kk; const LAS float* sp = scr + (kk * 4 + jb) * 18 * 64 + lane;
                    const float m2 = sp[0], l2 = sp[64], mm = fmaxf(m_run[k], m2), a1 = __expf(m_run[k] - mm), a2 = __expf(m2 - mm);
                    const float inv = 1.0f / (l_run[k] * a1 + l2 * a2);
                    const size_t qrow = (size_t)MP + (size_t)b * SEQ_S + (rfirst + k) * 64 + jb * 16;
                    bf16_t* op = O + (qrow + i) * DM + h * HD + 4 * q;
#pragma unroll
                    for (int dt = 0; dt < 4; ++dt) { float v[4];
#pragma unroll
                        for (int j = 0; j < 4; ++j) v[j] = (o[k][dt][j] * a1 + sp[(2 + dt * 4 + j) * 64] * a2) * inv;
                        u32x2 w; w.x = cvt_pk_bf16(v[0], v[1]); w.y = cvt_pk_bf16(v[2], v[3]); *(u32x2*)(op + 16 * dt) = w; } }
            }
            __syncthreads();
        }
    }
    __syncthreads();
}

__device__ __forceinline__ void gate_fixup(const Args& a, int layer, int pm, int tid) {
    const float* SB = (const float*)(a.ws + WS_SB); bf16_t* A3 = (bf16_t*)(a.ws + WS_A3);
    const float* cw = a.in[18] + (size_t)layer * 3 * DFF; const float* cbias = a.in[19] + (size_t)layer * DFF;
    const int T = pm - 32, pos = T & 3;
    const float* sT = SB + (size_t)T * 6 * DFF;
    for (int c = tid; c < DFF; c += 512) {
        const float w0 = cw[c], w1 = cw[DFF + c], w2 = cw[2 * DFF + c], cb = cbias[c];
        if (pos > 0) { const float up = sT[c - 6 * DFF + 4 * DFF], uc = sT[c], dn = sT[DFF + c], g = sT[2 * DFF + c];
            A3[(size_t)(pm * 256) * DFF + c] = f2bf(pg8::gelu_tanh_f(w0 * up + w1 * uc + w2 * dn + cb) * g); }
        if (pos < 3) { const float up = sT[3 * DFF + c], uc = sT[4 * DFF + c], dn = sT[6 * DFF + c], g = sT[5 * DFF + c];
            A3[(size_t)(pm * 256 + 255) * DFF + c] = f2bf(pg8::gelu_tanh_f(w0 * up + w1 * uc + w2 * dn + cb) * g); }
    }
    asm volatile("s_waitcnt vmcnt(0)" ::: "memory");
    __syncthreads();
}

#define XB_TMO      128
#define XB_XCNT(j)  (256  + 64 * (j))
#define XB_XSUB(j)  (1280 + 64 * (j))
#define XB_XGEN(j)  (2304 + 64 * (j))
#define XB_TOP      3328
#define XB_TOPGEN   3392
#define XCD_BAR_WORDS 3456
#define XB_SPIN_CAP (1u << 22)
__device__ __forceinline__ unsigned xb_ld(unsigned* p)              { return __hip_atomic_load(p, __ATOMIC_RELAXED, __HIP_MEMORY_SCOPE_AGENT); }
__device__ __forceinline__ unsigned xb_add(unsigned* p, unsigned v) { return __hip_atomic_fetch_add(p, v, __ATOMIC_RELAXED, __HIP_MEMORY_SCOPE_AGENT); }
__device__ __forceinline__ unsigned xb_xcc_id() { return (unsigned)__builtin_amdgcn_s_getreg((3 << 11) | 20) & 0xFu; }
#define XB_SPIN(cond, bar) do { unsigned _sp = 0; while (cond) { __builtin_amdgcn_s_sleep(1); \
    if ((++_sp & 255u) == 0u) { if (xb_ld(&(bar)[XB_TMO])) break; if (_sp > XB_SPIN_CAP) { atomicAdd(&(bar)[XB_TMO], 1u); break; } } } } while (0)
struct XcdBarrier { unsigned* bar; unsigned x; volatile LAS unsigned* st; };
__device__ __forceinline__ void xcd_barrier_complete(unsigned* bar, unsigned x, unsigned G, unsigned& nloc, unsigned& nx) {
    unsigned sum, cnt, mine, sp = 0u;
    for (;;) {
        sum = 0u; cnt = 0u; mine = 0u;
#pragma unroll
        for (unsigned j = 0; j < 16; ++j) { const unsigned c = xb_ld(&bar[XB_XCNT(j)]); sum += c; cnt += (c > 0u) ? 1u : 0u; mine = (j == x) ? c : mine; }
        if (sum == G) break;
        __builtin_amdgcn_s_sleep(1);
        if ((++sp & 255u) == 0u) { if (xb_ld(&bar[XB_TMO])) break; if (sp > XB_SPIN_CAP) { atomicAdd(&bar[XB_TMO], 1u); break; } }
    }
    nloc = mine > 0u ? mine : 1u; nx = cnt > 0u ? cnt : 1u;
}
__device__ __forceinline__ void xcd_barrier(const XcdBarrier& b, int tid, unsigned G) {
    asm volatile("s_waitcnt vmcnt(0)" ::: "memory");
    __syncthreads();
    if (tid == 0) {
        unsigned* bar = b.bar;
        __builtin_amdgcn_s_waitcnt(0);
        unsigned nloc = b.st[0], nx = b.st[1];
        if (nloc == 0u) { xcd_barrier_complete(bar, b.x, G, nloc, nx); b.st[0] = nloc; b.st[1] = nx; }
        const unsigned old = xb_add(&bar[XB_XSUB(b.x)], 1u);
        const unsigned gen = old / nloc;
        if (old + 1u == (gen + 1u) * nloc) {
            __builtin_amdgcn_fence(__ATOMIC_RELEASE, "agent");
            asm volatile("s_waitcnt vmcnt(0)" ::: "memory");
            const unsigned og = xb_add(&bar[XB_TOP], 1u);
            const unsigned tg = og / nx;
            if (og + 1u == (tg + 1u) * nx) xb_add(&bar[XB_TOPGEN], 1u);
            else XB_SPIN(xb_ld(&bar[XB_TOPGEN]) == tg, bar);
            __builtin_amdgcn_fence(__ATOMIC_ACQUIRE, "agent");
            xb_add(&bar[XB_XGEN(b.x)], 1u);
            asm volatile("s_waitcnt vmcnt(0)" ::: "memory");
        } else {
            XB_SPIN(xb_ld(&bar[XB_XGEN(b.x)]) == gen, bar);
            __builtin_amdgcn_fence(__ATOMIC_ACQUIRE, "agent");
            asm volatile("s_waitcnt vmcnt(0)" ::: "memory");
        }
    }
    __syncthreads();
}

__global__ void __launch_bounds__(512, 2) fwd_kernel(Args a) {
    extern __shared__ __attribute__((aligned(16))) unsigned char lds_raw[];
    LAS unsigned char* lds = (LAS unsigned char*)lds_raw;
    unsigned char* ws = a.ws;
    XcdBarrier xb; xb.bar = (unsigned*)(ws + WS_CTL); xb.x = xb_xcc_id(); xb.st = (volatile LAS unsigned*)(lds + LDS_BYTES - 64);
    if (threadIdx.x == 0) { xb.st[0] = 0u; xb.st[1] = 0u; if (a.ph_hi - a.ph_lo > 1) (void)xb_add(&xb.bar[XB_XCNT(xb.x)], 1u); }
    __syncthreads();
#ifndef PROBE_MASK
#define PROBE_MASK 0
#endif
    for (int ph = a.ph_lo; ph < a.ph_hi; ++ph) {
      if (ph == 5 || ph == 9 || ph == 13 || ph == 17 || ph == 7 || ph == 15) continue;
      if (ph == 1 && a.ph_lo == 0) continue;
      for (int rep = 0; rep < (((PROBE_MASK >> ph) & 1) ? 3 : 1); ++rep) {
        if (ph > a.ph_lo || rep > 0) { if (a.ph_hi > NPH + 1000) cg::this_grid().sync();
          xcd_barrier(xb, threadIdx.x, gridDim.x); }
        int tid = threadIdx.x, bid = blockIdx.x, G = gridDim.x;
        asm volatile("" : "+v"(tid)); asm volatile("" : "+s"(bid)); asm volatile("" : "+s"(G));
        const int lane = tid & 63, wave = __builtin_amdgcn_readfirstlane(tid >> 6);
        if (ph == 0) {
#ifndef DIS_P0
 prologue(a, lds, tid, wave, lane, bid, G);
            if (a.ph_hi > 1) {
                if (tid == 0) { unsigned sp = 0; unsigned* mc = (unsigned*)(ws + WS_CTL) + CW_MODCNT;
                    while (__hip_atomic_load(mc, __ATOMIC_RELAXED, __HIP_MEMORY_SCOPE_AGENT) < 2u * (DM / 32)) { __builtin_amdgcn_s_sleep(2); if (++sp > (1u << 22)) break; }
                    __builtin_amdgcn_fence(__ATOMIC_ACQUIRE, "agent"); asm volatile("s_waitcnt vmcnt(0)" ::: "memory"); }
                __syncthreads();
                norm_phase(a, 1, wave, lane, bid, G);
            }
#endif
 }
        else if (ph == 1 || ph == 5 || ph == 9 || ph == 13 || ph == 17) {
#ifndef DIS_NORM
 norm_phase(a, ph, wave, lane, bid, G);
#endif
 }
        else if (ph == 3) {
#ifndef DIS_CONV
 convgate_phase(a, tid, bid, G);
#endif
 }
        else if (ph == 11) {
#ifndef DIS_ATTN
 attn_phase(a, lds, tid, wave, lane, bid, G);
#endif
 }
        else if (ph == 2) {
            pg8::Gemm g{(const bf16_t*)(ws + WS_H), (const bf16_t*)(ws + WS_WIN), MT, 3 * DM, DM}; pg8::EpiBf16 E{(bf16_t*)(ws + WS_BCX), 3 * DM};
            pg8::StaticOrder S; S.init(g.M, g.N, G, bid);
            pg8::gemm_phase<pg8::EpiBf16, pg8::StaticOrder>(lds, g, S, E, tid);
        }
        else if (ph == 6 || ph == 14) {
            const int l = ph == 14 ? 1 : 0;
            pg8::Gemm g{(const bf16_t*)(ws + WS_H), (const bf16_t*)(ws + WS_WUP) + (size_t)l * DM * 2 * DFF, MT, 2 * DFF, DM};
            pg8::EpiGate E{(bf16_t*)(ws + WS_A3), a.in[18] + (size_t)l * 3 * DFF, a.in[19] + (size_t)l * DFF, (float*)(ws + WS_SB)};
            pg8::StaticOrder S; S.init(g.M, g.N, G, bid);
            pg8::gemm_phase<pg8::EpiGate, pg8::StaticOrder>(lds, g, S, E, tid);
        }
        else if (ph == 10) {
            pg8::Gemm g{(const bf16_t*)(ws + WS_HB), (const bf16_t*)(ws + WS_WQKV), MT, 3 * DM, DM};
            float* sk = a.out + (size_t)MT * DM; float* sv = sk + (size_t)NB_P * NH * SEQ_P * HD;
            pg8::EpiQKV E{(bf16_t*)(ws + WS_Q), (bf16_t*)(ws + WS_K), (bf16_t*)(ws + WS_VT), sk, sv};
            pg8::StaticOrder S; S.init(g.M, g.N, G, bid);
#ifndef DIS_G2
            pg8::gemm_phase<pg8::EpiQKV, pg8::StaticOrder>(lds, g, S, E, tid);
#endif
        }
        else {
            pg8::Gemm g; pg8::EpiResNorm E;
            const float* MOD0 = (const float*)(ws + WS_MOD); const float* MOD1 = MOD0 + (size_t)NCV * MODW;
            float* X = a.out; float* XS = a.out + (size_t)MP * DM;
            float* xch = (float*)(ws + WS_XCH); unsigned* cnt = (unsigned*)(ws + WS_CTL) + CW_CNT;
            bf16_t* HA = (bf16_t*)(ws + WS_H); bf16_t* HB = (bf16_t*)(ws + WS_HB);
            if (ph == 4) { g = pg8::Gemm{(const bf16_t*)(ws + WS_A2), (const bf16_t*)(ws + WS_WOUT), MT, DM, DM};
                E = pg8::EpiResNorm{a.in[0], a.in[1], X, MOD0 + 2 * DM, HA, a.in[9], MOD0 + 3 * DM, MOD0 + 4 * DM, xch, cnt, 0}; }
            else if (ph == 8) { g = pg8::Gemm{(const bf16_t*)(ws + WS_A3), (const bf16_t*)(ws + WS_WDN), MT, DM, DFF};
                E = pg8::EpiResNorm{X, XS, X, MOD0 + 5 * DM, HB, a.in[8] + DM, MOD1, MOD1 + DM, xch + (size_t)MT * 4, cnt + 48 * 16, 0}; }
            else if (ph == 12) { g = pg8::Gemm{(const bf16_t*)(ws + WS_A2), (const bf16_t*)(ws + WS_WO), MT, DM, DM};
                E = pg8::EpiResNorm{X, XS, X, MOD1 + 2 * DM, HA, a.in[9] + DM, MOD1 + 3 * DM, MOD1 + 4 * DM, xch + (size_t)2 * MT * 4, cnt + 2 * 48 * 16, 0}; }
            else { g = pg8::Gemm{(const bf16_t*)(ws + WS_A3), (const bf16_t*)(ws + WS_WDN) + (size_t)DM * DFF, MT, DM, DFF};
                E = pg8::EpiResNorm{X, XS, X, MOD1 + 5 * DM, HA, a.in[21], MOD1, MOD1, xch + (size_t)3 * MT * 4, cnt + 3 * 48 * 16, 1}; }
            pg8::StaticOrder S; S.init(g.M, g.N, G, bid);
            if (ph != 16 && bid >= 192) {
                const int nidle = G - 192; constexpr int TI_A = TI_R1 + 640, TI_B = TI_R2 - I_DN;
                if (ph == 4) transpose_items(a, lds, TI_R0, TI_A, (bid - 192) * 8 + wave, nidle * 8, wave, lane);
                else if (ph == 8) transpose_items(a, lds, TI_A, TI_B, (bid - 192) * 8 + wave, nidle * 8, wave, lane);
                else transpose_items(a, lds, TI_B, TI_R2, (bid - 192) * 8 + wave, nidle * 8, wave, lane);
            }
            if (ph == 8 || ph == 16) { pg8::Unit u0; if (S.next(0, u0) && u0.pm >= 32) gate_fixup(a, ph == 16 ? 1 : 0, u0.pm, tid); }
#ifndef DIS_G3
            pg8::gemm_phase<pg8::EpiResNorm, pg8::StaticOrder>(lds, g, S, E, tid);
#endif
        }
      }
    }
}

extern "C" void kernel_launch(void* const* d_in, const int* in_sizes, int n_in, void* d_out, int out_size, void* d_ws, size_t ws_size, hipStream_t stream) {
    static int grid = 0;
    if (grid == 0) {
        if (n_in != 22 || ws_size < WS_END) { fprintf(stderr, "kernel_launch: unexpected n_in %d / ws_size %zu\n", n_in, ws_size); grid = -1; return; }
        int dev = 0, cus = 0, per_cu = 0;
        hipGetDevice(&dev); hipDeviceGetAttribute(&cus, hipDeviceAttributeMultiprocessorCount, dev);
        if (hipFuncSetAttribute((const void*)fwd_kernel, hipFuncAttributeMaxDynamicSharedMemorySize, LDS_BYTES) != hipSuccess) { fprintf(stderr, "hipFuncSetAttribute failed\n"); grid = -1; return; }
        hipOccupancyMaxActiveBlocksPerMultiprocessor(&per_cu, (const void*)fwd_kernel, 512, LDS_BYTES);
        (void)hipGetLastError();
        if (per_cu < 1) { fprintf(stderr, "occupancy query says %d\n", per_cu); per_cu = 1; }
        grid = cus;
    }
    if (grid < 0) return;
    Args a{};
    for (int i = 0; i < 22; ++i) a.in[i] = (const float*)d_in[i];
    a.out = (float*)d_out; a.ws = (unsigned char*)d_ws;
    if (hipMemsetAsync((char*)d_ws + WS_CTL, 0, CTL_BYTES, stream) != hipSuccess) { fprintf(stderr, "memset failed\n"); return; }
#if MK_MULTI
    for (int ph = 0; ph < NPH; ++ph) { a.ph_lo = ph; a.ph_hi = ph + 1; hipLaunchKernelGGL(fwd_kernel, dim3(grid), dim3(512), LDS_BYTES, stream, a); }
#else
    a.ph_lo = 0; a.ph_hi = NPH;
    void* args[] = {&a};
    hipError_t e = hipLaunchCooperativeKernel((const void*)fwd_kernel, dim3(grid), dim3(512), args, LDS_BYTES, stream);
    if (e != hipSuccess) fprintf(stderr, "cooperative launch failed: %s (grid %d)\n", hipGetErrorString(e), grid);
#endif
}
```

```cpp
#include <hip/hip_runtime.h>
#include <hip/hip_cooperative_groups.h>
#include <cstdio>
#include <cstdint>
namespace cg = cooperative_groups;

#ifndef MK_MULTI
#define MK_MULTI 0
#endif

#define LAS __attribute__((address_space(3)))
typedef unsigned short bf16_t;
typedef short bf16x8 __attribute__((ext_vector_type(8)));
typedef float f32x4 __attribute__((ext_vector_type(4)));
typedef float f32x2 __attribute__((ext_vector_type(2)));
typedef unsigned u32x4 __attribute__((ext_vector_type(4)));
typedef unsigned u32x2 __attribute__((ext_vector_type(2)));

constexpr int DM = 1024, NB_P = 32, SEQ_P = 256, NB_S = 4, SEQ_S = 1024, PAST = 256;
constexpr int MP = NB_P * SEQ_P;
constexpr int MS = NB_S * SEQ_S;
constexpr int MT = MP + MS;
constexpr int NH = 16, HD = 64, DFF = 2816, NCV = 5, MODW = 6 * DM;
constexpr float EPS = 1e-6f;
constexpr int NPH = 18;

constexpr size_t MiB = 1u << 20;
constexpr size_t WS_WIN = 0, WS_WOUT = 6 * MiB, WS_WQKV = 8 * MiB, WS_WO = 14 * MiB, WS_WUP = 16 * MiB, WS_WDN = 38 * MiB;
constexpr size_t WS_MOD = 49 * MiB, WS_KC = 50 * MiB, WS_VTC = 52 * MiB;
constexpr size_t WS_A3 = 54 * MiB;
constexpr size_t WS_H = 120 * MiB, WS_HB = WS_H;
constexpr size_t WS_BCX = 144 * MiB, WS_A2 = 216 * MiB;
constexpr size_t WS_Q = 144 * MiB, WS_K = 168 * MiB, WS_VT = 192 * MiB;
constexpr size_t WS_CTL = 252 * MiB, CTL_BYTES = 32768;
constexpr size_t WS_XCH = 253 * MiB;
constexpr size_t WS_SB = 254 * MiB;
constexpr size_t WS_END = 256 * MiB;
constexpr int CW_MODCNT = 7900;
constexpr int CW_CNT = 4096;
constexpr int LDS_BYTES = 147456;

struct Args { const float* in[22]; float* out; unsigned char* ws; int ph_lo, ph_hi; };

__device__ __forceinline__ unsigned cvt_pk_bf16(float lo, float hi) { unsigned r; asm volatile("v_cvt_pk_bf16_f32 %0, %1, %2" : "=v"(r) : "v"(lo), "v"(hi)); return r; }
__device__ __forceinline__ float bf_lo(unsigned u) { return __uint_as_float(u << 16); }
__device__ __forceinline__ float bf_hi(unsigned u) { return __uint_as_float(u & 0xffff0000u); }
__device__ __forceinline__ unsigned short f2bf(float f) { return (unsigned short)(cvt_pk_bf16(f, 0.f) & 0xffffu); }

namespace pg8 {
constexpr int BM = 256, BK = 64, HALF = 128, HTB = HALF * BK * 2, STAGE_BYTES = 8 * HTB, NXCD = 8, WGM = 8;
__host__ __device__ __forceinline__ int lds_byte(int r, int c) { const int st = (r >> 4) * 2 + (c >> 5), rr = r & 15, cc = c & 31, ob = rr * 64 + cc * 2; return st * 1024 + (ob ^ (((ob >> 9) & 1) << 5)); }
__host__ __device__ __forceinline__ void stage_rc(int b, int& R, int& C) { const int st = b / 1024, sb = b % 1024, swz = sb ^ (((sb >> 9) & 1) << 5); R = (st >> 1) * 16 + swz / 64; C = (st & 1) * 32 + (swz % 64) / 2; }
__host__ __device__ __forceinline__ int perm32(int rho) { const int n = rho >> 4, i = rho & 15; return 8 * (i >> 2) + 4 * n + (i & 3); }

struct Unit { int pm, pn; };
struct Gemm { const bf16_t* A; const bf16_t* Bt; int M, N, K; };

struct StaticOrder {
    int nM, nN, nwg, G, c;
    __device__ void init(int M, int N, int G_, int c_) { nM = M / BM; nN = N / BM; nwg = nM * nN; G = G_; c = c_; }
    __device__ bool next(int i, Unit& u) const {
        const long L = (long)i * G + c; if (L >= nwg) return false;
        int wgid = (int)L; { const int q = nwg / NXCD, r = nwg % NXCD, xcd = wgid % NXCD, off = wgid / NXCD; wgid = (xcd < r ? xcd * (q + 1) : r * (q + 1) + (xcd - r) * q) + off; }
        const int nig = WGM * nN, gid = wgid / nig, fm = gid * WGM, gsz = (nM - fm) < WGM ? (nM - fm) : WGM;
        u.pm = fm + ((wgid % nig) % gsz); u.pn = (wgid % nig) / gsz; return true;
    }
};

struct EpiBf16 {
    static constexpr bool PERM = true, AFTER_DRAIN = false, NEEDS_LDS = false;
    bf16_t* O; int ldc;
    __device__ __forceinline__ void operator()(const f32x4 (&acc)[2][2][4][2], const Unit& u, int wr, int wc, int fr, int fq) const {
        const int row0 = u.pm * BM + wr * 64 + fr; const int col0 = u.pn * BM + wc * 32 + 8 * fq;
#pragma unroll
        for (int ai = 0; ai < 2; ++ai)
#pragma unroll
            for (int m = 0; m < 4; ++m) { bf16_t* rowp = O + (size_t)(row0 + ai * HALF + m * 16) * ldc + col0;
#pragma unroll
                for (int bj = 0; bj < 2; ++bj) { const f32x4 v0 = acc[ai][bj][m][0], v1 = acc[ai][bj][m][1];
                    u32x4 w; w.x = cvt_pk_bf16(v0[0], v0[1]); w.y = cvt_pk_bf16(v0[2], v0[3]); w.z = cvt_pk_bf16(v1[0], v1[1]); w.w = cvt_pk_bf16(v1[2], v1[3]);
                    *(u32x4*)(rowp + bj * HALF) = w; } }
    }
};

struct EpiRes {
    static constexpr bool PERM = false, AFTER_DRAIN = false, NEEDS_LDS = false;
    const float* base_p; const float* base_s; float* out; const float* gate;
    __device__ __forceinline__ void operator()(const f32x4 (&acc)[2][2][4][2], const Unit& u, int wr, int wc, int fr, int fq) const {
        const int cv = u.pm < 32 ? 0 : 1 + ((u.pm - 32) >> 2);
        const int col0 = u.pn * BM + wc * 32 + 4 * fq;
        const float* gp = gate + cv * MODW + col0;
        f32x4 gv[2][2];
#pragma unroll
        for (int bj = 0; bj < 2; ++bj)
#pragma unroll
            for (int n = 0; n < 2; ++n) gv[bj][n] = *(const f32x4*)(gp + bj * HALF + n * 16);
        const float* bb = u.pm < 32 ? base_p + (size_t)u.pm * BM * DM : base_s + (size_t)(u.pm - 32) * BM * DM;
        float* ob = out + (size_t)u.pm * BM * DM;
#pragma unroll
        for (int ai = 0; ai < 2; ++ai)
#pragma unroll
            for (int m = 0; m < 4; ++m) { const size_t off = (size_t)(ai * HALF + wr * 64 + m * 16 + fr) * DM + col0;
#pragma unroll
                for (int bj = 0; bj < 2; ++bj)
#pragma unroll
                    for (int n = 0; n < 2; ++n) { const f32x4 bs = *(const f32x4*)(bb + off + bj * HALF + n * 16);
                        *(f32x4*)(ob + off + bj * HALF + n * 16) = bs + gv[bj][n] * acc[ai][bj][m][n]; }
                asm volatile("" ::: "memory"); }
    }
};

struct EpiResNorm {
    static constexpr bool PERM = false, AFTER_DRAIN = true, NEEDS_LDS = false;
    const float* base_p; const float* base_s; float* out; const float* gate; bf16_t* H; const float* gn; const float* mod_sh; const float* mod_sc; float* xbuf; unsigned* cnt; int final_mode;
    __device__ __forceinline__ void fused(f32x4 (&acc)[2][2][4][2], const Unit& u, int wr, int wc, int fr, int fq, LAS unsigned char* lds, int wid, int lane) const {
        LAS float* P = (LAS float*)lds;
        LAS float* S = (LAS float*)(lds + 8192);
        const int cv = u.pm < 32 ? 0 : 1 + ((u.pm - 32) >> 2);
        const int col0 = u.pn * BM + wc * 32 + 4 * fq;
        const float* bb = u.pm < 32 ? base_p + (size_t)u.pm * BM * DM : base_s + (size_t)(u.pm - 32) * BM * DM;
        float* ob = out + (size_t)u.pm * BM * DM;
        {   const float* gp = gate + cv * MODW + col0;
            f32x4 gv[2][2];
#pragma unroll
            for (int bj = 0; bj < 2; ++bj)
#pragma unroll
                for (int n = 0; n < 2; ++n) gv[bj][n] = *(const f32x4*)(gp + bj * HALF + n * 16);
#pragma unroll
            for (int ai = 0; ai < 2; ++ai)
#pragma unroll
                for (int m = 0; m < 4; ++m) { const size_t off = (size_t)(ai * HALF + wr * 64 + m * 16 + fr) * DM + col0;
                    float ss = 0.f;
#pragma unroll
                    for (int bj = 0; bj < 2; ++bj)
#pragma unroll
                        for (int n = 0; n < 2; ++n) { const f32x4 bs = *(const f32x4*)(bb + off + bj * HALF + n * 16);
                            const f32x4 x = bs + gv[bj][n] * acc[ai][bj][m][n]; acc[ai][bj][m][n] = x;
                            if (!final_mode) *(f32x4*)(ob + off + bj * HALF + n * 16) = x;
                            ss += (x[0] * x[0] + x[1] * x[1]) + (x[2] * x[2] + x[3] * x[3]); }
                    ss += __shfl_xor(ss, 16); ss += __shfl_xor(ss, 32);
                    if (fq == 0) P[(ai * HALF + wr * 64 + m * 16 + fr) * 4 + wc] = ss;
                    asm volatile("" ::: "memory"); }
        }
        asm volatile("s_waitcnt lgkmcnt(0)" ::: "memory"); __builtin_amdgcn_s_barrier(); asm volatile("" ::: "memory");
        const int row = wid * 32 + (lane & 31);
        if (lane < 32) {
            const float tot = (P[row * 4 + 0] + P[row * 4 + 1]) + (P[row * 4 + 2] + P[row * 4 + 3]);
            __hip_atomic_store(xbuf + ((size_t)(u.pm * BM + row) * 4 + u.pn), tot, __ATOMIC_RELAXED, __HIP_MEMORY_SCOPE_AGENT);
        }
        asm volatile("s_waitcnt vmcnt(0)" ::: "memory");
        if (lane == 0) __hip_atomic_fetch_add(cnt + 16 * u.pm, 1u, __ATOMIC_RELAXED, __HIP_MEMORY_SCOPE_AGENT);
        if (wid == 0) {
            unsigned sp = 0;
            while ((unsigned)__builtin_amdgcn_readfirstlane(__hip_atomic_load(cnt + 16 * u.pm, __ATOMIC_RELAXED, __HIP_MEMORY_SCOPE_AGENT)) < 32u) { __builtin_amdgcn_s_sleep(2); if (++sp > (1u << 22)) break; }
            __builtin_amdgcn_fence(__ATOMIC_ACQUIRE, "agent");
        }
        asm volatile("s_waitcnt vmcnt(0) lgkmcnt(0)" ::: "memory"); __builtin_amdgcn_s_barrier(); asm volatile("" ::: "memory");
        if (lane < 32) {
            const float* slot = xbuf + (size_t)(u.pm * BM + row) * 4; float t = 0.f;
#pragma unroll
            for (int k = 0; k < 4; ++k) t += __hip_atomic_load(slot + k, __ATOMIC_RELAXED, __HIP_MEMORY_SCOPE_AGENT);
            S[row] = 1.0f / sqrtf(t * (1.0f / DM) + EPS);
        }
        asm volatile("s_waitcnt vmcnt(0) lgkmcnt(0)" ::: "memory"); __builtin_amdgcn_s_barrier(); asm volatile("" ::: "memory");
        f32x4 ga[2][2], gb[2][2];
#pragma unroll
        for (int bj = 0; bj < 2; ++bj)
#pragma unroll
            for (int n = 0; n < 2; ++n) { const int c = col0 + bj * HALF + n * 16; const f32x4 g4 = *(const f32x4*)(gn + c);
                if (final_mode) { ga[bj][n] = g4; gb[bj][n] = (f32x4){0.f, 0.f, 0.f, 0.f}; }
                else { const f32x4 sc = *(const f32x4*)(mod_sc + cv * MODW + c), sh = *(const f32x4*)(mod_sh + cv * MODW + c); ga[bj][n] = g4 * (1.0f + sc); gb[bj][n] = sh; } }
#pragma unroll
        for (int ai = 0; ai < 2; ++ai)
#pragma unroll
            for (int m = 0; m < 4; ++m) { const int r = ai * HALF + wr * 64 + m * 16 + fr; const float rstd = S[r]; const size_t off = (size_t)r * DM + col0;
#pragma unroll
                for (int bj = 0; bj < 2; ++bj)
#pragma unroll
                    for (int n = 0; n < 2; ++n) { const f32x4 h = (acc[ai][bj][m][n] * rstd) * ga[bj][n] + gb[bj][n];
                        if (final_mode) __builtin_nontemporal_store(h, (f32x4*)(ob + off + bj * HALF + n * 16));
                        else { u32x2 w; w.x = cvt_pk_bf16(h[0], h[1]); w.y = cvt_pk_bf16(h[2], h[3]); *(u32x2*)(H + (size_t)u.pm * BM * DM + off + bj * HALF + n * 16) = w; } }
            }
    }
};

__device__ __forceinline__ float gelu_tanh_f(float x) {
    const float t = x * x; const float p = __builtin_fmaf(t, -0.10294324f, -2.3022082f);
    return x * __builtin_amdgcn_rcpf(1.0f + __builtin_amdgcn_exp2f(p * x));
}
template <int CTRL> __device__ __forceinline__ float dppf(float oldv, float src) {
    return __int_as_float(__builtin_amdgcn_update_dpp(__float_as_int(oldv), __float_as_int(src), CTRL, 0xf, 0xf, false));
}
struct EpiGate {
    static constexpr bool PERM = true, AFTER_DRAIN = false, NEEDS_LDS = true;
    bf16_t* A3; const float* cw; const float* cbias; float* SB;
    __device__ __forceinline__ void operator()(f32x4 (&acc)[2][2][4][2], const Unit& u, int wr, int wc, int fr, int fq, LAS unsigned char* lds) const {
        LAS float* XU = (LAS float*)(lds + 131072);
        const int c8 = wc * 32 + 8 * fq, gc = u.pn * HALF + c8;
#ifndef NOXU
#pragma unroll
        for (int ai = 0; ai < 2; ++ai) { const int sidx = 2 * ai + wr;
            if (fr == 0)  { *(LAS f32x4*)(XU + (sidx * 2 + 0) * 128 + c8) = acc[ai][0][0][0]; *(LAS f32x4*)(XU + (sidx * 2 + 0) * 128 + c8 + 4) = acc[ai][0][0][1]; }
            if (fr == 15) { *(LAS f32x4*)(XU + (sidx * 2 + 1) * 128 + c8) = acc[ai][0][3][0]; *(LAS f32x4*)(XU + (sidx * 2 + 1) * 128 + c8 + 4) = acc[ai][0][3][1]; } }
#endif
        if (u.pm >= 32) {
            float* sb = SB + (size_t)(u.pm - 32) * 6 * DFF + gc;
            if (wr == 0 && fr < 2) { *(f32x4*)(sb + fr * DFF) = acc[0][0][0][0]; *(f32x4*)(sb + fr * DFF + 4) = acc[0][0][0][1];
                if (fr == 0) { *(f32x4*)(sb + 2 * DFF) = acc[0][1][0][0]; *(f32x4*)(sb + 2 * DFF + 4) = acc[0][1][0][1]; } }
            if (wr == 1 && fr >= 14) { *(f32x4*)(sb + (fr - 11) * DFF) = acc[1][0][3][0]; *(f32x4*)(sb + (fr - 11) * DFF + 4) = acc[1][0][3][1];
                if (fr == 15) { *(f32x4*)(sb + 5 * DFF) = acc[1][1][3][0]; *(f32x4*)(sb + 5 * DFF + 4) = acc[1][1][3][1]; } }
        }
        f32x4 w0[2], w1[2], w2[2], cb[2];
#pragma unroll
        for (int n = 0; n < 2; ++n) { w0[n] = *(const f32x4*)(cw + gc + 4 * n); w1[n] = *(const f32x4*)(cw + DFF + gc + 4 * n); w2[n] = *(const f32x4*)(cw + 2 * DFF + gc + 4 * n); cb[n] = *(const f32x4*)(cbias + gc + 4 * n); }
#ifndef NOXU
        asm volatile("s_waitcnt lgkmcnt(0)" ::: "memory"); __builtin_amdgcn_s_barrier(); asm volatile("" ::: "memory");
#endif
#pragma unroll
        for (int ai = 0; ai < 2; ++ai) { const int sidx = 2 * ai + wr;
            f32x4 top[2], bot[2];
#pragma unroll
            for (int n = 0; n < 2; ++n) {
#ifdef NOXU
                top[n] = (f32x4){0.f,0.f,0.f,0.f}; bot[n] = top[n];
#else
                top[n] = sidx > 0 ? *(const LAS f32x4*)(XU + ((sidx - 1) * 2 + 1) * 128 + c8 + 4 * n) : (f32x4){0.f, 0.f, 0.f, 0.f};
                bot[n] = sidx < 3 ? *(const LAS f32x4*)(XU + ((sidx + 1) * 2 + 0) * 128 + c8 + 4 * n) : (f32x4){0.f, 0.f, 0.f, 0.f};
#endif
            }
#pragma unroll
            for (int m = 0; m < 4; ++m) {
                u32x4 w;
#pragma unroll
                for (int n = 0; n < 2; ++n) { float ov[4];
#pragma unroll
                    for (int j = 0; j < 4; ++j) {
                        const float uc = acc[ai][0][m][n][j];
                        const float upo = m > 0 ? dppf<0x140>(0.f, acc[ai][0][m - 1][n][j]) : top[n][j];
                        const float up = dppf<0x111>(upo, uc);
                        const float dno = m < 3 ? dppf<0x140>(0.f, acc[ai][0][m + 1][n][j]) : bot[n][j];
                        const float dn = dppf<0x101>(dno, uc);
                        const float cv = __builtin_fmaf(w0[n][j], up, __builtin_fmaf(w1[n][j], uc, __builtin_fmaf(w2[n][j], dn, cb[n][j])));
                        ov[j] = gelu_tanh_f(cv) * acc[ai][1][m][n][j]; }
                    if (n == 0) { w.x = cvt_pk_bf16(ov[0], ov[1]); w.y = cvt_pk_bf16(ov[2], ov[3]); } else { w.z = cvt_pk_bf16(ov[0], ov[1]); w.w = cvt_pk_bf16(ov[2], ov[3]); } }
                *(u32x4*)(A3 + (size_t)(u.pm * BM + ai * HALF + wr * 64 + m * 16 + fr) * DFF + gc) = w;
            }
        }
#ifndef NOXU
        asm volatile("s_waitcnt lgkmcnt(0)" ::: "memory"); __builtin_amdgcn_s_barrier(); asm volatile("" ::: "memory");
#endif
    }
};

struct EpiQKV {
    static constexpr bool PERM = false, AFTER_DRAIN = false, NEEDS_LDS = false;
    bf16_t* Q; bf16_t* Kb; bf16_t* Vt; float* sk; float* sv;
    __device__ __forceinline__ void operator()(const f32x4 (&acc)[2][2][4][2], const Unit& u, int wr, int wc, int fr, int fq) const {
        const int which = u.pn >> 2; const int cb = (u.pn & 3) * BM + wc * 32 + 4 * fq;
        const bool prompt = u.pm < 32;
        const int bidx = prompt ? u.pm : ((u.pm - 32) >> 2);
        const int tbase = (prompt ? 0 : ((u.pm - 32) & 3) * 256) + wr * 64 + fr;
        const int T = prompt ? SEQ_P : SEQ_S;
#pragma unroll
        for (int ai = 0; ai < 2; ++ai)
#pragma unroll
            for (int m = 0; m < 4; ++m) {
                const int t = tbase + ai * HALF + m * 16; const size_t row = (size_t)u.pm * BM + ai * HALF + wr * 64 + m * 16 + fr;
#pragma unroll
                for (int bj = 0; bj < 2; ++bj)
#pragma unroll
                    for (int n = 0; n < 2; ++n) { const int c = cb + bj * HALF + n * 16; const f32x4 v = acc[ai][bj][m][n];
                        if (which == 0) { u32x2 w; w.x = cvt_pk_bf16(v[0] * 0.125f, v[1] * 0.125f); w.y = cvt_pk_bf16(v[2] * 0.125f, v[3] * 0.125f); *(u32x2*)(Q + row * DM + c) = w; }
                        else if (which == 1) { u32x2 w; w.x = cvt_pk_bf16(v[0], v[1]); w.y = cvt_pk_bf16(v[2], v[3]); *(u32x2*)(Kb + row * DM + c) = w;
                            if (prompt) __builtin_nontemporal_store(v, (f32x4*)(sk + ((size_t)(bidx * NH + (c >> 6)) * SEQ_P + t) * HD + (c & 63))); }
                        else { const int h = c >> 6, d = c & 63;
                            if (prompt) __builtin_nontemporal_store(v, (f32x4*)(sv + ((size_t)(bidx * NH + h) * SEQ_P + t) * HD + d));
                            bf16_t* vp = Vt + (prompt ? 0 : (size_t)MP * DM) + ((size_t)(bidx * NH + h) * HD + d) * T + t;
                            vp[0] = f2bf(v[0]); vp[T] = f2bf(v[1]); vp[2 * T] = f2bf(v[2]); vp[3 * T] = f2bf(v[3]); }
                    }
            }
    }
};

template <class Epi, class Sched>
__device__ __forceinline__ void gemm_phase(LAS unsigned char* lds, const Gemm g, const Sched& S, const Epi& E, const int tid) {
    const int wid = __builtin_amdgcn_readfirstlane(tid >> 6), lane = tid & 63, wr = wid >> 2, wc = wid & 3, fr = lane & 15, fq = lane >> 4;
    const int K = g.K, nt = K / BK;
    unsigned voffA[2], voffB[2];
#pragma unroll
    for (int i = 0; i < 2; ++i) { int R, C; stage_rc(tid * 16 + i * 8192, R, C); const int Rb = Epi::PERM ? ((R & ~31) + perm32(R & 31)) : R;
        voffA[i] = (unsigned)(R * K + C) * 2u; voffB[i] = (unsigned)(Rb * K + C) * 2u; }
    const size_t kstep = (size_t)(BK * 2);
    const size_t hstep = (size_t)HALF * K * 2;
    const size_t tstep = 2 * hstep;
    const unsigned ldsw = (unsigned)wid * 1024u;
    const int aoff = lds_byte(wr * 64 + fr, fq * 8), boff = lds_byte(wc * 32 + fr, fq * 8);
#define PG8_SA(b, h) (((b) * 2 + (h)) * HTB)
#define PG8_SB(b, h) ((4 + (b) * 2 + (h)) * HTB)
#define PG8_STAGE(bufoff, gbase, voff) do { _Pragma("unroll") for (int _i = 0; _i < 2; ++_i) \
        __builtin_amdgcn_global_load_lds((const unsigned*)((const char*)(gbase) + (voff)[_i]), (LAS unsigned*)(lds + (bufoff) + ldsw + _i * 8192), 16, 0, 0); } while (0)
#define PG8_LDA(dst, b, h) do { _Pragma("unroll") for (int m = 0; m < 4; ++m) _Pragma("unroll") for (int k = 0; k < 2; ++k) dst[m][k] = *(const LAS bf16x8*)(lds + PG8_SA(b, h) + aoff + m * 2048 + k * 1024); } while (0)
#define PG8_LDB(dst, b, h) do { _Pragma("unroll") for (int n = 0; n < 2; ++n) _Pragma("unroll") for (int k = 0; k < 2; ++k) dst[n][k] = *(const LAS bf16x8*)(lds + PG8_SB(b, h) + boff + n * 2048 + k * 1024); } while (0)
#define PG8_MMA(ai, bj, At, Bt) do { __builtin_amdgcn_s_setprio(1); _Pragma("unroll") for (int m = 0; m < 4; ++m) _Pragma("unroll") for (int n = 0; n < 2; ++n) _Pragma("unroll") for (int k = 0; k < 2; ++k) \
        acc[ai][bj][m][n] = __builtin_amdgcn_mfma_f32_16x16x32_bf16(Bt[n][k], At[m][k], acc[ai][bj][m][n], 0, 0, 0); __builtin_amdgcn_s_setprio(0); } while (0)
#define PG8_WAIT_V(n) asm volatile("s_waitcnt vmcnt(" #n ")" ::: "memory")
#define PG8_WAIT_L(n) asm volatile("s_waitcnt lgkmcnt(" #n ")" ::: "memory")
#define PG8_BAR __builtin_amdgcn_s_barrier()
#define PG8_SCHED __builtin_amdgcn_sched_barrier(0)
    Unit cur, nxt; int ui = 0;
    if (!S.next(0, cur)) return;
    f32x4 acc[2][2][4][2];
#pragma unroll
    for (int a = 0; a < 2; ++a)
#pragma unroll
        for (int b = 0; b < 2; ++b)
#pragma unroll
            for (int m = 0; m < 4; ++m)
#pragma unroll
                for (int n = 0; n < 2; ++n) acc[a][b][m][n] = (f32x4){0.f, 0.f, 0.f, 0.f};
    bf16x8 At[4][2], B0[2][2], B1[2][2];
    const char* cA = (const char*)g.A + (size_t)cur.pm * tstep; const char* cB = (const char*)g.Bt + (size_t)cur.pn * tstep;
    PG8_STAGE(PG8_SB(0, 0), cB, voffB); PG8_STAGE(PG8_SB(0, 1), cB + hstep, voffB); PG8_STAGE(PG8_SA(0, 0), cA, voffA); PG8_STAGE(PG8_SA(0, 1), cA + hstep, voffA);
    if (wr == 1) PG8_BAR;
    PG8_WAIT_V(2); PG8_BAR;
    PG8_STAGE(PG8_SB(1, 0), cB + kstep, voffB); PG8_STAGE(PG8_SA(1, 0), cA + kstep, voffA); PG8_STAGE(PG8_SB(1, 1), cB + hstep + kstep, voffB);
    PG8_WAIT_V(6); PG8_BAR;
    for (;;) {
        const bool has_next = S.next(ui + 1, nxt);
        const char* nA = has_next ? (const char*)g.A + (size_t)nxt.pm * tstep : cA; const char* nB = has_next ? (const char*)g.Bt + (size_t)nxt.pn * tstep : cB;
        for (int t = 0; t < nt; t += 2) {
            const bool last = (t == nt - 2);
            const char* a1 = cA + (size_t)(t + 1) * kstep;
            const char* a2 = last ? nA : cA + (size_t)(t + 2) * kstep; const char* b2 = last ? nB : cB + (size_t)(t + 2) * kstep;
            const char* a3 = a2 + kstep; const char* b3 = b2 + kstep;
            PG8_LDB(B0, 0, 0); PG8_LDB(B1, 0, 1); PG8_SCHED; PG8_LDA(At, 0, 0); PG8_STAGE(PG8_SA(1, 1), a1 + hstep, voffA);
            PG8_WAIT_V(8); PG8_WAIT_L(0); PG8_BAR; PG8_MMA(0, 0, At, B0); PG8_MMA(0, 1, At, B1); PG8_BAR; PG8_SCHED;
            PG8_LDA(At, 0, 1); PG8_STAGE(PG8_SB(0, 0), b2, voffB); PG8_STAGE(PG8_SB(0, 1), b2 + hstep, voffB); PG8_STAGE(PG8_SA(0, 0), a2, voffA);
            PG8_WAIT_V(8); PG8_WAIT_L(0); PG8_BAR; PG8_MMA(1, 0, At, B0); PG8_MMA(1, 1, At, B1); PG8_BAR; PG8_SCHED;
            PG8_LDB(B0, 1, 0); PG8_LDB(B1, 1, 1); PG8_SCHED; PG8_LDA(At, 1, 0); PG8_STAGE(PG8_SA(0, 1), a2 + hstep, voffA);
            PG8_WAIT_V(8); PG8_WAIT_L(0); PG8_BAR; PG8_MMA(0, 0, At, B0); PG8_MMA(0, 1, At, B1); PG8_BAR; PG8_SCHED;
            PG8_LDA(At, 1, 1); PG8_STAGE(PG8_SB(1, 0), b3, voffB); PG8_STAGE(PG8_SB(1, 1), b3 + hstep, voffB); PG8_STAGE(PG8_SA(1, 0), a3, voffA);
            PG8_WAIT_V(8); PG8_WAIT_L(0); PG8_BAR; PG8_MMA(1, 0, At, B0); PG8_MMA(1, 1, At, B1); PG8_BAR; PG8_SCHED;
        }
        if (wr == 0) PG8_BAR;
        if constexpr (!Epi::AFTER_DRAIN) { if constexpr (Epi::NEEDS_LDS) E(acc, cur, wr, wc, fr, fq, lds); else E(acc, cur, wr, wc, fr, fq); }
        if (!has_next) break;
#pragma unroll
        for (int a = 0; a < 2; ++a)
#pragma unroll
            for (int b = 0; b < 2; ++b)
#pragma unroll
                for (int m = 0; m < 4; ++m)
#pragma unroll
                    for (int n = 0; n < 2; ++n) acc[a][b][m][n] = (f32x4){0.f, 0.f, 0.f, 0.f};
        cur = nxt; cA = nA; cB = nB; ++ui;
        if (wr == 1) PG8_BAR;
    }
    PG8_WAIT_V(0);
    PG8_BAR;
    if constexpr (Epi::AFTER_DRAIN) E.fused(acc, cur, wr, wc, fr, fq, lds, wid, lane);
#undef PG8_SA
#undef PG8_SB
#undef PG8_STAGE
#undef PG8_LDA
#undef PG8_LDB
#undef PG8_MMA
#undef PG8_WAIT_V
#undef PG8_WAIT_L
#undef PG8_BAR
#undef PG8_SCHED
}
}

__device__ __forceinline__ float wave_sum(float v) {
#pragma unroll
    for (int o = 1; o < 64; o <<= 1) v += __shfl_xor(v, o);
    return v;
}
#define LDS_WAIT() asm volatile("s_waitcnt lgkmcnt(0)" ::: "memory")

template <bool UPMAP = false>
__device__ __forceinline__ void p0_transpose_item(const float* W, int K, int N, bf16_t* WT, LAS float* scr, int item, int lane) {
    const int nblk = N / 32, kb = item / nblk, nb = item % nblk, k0 = 64 * kb, n0 = 32 * nb;
    int d0 = n0; if (UPMAP) { const int part = n0 >= DFF ? 1 : 0, cc = n0 - part * DFF; d0 = 256 * (cc >> 7) + 128 * part + (cc & 127); }
    {
        f32x4 v[8]; const int cq = 4 * (lane & 7), kr = lane >> 3;
#pragma unroll
        for (int i = 0; i < 8; ++i) v[i] = __builtin_nontemporal_load((const f32x4*)(W + (size_t)(k0 + 8 * i + kr) * N + n0 + cq));
#pragma unroll
        for (int i = 0; i < 8; ++i) { LAS float* d = scr + (8 * i + kr) * 33 + cq; d[0] = v[i].x; d[1] = v[i].y; d[2] = v[i].z; d[3] = v[i].w; }
    }
    LDS_WAIT(); asm volatile("" ::: "memory");
    const int c = lane & 7;
#pragma unroll
    for (int j = 0; j < 4; ++j) { const int n = (lane >> 3) + 8 * j; const LAS float* s = scr + (8 * c) * 33 + n;
        u32x4 o; o.x = cvt_pk_bf16(s[0 * 33], s[1 * 33]); o.y = cvt_pk_bf16(s[2 * 33], s[3 * 33]); o.z = cvt_pk_bf16(s[4 * 33], s[5 * 33]); o.w = cvt_pk_bf16(s[6 * 33], s[7 * 33]);
        *(u32x4*)(WT + (size_t)(d0 + n) * K + k0 + 8 * c) = o; }
    LDS_WAIT(); asm volatile("" ::: "memory");
}

constexpr int I_IN = 16 * 96, I_OUT = 16 * 32, I_UP = 16 * 176, I_DN = 44 * 32;
constexpr int TI_R0 = I_IN + I_OUT + I_UP, TI_R1 = TI_R0 + I_DN, TI_R2 = TI_R1 + I_IN + I_OUT + I_UP + I_DN;
__device__ __forceinline__ void transpose_items(const Args& a, LAS unsigned char* lds, int lo, int hi, int worker, int nworkers, int wave, int lane) {
    unsigned char* ws = a.ws;
    LAS float* scr = (LAS float*)(lds + wave * 16384);
    for (int it = lo + worker; it < hi; it += nworkers) {
        int r = it;
        if (r < I_IN) { p0_transpose_item(a.in[10], DM, 3 * DM, (bf16_t*)(ws + WS_WIN), scr, r, lane); continue; } r -= I_IN;
        if (r < I_OUT) { p0_transpose_item(a.in[13], DM, DM, (bf16_t*)(ws + WS_WOUT), scr, r, lane); continue; } r -= I_OUT;
        if (r < I_UP) { p0_transpose_item<true>(a.in[17], DM, 2 * DFF, (bf16_t*)(ws + WS_WUP), scr, r, lane); continue; } r -= I_UP;
        if (r < I_DN) { p0_transpose_item(a.in[20], DFF, DM, (bf16_t*)(ws + WS_WDN), scr, r, lane); continue; } r -= I_DN;
        if (r < I_IN) { p0_transpose_item(a.in[14], DM, 3 * DM, (bf16_t*)(ws + WS_WQKV), scr, r, lane); continue; } r -= I_IN;
        if (r < I_OUT) { p0_transpose_item(a.in[16], DM, DM, (bf16_t*)(ws + WS_WO), scr, r, lane); continue; } r -= I_OUT;
        if (r < I_UP) { p0_transpose_item<true>(a.in[17] + (size_t)DM * 2 * DFF, DM, 2 * DFF, (bf16_t*)(ws + WS_WUP) + (size_t)DM * 2 * DFF, scr, r, lane); continue; } r -= I_UP;
        p0_transpose_item(a.in[20] + (size_t)DM * DFF, DFF, DM, (bf16_t*)(ws + WS_WDN) + (size_t)DM * DFF, scr, r, lane);
    }
}

__device__ __forceinline__ void prologue(const Args& a, LAS unsigned char* lds, int tid, int wave, int lane, int bid, int G) {
    unsigned char* ws = a.ws;
    float* MOD = (float*)(ws + WS_MOD);
    LAS float* sil = (LAS float*)lds;
    LAS float* red = (LAS float*)(lds + 5 * 1024 * 4);
    for (int i = tid; i < NCV * DM; i += 512) { const int cv = i >> 10, k = i & 1023; const float x = cv == 0 ? a.in[5][k] : a.in[4][(cv - 1) * DM + k]; sil[i] = x / (1.f + __expf(-x)); }
    __syncthreads();
    for (int item = bid; item < 2 * (MODW / 32); item += G) {
        const int l = item / (MODW / 32), col0 = (item % (MODW / 32)) * 32;
        const float* W = a.in[6] + (size_t)l * DM * MODW + col0 + 4 * (lane & 7);
        f32x4 acc[NCV];
#pragma unroll
        for (int cv = 0; cv < NCV; ++cv) acc[cv] = (f32x4){0.f, 0.f, 0.f, 0.f};
#pragma unroll 4
        for (int i = 0; i < 16; ++i) { const int k = 128 * wave + 8 * i + (lane >> 3); const f32x4 w = __builtin_nontemporal_load((const f32x4*)(W + (size_t)k * MODW));
#pragma unroll
            for (int cv = 0; cv < NCV; ++cv) acc[cv] += sil[cv * DM + k] * w; }
#pragma unroll
        for (int cv = 0; cv < NCV; ++cv)
#pragma unroll
            for (int j = 0; j < 4; ++j) { float v = acc[cv][j]; v += __shfl_xor(v, 8); v += __shfl_xor(v, 16); v += __shfl_xor(v, 32); acc[cv][j] = v; }
        if (lane < 8) {
#pragma unroll
            for (int cv = 0; cv < NCV; ++cv)
#pragma unroll
                for (int j = 0; j < 4; ++j) red[(wave * NCV + cv) * 32 + 4 * lane + j] = acc[cv][j];
        }
        __syncthreads();
        if (tid < NCV * 32) { const int cv = tid >> 5, c = tid & 31; float s = 0.f;
#pragma unroll
            for (int w = 0; w < 8; ++w) s += red[(w * NCV + cv) * 32 + c];
            MOD[((size_t)l * NCV + cv) * MODW + col0 + c] = s + a.in[7][l * MODW + col0 + c]; }
        asm volatile("s_waitcnt vmcnt(0)" ::: "memory");
        __syncthreads();
        if (l == 0 && col0 < 2 * DM && tid == 0) {
            __builtin_amdgcn_fence(__ATOMIC_RELEASE, "agent");
            __hip_atomic_fetch_add((unsigned*)(ws + WS_CTL) + CW_MODCNT, 1u, __ATOMIC_RELAXED, __HIP_MEMORY_SCOPE_AGENT);
        }
    }
    __syncthreads();
    transpose_items(a, lds, 0, TI_R0, bid * 8 + wave, G * 8, wave, lane);
    const int gt = bid * 512 + tid, NGT = G * 512;
    bf16_t* Kc = (bf16_t*)(ws + WS_KC); bf16_t* Vtc = (bf16_t*)(ws + WS_VTC);
    for (int i = gt; i < NB_S * NH * PAST * HD; i += NGT) {
        Kc[i] = f2bf(a.in[2][i]);
        const int t = i & 255, d = (i >> 8) & 63, bh = i >> 14;
        Vtc[i] = f2bf(a.in[3][((size_t)bh * PAST + t) * HD + d]);
    }
}

__device__ __forceinline__ void norm_phase(const Args& a, int ph, int wave, int lane, int bid, int G) {
    const int gw = bid * 8 + wave, NGW = G * 8;
    const bool is_final = ph == 17, ffn = (ph == 5 || ph == 13); const int layer = ph >= 9 ? 1 : 0;
    const float* g = is_final ? a.in[21] : ((ffn ? a.in[9] : a.in[8]) + layer * DM);
    const float* mod = (const float*)(a.ws + WS_MOD) + (size_t)layer * NCV * MODW + (ffn ? 3 * DM : 0);
    bf16_t* H = (bf16_t*)(a.ws + WS_H);
    f32x4 gv[4];
#pragma unroll
    for (int j = 0; j < 4; ++j) gv[j] = *(const f32x4*)(g + 4 * lane + 256 * j);
    for (int row = gw; row < MT; row += NGW) {
        const float* xr = (ph == 1) ? (row < MP ? a.in[0] + (size_t)row * DM : a.in[1] + (size_t)(row - MP) * DM) : a.out + (size_t)row * DM;
        f32x4 v[4]; float s = 0.f;
#pragma unroll
        for (int j = 0; j < 4; ++j) { v[j] = *(const f32x4*)(xr + 4 * lane + 256 * j); s += (v[j].x * v[j].x + v[j].y * v[j].y) + (v[j].z * v[j].z + v[j].w * v[j].w); }
        const float rstd = 1.0f / sqrtf(wave_sum(s) * (1.f / DM) + EPS);
        if (is_final) {
#pragma unroll
            for (int j = 0; j < 4; ++j) *(f32x4*)(a.out + (size_t)row * DM + 4 * lane + 256 * j) = (v[j] * rstd) * gv[j];
        } else {
            const int cv = row < MP ? 0 : 1 + ((row - MP) >> 10);
            const float* mp = mod + (size_t)cv * MODW + 4 * lane;
#pragma unroll
            for (int j = 0; j < 4; ++j) { const f32x4 sh = *(const f32x4*)(mp + 256 * j), sc = *(const f32x4*)(mp + DM + 256 * j);
                const f32x4 h = ((v[j] * rstd) * gv[j]) * (1.0f + sc) + sh;
                u32x2 w; w.x = cvt_pk_bf16(h.x, h.y); w.y = cvt_pk_bf16(h.z, h.w);
                *(u32x2*)(H + (size_t)row * DM + 4 * lane + 256 * j) = w; }
        }
    }
}

struct F8 { float v[8]; };
__device__ __forceinline__ F8 ld8(const bf16_t* p) { const u32x4 w = *(const u32x4*)p; F8 r; r.v[0] = bf_lo(w.x); r.v[1] = bf_hi(w.x); r.v[2] = bf_lo(w.y); r.v[3] = bf_hi(w.y); r.v[4] = bf_lo(w.z); r.v[5] = bf_hi(w.z); r.v[6] = bf_lo(w.w); r.v[7] = bf_hi(w.w); return r; }
__device__ __forceinline__ F8 ldf8(const float* p) { const f32x4 a = *(const f32x4*)p, b = *(const f32x4*)(p + 4); F8 r; r.v[0] = a.x; r.v[1] = a.y; r.v[2] = a.z; r.v[3] = a.w; r.v[4] = b.x; r.v[5] = b.y; r.v[6] = b.z; r.v[7] = b.w; return r; }
__device__ __forceinline__ void st8(bf16_t* p, const F8& o) { u32x4 w; w.x = cvt_pk_bf16(o.v[0], o.v[1]); w.y = cvt_pk_bf16(o.v[2], o.v[3]); w.z = cvt_pk_bf16(o.v[4], o.v[5]); w.w = cvt_pk_bf16(o.v[6], o.v[7]); *(u32x4*)p = w; }
__device__ __forceinline__ F8 zero8() { F8 r;
#pragma unroll
    for (int e = 0; e < 8; ++e) r.v[e] = 0.f;
    return r; }

constexpr int RS = 8;
__device__ __forceinline__ F8 unpack8c(const u32x4 w) { F8 r; r.v[0] = bf_lo(w.x); r.v[1] = bf_hi(w.x); r.v[2] = bf_lo(w.y); r.v[3] = bf_hi(w.y); r.v[4] = bf_lo(w.z); r.v[5] = bf_hi(w.z); r.v[6] = bf_lo(w.w); r.v[7] = bf_hi(w.w); return r; }
__device__ __forceinline__ void convgate_phase(const Args& a, int tid, int bid, int G) {
    const bf16_t* BCX = (const bf16_t*)(a.ws + WS_BCX); bf16_t* A2 = (bf16_t*)(a.ws + WS_A2);
    const float* cw = a.in[11]; const float* cbias = a.in[12];
    constexpr int NITEM = (MT / RS) * (DM / 8); const int per = (NITEM + G - 1) / G;
    for (int j = tid; j < per; j += 512) {
        const int item = bid * per + j; if (item >= NITEM) break;
        const int strip = item >> 7, c = (item & 127) * 8, r0 = strip * RS;
        const int seqm = r0 < MP ? (SEQ_P - 1) : (SEQ_S - 1);
        const bool first = (r0 & seqm) == 0, last = ((r0 + RS) & seqm) == 0;
        const bf16_t* p = BCX + (size_t)r0 * (3 * DM) + c;
        u32x4 cr[RS + 2], xr[RS + 2], br[RS];
        const u32x4 z4 = (u32x4){0u, 0u, 0u, 0u};
        cr[0] = first ? z4 : *(const u32x4*)(p - 3 * DM + DM); xr[0] = first ? z4 : *(const u32x4*)(p - 3 * DM + 2 * DM);
#pragma unroll
        for (int i = 0; i < RS; ++i) { br[i] = *(const u32x4*)(p + (size_t)i * 3 * DM); cr[i + 1] = *(const u32x4*)(p + (size_t)i * 3 * DM + DM); xr[i + 1] = *(const u32x4*)(p + (size_t)i * 3 * DM + 2 * DM); }
        cr[RS + 1] = last ? z4 : *(const u32x4*)(p + (size_t)RS * 3 * DM + DM); xr[RS + 1] = last ? z4 : *(const u32x4*)(p + (size_t)RS * 3 * DM + 2 * DM);
        const F8 w0 = ldf8(cw + c), w1 = ldf8(cw + DM + c), w2 = ldf8(cw + 2 * DM + c), cb = ldf8(cbias + c);
        F8 prev, cur;
        { const F8 x = unpack8c(cr[0]), y = unpack8c(xr[0]);
#pragma unroll
            for (int e = 0; e < 8; ++e) prev.v[e] = x.v[e] * y.v[e]; }
        { const F8 x = unpack8c(cr[1]), y = unpack8c(xr[1]);
#pragma unroll
            for (int e = 0; e < 8; ++e) cur.v[e] = x.v[e] * y.v[e]; }
#pragma unroll
        for (int i = 0; i < RS; ++i) {
            F8 nxt; { const F8 x = unpack8c(cr[i + 2]), y = unpack8c(xr[i + 2]);
#pragma unroll
                for (int e = 0; e < 8; ++e) nxt.v[e] = x.v[e] * y.v[e]; }
            const F8 bg = unpack8c(br[i]); F8 o;
#pragma unroll
            for (int e = 0; e < 8; ++e) o.v[e] = bg.v[e] * (w0.v[e] * prev.v[e] + w1.v[e] * cur.v[e] + w2.v[e] * nxt.v[e] + cb.v[e]);
            st8(A2 + (size_t)(r0 + i) * DM + c, o);
            prev = cur; cur = nxt;
        }
    }
}
__device__ __forceinline__ float gelu_tanh(float x) {
    const float t = x * x; const float p = __builtin_fmaf(t, -0.10294324f, -2.3022082f);
    return x * __builtin_amdgcn_rcpf(1.0f + __builtin_amdgcn_exp2f(p * x));
}
__device__ __forceinline__ F8 unpack8(const u32x4 w) { F8 r; r.v[0] = bf_lo(w.x); r.v[1] = bf_hi(w.x); r.v[2] = bf_lo(w.y); r.v[3] = bf_hi(w.y); r.v[4] = bf_lo(w.z); r.v[5] = bf_hi(w.z); r.v[6] = bf_lo(w.w); r.v[7] = bf_hi(w.w); return r; }
template <bool BIAS>
__device__ __forceinline__ void attn_chunk(const bf16_t* Kp, int kpitch, const bf16_t* Vp, int vpitch, int tok0, int gstride,
                                           const bf16x8 qf0, const bf16x8 qf1, float& m_run, float& l_run, f32x4 (&o)[4],
                                           const float* rpb_h, int drow0, int kc0, int qc, int lane) {
    const int i = lane & 15, q = lane >> 4;
    f32x4 s[8];
#pragma unroll
    for (int kt = 0; kt < 8; ++kt) {
        const bf16_t* kp = Kp + (size_t)(tok0 + (kt >> 1) * gstride + (kt & 1) * 16 + i) * kpitch + 8 * q;
        const bf16x8 a0 = *(const bf16x8*)kp, a1 = *(const bf16x8*)(kp + 32);
        f32x4 z = (f32x4){0.f, 0.f, 0.f, 0.f};
        z = __builtin_amdgcn_mfma_f32_16x16x32_bf16(a0, qf0, z, 0, 0, 0);
        s[kt] = __builtin_amdgcn_mfma_f32_16x16x32_bf16(a1, qf1, z, 0, 0, 0);
    }
    if (BIAS) {
        const int cs = min(max(qc - 8, 0), 48);
#pragma unroll
        for (int kt = 0; kt < 8; ++kt) {
            const float* rp = rpb_h + ((kt >> 1) + drow0) * 31;
#pragma unroll
            for (int j = 0; j < 4; ++j) { const int kc = kc0 + (kt & 1) * 16 + 4 * q + j; const bool ok = (kc >= cs) && (kc < cs + 16);
                const int dc = min(max(kc - qc, -15), 15);
                s[kt][j] = ok ? s[kt][j] + rp[dc + 15] : -1e30f; }
        }
    }
    float mx = -1e30f;
#pragma unroll
    for (int kt = 0; kt < 8; ++kt) mx = fmaxf(mx, fmaxf(fmaxf(s[kt][0], s[kt][1]), fmaxf(s[kt][2], s[kt][3])));
    mx = fmaxf(mx, __shfl_xor(mx, 16)); mx = fmaxf(mx, __shfl_xor(mx, 32));
    const float m_new = fmaxf(m_run, mx), alpha = __expf(m_run - m_new);
    float ls = 0.f;
#pragma unroll
    for (int kt = 0; kt < 8; ++kt)
#pragma unroll
        for (int j = 0; j < 4; ++j) { const float p = __expf(s[kt][j] - m_new); s[kt][j] = p; ls += p; }
    ls += __shfl_xor(ls, 16); ls += __shfl_xor(ls, 32);
    l_run = l_run * alpha + ls; m_run = m_new;
#pragma unroll
    for (int dt = 0; dt < 4; ++dt) o[dt] = o[dt] * alpha;
#pragma unroll
    for (int g = 0; g < 4; ++g) {
        u32x4 pw; pw.x = cvt_pk_bf16(s[2 * g][0], s[2 * g][1]); pw.y = cvt_pk_bf16(s[2 * g][2], s[2 * g][3]);
        pw.z = cvt_pk_bf16(s[2 * g + 1][0], s[2 * g + 1][1]); pw.w = cvt_pk_bf16(s[2 * g + 1][2], s[2 * g + 1][3]);
        const bf16x8 pb = __builtin_bit_cast(bf16x8, pw);
#pragma unroll
        for (int dt = 0; dt < 4; ++dt) {
            const bf16_t* vp = Vp + (size_t)(16 * dt + i) * vpitch + tok0 + g * gstride + 4 * q;
            const u32x2 lo = *(const u32x2*)vp, hi = *(const u32x2*)(vp + 16);
            u32x4 vw; vw.x = lo.x; vw.y = lo.y; vw.z = hi.x; vw.w = hi.y;
            o[dt] = __builtin_amdgcn_mfma_f32_16x16x32_bf16(__builtin_bit_cast(bf16x8, vw), pb, o[dt], 0, 0, 0);
        }
    }
    asm volatile("" ::: "memory");
}

constexpr int KROWB = 144;
template <bool BIAS, bool RING = false>
__device__ __forceinline__ void attn_chunk_lds(const LAS unsigned char* Kl, const LAS unsigned char* Vl, int vpitchB, int tok0, int gstride,
                                               const bf16x8 qf0, const bf16x8 qf1, float& m_run, float& l_run, f32x4 (&o)[4],
                                               const float* rpb_h, int drow0, int kc0, int qc, int lane) {
    const int i = lane & 15, q = lane >> 4;
    f32x4 s[8];
#pragma unroll
    for (int kt = 0; kt < 8; ++kt) {
        const int tg = RING ? ((((gstride + (kt >> 1)) & 7) << 6) + tok0) : (tok0 + (kt >> 1) * gstride);
        const LAS unsigned char* kp = Kl + (tg + (kt & 1) * 16 + i) * KROWB + 16 * q;
        const bf16x8 a0 = *(const LAS bf16x8*)kp, a1 = *(const LAS bf16x8*)(kp + 64);
        f32x4 z = (f32x4){0.f, 0.f, 0.f, 0.f};
        z = __builtin_amdgcn_mfma_f32_16x16x32_bf16(a0, qf0, z, 0, 0, 0);
        s[kt] = __builtin_amdgcn_mfma_f32_16x16x32_bf16(a1, qf1, z, 0, 0, 0);
        if (kt & 1) asm volatile("" ::: "memory");
    }
    if (BIAS) {
        const int cs = min(max(qc - 8, 0), 48);
        int off[8]; bool ok[8];
#pragma unroll
        for (int ee = 0; ee < 8; ++ee) { const int kc = kc0 + (ee >> 2) * 16 + 4 * q + (ee & 3); ok[ee] = (unsigned)(kc - cs) < 16u; off[ee] = min(max(kc - qc + 15, 0), 30); }
#pragma unroll
        for (int g = 0; g < 4; ++g) {
            const float* rp = rpb_h + (g + drow0) * 31;
#pragma unroll
            for (int ee = 0; ee < 8; ++ee) { const float bv = rp[off[ee]]; const float sv = s[2 * g + (ee >> 2)][ee & 3]; s[2 * g + (ee >> 2)][ee & 3] = ok[ee] ? sv + bv : -1e30f; }
        }
    }
    float mx = -1e30f;
#pragma unroll
    for (int kt = 0; kt < 8; ++kt) mx = fmaxf(mx, fmaxf(fmaxf(s[kt][0], s[kt][1]), fmaxf(s[kt][2], s[kt][3])));
    mx = fmaxf(mx, __shfl_xor(mx, 16)); mx = fmaxf(mx, __shfl_xor(mx, 32));
    const float m_new = fmaxf(m_run, mx), alpha = __expf(m_run - m_new);
    float ls = 0.f;
#pragma unroll
    for (int kt = 0; kt < 8; ++kt)
#pragma unroll
        for (int j = 0; j < 4; ++j) { const float p = __expf(s[kt][j] - m_new); s[kt][j] = p; ls += p; }
    ls += __shfl_xor(ls, 16); ls += __shfl_xor(ls, 32);
    l_run = l_run * alpha + ls; m_run = m_new;
#pragma unroll
    for (int dt = 0; dt < 4; ++dt) o[dt] = o[dt] * alpha;
#pragma unroll
    for (int g = 0; g < 4; ++g) {
        u32x4 pw; pw.x = cvt_pk_bf16(s[2 * g][0], s[2 * g][1]); pw.y = cvt_pk_bf16(s[2 * g][2], s[2 * g][3]);
        pw.z = cvt_pk_bf16(s[2 * g + 1][0], s[2 * g + 1][1]); pw.w = cvt_pk_bf16(s[2 * g + 1][2], s[2 * g + 1][3]);
        const bf16x8 pb = __builtin_bit_cast(bf16x8, pw);
#pragma unroll
        for (int dt = 0; dt < 4; ++dt) {
            const int tgv = RING ? ((((gstride + g) & 7) << 6) + tok0) : (tok0 + g * gstride);
            const LAS unsigned char* vp = Vl + (16 * dt + i) * vpitchB + (tgv + 4 * q) * 2;
            const u32x2 lo = *(const LAS u32x2*)vp, hi = *(const LAS u32x2*)(vp + 32);
            u32x4 vw; vw.x = lo.x; vw.y = lo.y; vw.z = hi.x; vw.w = hi.y;
            o[dt] = __builtin_amdgcn_mfma_f32_16x16x32_bf16(__builtin_bit_cast(bf16x8, vw), pb, o[dt], 0, 0, 0);
        }
        asm volatile("" ::: "memory");
    }
}
__device__ __forceinline__ void attn_chunk_lds2(const LAS unsigned char* Kl, const LAS unsigned char* Vl, int vpitchB, int tok0, int gstride,
                                                const bf16x8 qa0, const bf16x8 qa1, const bf16x8 qb0, const bf16x8 qb1,
                                                float (&m_run)[2], float (&l_run)[2], f32x4 (&o)[2][4], int lane) {
    const int i = lane & 15, q = lane >> 4;
    f32x4 s[2][8];
#pragma unroll
    for (int kt = 0; kt < 8; ++kt) {
        const LAS unsigned char* kp = Kl + (tok0 + (kt >> 1) * gstride + (kt & 1) * 16 + i) * KROWB + 16 * q;
        const bf16x8 a0 = *(const LAS bf16x8*)kp, a1 = *(const LAS bf16x8*)(kp + 64);
        f32x4 za = (f32x4){0.f, 0.f, 0.f, 0.f}, zb = (f32x4){0.f, 0.f, 0.f, 0.f};
        za = __builtin_amdgcn_mfma_f32_16x16x32_bf16(a0, qa0, za, 0, 0, 0); zb = __builtin_amdgcn_mfma_f32_16x16x32_bf16(a0, qb0, zb, 0, 0, 0);
        s[0][kt] = __builtin_amdgcn_mfma_f32_16x16x32_bf16(a1, qa1, za, 0, 0, 0); s[1][kt] = __builtin_amdgcn_mfma_f32_16x16x32_bf16(a1, qb1, zb, 0, 0, 0);
        if (kt & 1) asm volatile("" ::: "memory");
    }
#pragma unroll
    for (int u = 0; u < 2; ++u) {
        float mx = -1e30f;
#pragma unroll
        for (int kt = 0; kt < 8; ++kt) mx = fmaxf(mx, fmaxf(fmaxf(s[u][kt][0], s[u][kt][1]), fmaxf(s[u][kt][2], s[u][kt][3])));
        mx = fmaxf(mx, __shfl_xor(mx, 16)); mx = fmaxf(mx, __shfl_xor(mx, 32));
        const float m_new = fmaxf(m_run[u], mx), alpha = __expf(m_run[u] - m_new);
        float ls = 0.f;
#pragma unroll
        for (int kt = 0; kt < 8; ++kt)
#pragma unroll
            for (int j = 0; j < 4; ++j) { const float p = __expf(s[u][kt][j] - m_new); s[u][kt][j] = p; ls += p; }
        ls += __shfl_xor(ls, 16); ls += __shfl_xor(ls, 32);
        l_run[u] = l_run[u] * alpha + ls; m_run[u] = m_new;
#pragma unroll
        for (int dt = 0; dt < 4; ++dt) o[u][dt] = o[u][dt] * alpha;
    }
#pragma unroll
    for (int g = 0; g < 4; ++g) {
        bf16x8 pb[2];
#pragma unroll
        for (int u = 0; u < 2; ++u) { u32x4 pw; pw.x = cvt_pk_bf16(s[u][2 * g][0], s[u][2 * g][1]); pw.y = cvt_pk_bf16(s[u][2 * g][2], s[u][2 * g][3]);
            pw.z = cvt_pk_bf16(s[u][2 * g + 1][0], s[u][2 * g + 1][1]); pw.w = cvt_pk_bf16(s[u][2 * g + 1][2], s[u][2 * g + 1][3]); pb[u] = __builtin_bit_cast(bf16x8, pw); }
#pragma unroll
        for (int dt = 0; dt < 4; ++dt) {
            const LAS unsigned char* vp = Vl + (16 * dt + i) * vpitchB + (tok0 + g * gstride + 4 * q) * 2;
            const u32x2 lo = *(const LAS u32x2*)vp, hi = *(const LAS u32x2*)(vp + 32);
            u32x4 vw; vw.x = lo.x; vw.y = lo.y; vw.z = hi.x; vw.w = hi.y;
            const bf16x8 va = __builtin_bit_cast(bf16x8, vw);
            o[0][dt] = __builtin_amdgcn_mfma_f32_16x16x32_bf16(va, pb[0], o[0][dt], 0, 0, 0);
            o[1][dt] = __builtin_amdgcn_mfma_f32_16x16x32_bf16(va, pb[1], o[1][dt], 0, 0, 0);
        }
        asm volatile("" ::: "memory");
    }
}
__device__ __forceinline__ void stage_k(const bf16_t* src, int pitch, int nkeys, LAS unsigned char* dst, int tid) {
    for (int idx = tid; idx < nkeys * 8; idx += 512) { const int row = idx >> 3, ch = idx & 7; const u32x4 v = *(const u32x4*)(src + (size_t)row * pitch + ch * 8); *(LAS u32x4*)(dst + row * KROWB + ch * 16) = v; }
}
__device__ __forceinline__ void stage_vt(const bf16_t* src, int pitch, int nkeys, LAS unsigned char* dst, int vpitchB, int tid) {
    const int nch = nkeys >> 3, sh = nkeys == 512 ? 6 : 5;
    for (int idx = tid; idx < 64 * nch; idx += 512) { const int d = idx >> sh, ch = idx & (nch - 1); const u32x4 v = *(const u32x4*)(src + (size_t)d * pitch + ch * 8); *(LAS u32x4*)(dst + d * vpitchB + ch * 16) = v; }
}

template <int NK> struct KVRegs { u32x4 k[NK / 64]; u32x4 v[NK / 64]; };
template <int NK> __device__ __forceinline__ void kv_load(KVRegs<NK>& R, const bf16_t* ksrc, int kpitch, const bf16_t* vsrc, int vpitch, int tid) {
    constexpr int NCH = NK / 8, SH = NK == 512 ? 6 : 5;
#pragma unroll
    for (int j = 0; j < NK / 64; ++j) { const int idx = tid + 512 * j; const int row = idx >> 3, ch = idx & 7; R.k[j] = *(const u32x4*)(ksrc + (size_t)row * kpitch + ch * 8);
        const int d = idx >> SH, c2 = idx & (NCH - 1); R.v[j] = *(const u32x4*)(vsrc + (size_t)d * vpitch + c2 * 8); }
}
template <int NK> __device__ __forceinline__ void kv_store(const KVRegs<NK>& R, LAS unsigned char* Kl, LAS unsigned char* Vl, int vpitchB, int tid) {
    constexpr int NCH = NK / 8, SH = NK == 512 ? 6 : 5;
#pragma unroll
    for (int j = 0; j < NK / 64; ++j) { const int idx = tid + 512 * j; const int row = idx >> 3, ch = idx & 7; *(LAS u32x4*)(Kl + row * KROWB + ch * 16) = R.k[j];
        const int d = idx >> SH, c2 = idx & (NCH - 1); *(LAS u32x4*)(Vl + d * vpitchB + c2 * 16) = R.v[j]; }
}

template <int NK> struct KRegs { u32x4 k[NK / 64]; };
template <int NK> __device__ __forceinline__ void k_load(KRegs<NK>& R, const bf16_t* ksrc, int kpitch, int tid) {
#pragma unroll
    for (int j = 0; j < NK / 64; ++j) { const int idx = tid + 512 * j; const int row = idx >> 3, ch = idx & 7; R.k[j] = *(const u32x4*)(ksrc + (size_t)row * kpitch + ch * 8); }
}
template <int NK> __device__ __forceinline__ void k_store(const KRegs<NK>& R, LAS unsigned char* Kl, int tid) {
#pragma unroll
    for (int j = 0; j < NK / 64; ++j) { const int idx = tid + 512 * j; const int row = idx >> 3, ch = idx & 7; *(LAS u32x4*)(Kl + row * KROWB + ch * 16) = R.k[j]; }
}
__device__ __forceinline__ void attn_phase(const Args& a, LAS unsigned char* lds, int tid, int wave, int lane, int bid, int G) {
    const bf16_t* Q = (const bf16_t*)(a.ws + WS_Q); const bf16_t* Kb = (const bf16_t*)(a.ws + WS_K); const bf16_t* Vt = (const bf16_t*)(a.ws + WS_VT);
    const bf16_t* Kc = (const bf16_t*)(a.ws + WS_KC); const bf16_t* Vtc = (const bf16_t*)(a.ws + WS_VTC);
    bf16_t* O = (bf16_t*)(a.ws + WS_A2);
    const int i = lane & 15, q = lane >> 4;
    LAS unsigned char* Kl = lds; LAS unsigned char* Vl = lds + 73728;
    LAS float* scr = (LAS float*)(lds + 36864);
    constexpr int VP256 = 528, VP512 = 1040;
    for (int bh = bid; bh < NB_P * NH; bh += G) {
        const int b = bh >> 4, h = bh & 15;
        __syncthreads();
        stage_k(Kb + (size_t)b * SEQ_P * DM + h * HD, DM, 256, Kl, tid);
        stage_vt(Vt + (size_t)bh * HD * SEQ_P, SEQ_P, 256, Vl, VP256, tid);
        __syncthreads();
        {
            const size_t qrow = (size_t)b * SEQ_P + wave * 32;
            const bf16_t* qp = Q + (qrow + i) * DM + h * HD + 8 * q;
            const bf16x8 qa0 = *(const bf16x8*)qp, qa1 = *(const bf16x8*)(qp + 32), qb0 = *(const bf16x8*)(qp + 16 * DM), qb1 = *(const bf16x8*)(qp + 16 * DM + 32);
            float m_run[2] = {-1e30f, -1e30f}, l_run[2] = {0.f, 0.f}; f32x4 o[2][4];
#pragma unroll
            for (int u = 0; u < 2; ++u)
#pragma unroll
                for (int dt = 0; dt < 4; ++dt) o[u][dt] = (f32x4){0.f, 0.f, 0.f, 0.f};
#pragma unroll 1
            for (int c = 0; c < 2; ++c) attn_chunk_lds2(Kl, Vl, VP256, c * 128, 32, qa0, qa1, qb0, qb1, m_run, l_run, o, lane);
#pragma unroll
            for (int u = 0; u < 2; ++u) { const float inv = 1.0f / l_run[u];
                bf16_t* op = O + (qrow + 16 * u + i) * DM + h * HD + 4 * q;
#pragma unroll
                for (int dt = 0; dt < 4; ++dt) { u32x2 w; w.x = cvt_pk_bf16(o[u][dt][0] * inv, o[u][dt][1] * inv); w.y = cvt_pk_bf16(o[u][dt][2] * inv, o[u][dt][3] * inv); *(u32x2*)(op + 16 * dt) = w; } }
        }
    }
    const int jb = wave & 3, half = wave >> 2;
    const int kb0 = min(max(jb * 16 - 8, 0), 32);
    for (int unit = bid; unit < NB_S * NH * 4; unit += G) {
        const int quad = unit & 3, bh = unit >> 2, b = bh >> 4, h = bh & 15;
        const float* rpb_h = a.in[15] + (size_t)h * 15 * 31;
        const bf16_t* Kg = Kb + ((size_t)MP + (size_t)b * SEQ_S) * DM + h * HD;
        const bf16_t* Vg = Vt + (size_t)MP * DM + (size_t)bh * HD * SEQ_S;
        float m_run[4], l_run[4]; f32x4 o[4][4];
        const int rfirst = 4 * quad, r0first = min(max(rfirst - 4, 0), 8);
        __syncthreads();
#pragma unroll
        for (int w8 = 0; w8 < 8; ++w8) { const int wrow = r0first + w8, slot = wrow & 7;
            { const int key = tid >> 3, ch = tid & 7; *(LAS u32x4*)(Kl + (slot * 64 + key) * KROWB + ch * 16) = *(const u32x4*)(Kg + (size_t)(wrow * 64 + key) * DM + ch * 8); }
            { const int d = tid >> 3, ch = tid & 7; *(LAS u32x4*)(Vl + d * VP512 + (slot * 64) * 2 + ch * 16) = *(const u32x4*)(Vg + (size_t)d * SEQ_S + wrow * 64 + ch * 8); } }
        __syncthreads();
#pragma unroll
        for (int k = 0; k < 4; ++k) {
            const int r = rfirst + k, r0 = min(max(r - 4, 0), 8);
            if (k > 0 && r0 != min(max(r - 5, 0), 8)) {
                __syncthreads();
                const int wrow = r0 + 7, slot = wrow & 7;
                { const int key = tid >> 3, ch = tid & 7; *(LAS u32x4*)(Kl + (slot * 64 + key) * KROWB + ch * 16) = *(const u32x4*)(Kg + (size_t)(wrow * 64 + key) * DM + ch * 8); }
                { const int d = tid >> 3, ch = tid & 7; *(LAS u32x4*)(Vl + d * VP512 + (slot * 64) * 2 + ch * 16) = *(const u32x4*)(Vg + (size_t)d * SEQ_S + wrow * 64 + ch * 8); }
                __syncthreads();
            }
            const size_t qrow = (size_t)MP + (size_t)b * SEQ_S + r * 64 + jb * 16;
            const bf16_t* qp = Q + (qrow + i) * DM + h * HD + 8 * q;
            const bf16x8 qf0 = *(const bf16x8*)qp, qf1 = *(const bf16x8*)(qp + 32);
            m_run[k] = -1e30f; l_run[k] = 0.f;
#pragma unroll
            for (int dt = 0; dt < 4; ++dt) o[k][dt] = (f32x4){0.f, 0.f, 0.f, 0.f};
            attn_chunk_lds<true, true>(Kl, Vl, VP512, kb0, r0 + 4 * half, qf0, qf1, m_run[k], l_run[k], o[k], rpb_h, r0 + 4 * half - r + 7, kb0, jb * 16 + i, lane);
        }
        __syncthreads();
        stage_k(Kc + (size_t)bh * PAST * HD, HD, 256, Kl, tid);
        stage_vt(Vtc + (size_t)bh * HD * PAST, PAST, 256, Vl, VP256, tid);
        __syncthreads();
#pragma unroll
        for (int k = 0; k < 4; ++k) {
            const int r = rfirst + k;
            const size_t qrow = (size_t)MP + (size_t)b * SEQ_S + r * 64 + jb * 16;
            const bf16_t* qp = Q + (qrow + i) * DM + h * HD + 8 * q;
            const bf16x8 qf0 = *(const bf16x8*)qp, qf1 = *(const bf16x8*)(qp + 32);
            attn_chunk_lds<false>(Kl, Vl, VP256, half * 128, 32, qf0, qf1, m_run[k], l_run[k], o[k], nullptr, 0, 0, 0, lane);
        }
#pragma unroll
        for (int rnd = 0; rnd < 2; ++rnd) {
            if (half == 1) {
#pragma unroll
                for (int kk = 0; kk < 2; ++kk) { const int k = 2 * rnd + kk; LAS float* sp = scr + (kk * 4 + jb) * 18 * 64 + lane;
                    sp[0] = m_run[k]; sp[64] = l_run[k];
#pragma unroll
                    for (int dt = 0; dt < 4; ++dt)
#pragma unroll
                        for (int j = 0; j < 4; ++j) sp[(2 + dt * 4 + j) * 64] = o[k][dt][j]; }
            }
            __syncthreads();
            if (half == 0) {
#pragma unroll
                for (int kk = 0; kk < 2; ++kk) { const int k = 2 * rnd + kk; const LAS float* sp = scr + (kk * 4 + jb) * 18 * 64 + lane;
                    const float m2 = sp[0], l2 = sp[64], mm = fmaxf(m_run[k], m2), a1 = __expf(m_run[k] - mm), a2 = __expf(m2 - mm);
                    const float inv = 1.0f / (l_run[k] * a1 + l2 * a2);
                    const size_t qrow = (size_t)MP + (size_t)b * SEQ_S + (rfirst + k) * 64 + jb * 16;
                    bf16_t* op = O + (qrow + i) * DM + h * HD + 4 * q;
#pragma unroll
                    for (int dt = 0; dt < 4; ++dt) { float v[4];
#pragma unroll
                        for (int j = 0; j < 4; ++j) v[j] = (o[k][dt][j] * a1 + sp[(2 + dt * 4 + j) * 64] * a2) * inv;
                        u32x2 w; w.x = cvt_pk_bf16(v[0], v[1]); w.y = cvt_pk_bf16(v[2], v[3]); *(u32x2*)(op + 16 * dt) = w; } }
            }
            __syncthreads();
        }
    }
    __syncthreads();
}

__device__ __forceinline__ void gate_fixup(const Args& a, int layer, int pm, int tid) {
    const float* SB = (const float*)(a.ws + WS_SB); bf16_t* A3 = (bf16_t*)(a.ws + WS_A3);
    const float* cw = a.in[18] + (size_t)layer * 3 * DFF; const float* cbias = a.in[19] + (size_t)layer * DFF;
    const int T = pm - 32, pos = T & 3;
    const float* sT = SB + (size_t)T * 6 * DFF;
    for (int c = tid; c < DFF; c += 512) {
        const float w0 = cw[c], w1 = cw[DFF + c], w2 = cw[2 * DFF + c], cb = cbias[c];
        if (pos > 0) { const float up = sT[c - 6 * DFF + 4 * DFF], uc = sT[c], dn = sT[DFF + c], g = sT[2 * DFF + c];
            A3[(size_t)(pm * 256) * DFF + c] = f2bf(pg8::gelu_tanh_f(w0 * up + w1 * uc + w2 * dn + cb) * g); }
        if (pos < 3) { const float up = sT[3 * DFF + c], uc = sT[4 * DFF + c], dn = sT[6 * DFF + c], g = sT[5 * DFF + c];
            A3[(size_t)(pm * 256 + 255) * DFF + c] = f2bf(pg8::gelu_tanh_f(w0 * up + w1 * uc + w2 * dn + cb) * g); }
    }
    asm volatile("s_waitcnt vmcnt(0)" ::: "memory");
    __syncthreads();
}

#define XB_TMO      128
#define XB_XCNT(j)  (256  + 64 * (j))
#define XB_XSUB(j)  (1280 + 64 * (j))
#define XB_XGEN(j)  (2304 + 64 * (j))
#define XB_TOP      3328
#define XB_TOPGEN   3392
#define XCD_BAR_WORDS 3456
#define XB_SPIN_CAP (1u << 22)
__device__ __forceinline__ unsigned xb_ld(unsigned* p)              { return __hip_atomic_load(p, __ATOMIC_RELAXED, __HIP_MEMORY_SCOPE_AGENT); }
__device__ __forceinline__ unsigned xb_add(unsigned* p, unsigned v) { return __hip_atomic_fetch_add(p, v, __ATOMIC_RELAXED, __HIP_MEMORY_SCOPE_AGENT); }
__device__ __forceinline__ unsigned xb_xcc_id() { return (unsigned)__builtin_amdgcn_s_getreg((3 << 11) | 20) & 0xFu; }
#define XB_SPIN(cond, bar) do { unsigned _sp = 0; while (cond) { __builtin_amdgcn_s_sleep(1); \
    if ((++_sp & 255u) == 0u) { if (xb_ld(&(bar)[XB_TMO])) break; if (_sp > XB_SPIN_CAP) { atomicAdd(&(bar)[XB_TMO], 1u); break; } } } } while (0)
struct XcdBarrier { unsigned* bar; unsigned x; volatile LAS unsigned* st; };
__device__ __forceinline__ void xcd_barrier_complete(unsigned* bar, unsigned x, unsigned G, unsigned& nloc, unsigned& nx) {
    unsigned sum, cnt, mine, sp = 0u;
    for (;;) {
        sum = 0u; cnt = 0u; mine = 0u;
#pragma unroll
        for (unsigned j = 0; j < 16; ++j) { const unsigned c = xb_ld(&bar[XB_XCNT(j)]); sum += c; cnt += (c > 0u) ? 1u : 0u; mine = (j == x) ? c : mine; }
        if (sum == G) break;
        __builtin_amdgcn_s_sleep(1);
        if ((++sp & 255u) == 0u) { if (xb_ld(&bar[XB_TMO])) break; if (sp > XB_SPIN_CAP) { atomicAdd(&bar[XB_TMO], 1u); break; } }
    }
    nloc = mine > 0u ? mine : 1u; nx = cnt > 0u ? cnt : 1u;
}
__device__ __forceinline__ void xcd_barrier(const XcdBarrier& b, int tid, unsigned G) {
    asm volatile("s_waitcnt vmcnt(0)" ::: "memory");
    __syncthreads();
    if (tid == 0) {
        unsigned* bar = b.bar;
        __builtin_amdgcn_s_waitcnt(0);
        unsigned nloc = b.st[0], nx = b.st[1];
        if (nloc == 0u) { xcd_barrier_complete(bar, b.x, G, nloc, nx); b.st[0] = nloc; b.st[1] = nx; }
        const unsigned old = xb_add(&bar[XB_XSUB(b.x)], 1u);
        const unsigned gen = old / nloc;
        if (old + 1u == (gen + 1u) * nloc) {
            __builtin_amdgcn_fence(__ATOMIC_RELEASE, "agent");
            asm volatile("s_waitcnt vmcnt(0)" ::: "memory");
            const unsigned og = xb_add(&bar[XB_TOP], 1u);
            const unsigned tg = og / nx;
            if (og + 1u == (tg + 1u) * nx) xb_add(&bar[XB_TOPGEN], 1u);
            else XB_SPIN(xb_ld(&bar[XB_TOPGEN]) == tg, bar);
            __builtin_amdgcn_fence(__ATOMIC_ACQUIRE, "agent");
            xb_add(&bar[XB_XGEN(b.x)], 1u);
            asm volatile("s_waitcnt vmcnt(0)" ::: "memory");
        } else {
            XB_SPIN(xb_ld(&bar[XB_XGEN(b.x)]) == gen, bar);
            __builtin_amdgcn_fence(__ATOMIC_ACQUIRE, "agent");
            asm volatile("s_waitcnt vmcnt(0)" ::: "memory");
        }
    }
    __syncthreads();
}

__global__ void __launch_bounds__(512, 2) fwd_kernel(Args a) {
    extern __shared__ __attribute__((aligned(16))) unsigned char lds_raw[];
    LAS unsigned char* lds = (LAS unsigned char*)lds_raw;
    unsigned char* ws = a.ws;
    XcdBarrier xb; xb.bar = (unsigned*)(ws + WS_CTL); xb.x = xb_xcc_id(); xb.st = (volatile LAS unsigned*)(lds + LDS_BYTES - 64);
    if (threadIdx.x == 0) { xb.st[0] = 0u; xb.st[1] = 0u; if (a.ph_hi - a.ph_lo > 1) (void)xb_add(&xb.bar[XB_XCNT(xb.x)], 1u); }
    __syncthreads();
#ifndef PROBE_MASK
#define PROBE_MASK 0
#endif
    for (int ph = a.ph_lo; ph < a.ph_hi; ++ph) {
      if (ph == 5 || ph == 9 || ph == 13 || ph == 17 || ph == 7 || ph == 15) continue;
      if (ph == 1 && a.ph_lo == 0) continue;
      for (int rep = 0; rep < (((PROBE_MASK >> ph) & 1) ? 3 : 1); ++rep) {
        if (ph > a.ph_lo || rep > 0) { if (a.ph_hi > NPH + 1000) cg::this_grid().sync();
          xcd_barrier(xb, threadIdx.x, gridDim.x); }
        int tid = threadIdx.x, bid = blockIdx.x, G = gridDim.x;
        asm volatile("" : "+v"(tid)); asm volatile("" : "+s"(bid)); asm volatile("" : "+s"(G));
        const int lane = tid & 63, wave = __builtin_amdgcn_readfirstlane(tid >> 6);
        if (ph == 0) {
#ifndef DIS_P0
 prologue(a, lds, tid, wave, lane, bid, G);
            if (a.ph_hi > 1) {
                if (tid == 0) { unsigned sp = 0; unsigned* mc = (unsigned*)(ws + WS_CTL) + CW_MODCNT;
                    while (__hip_atomic_load(mc, __ATOMIC_RELAXED, __HIP_MEMORY_SCOPE_AGENT) < 2u * (DM / 32)) { __builtin_amdgcn_s_sleep(2); if (++sp > (1u << 22)) break; }
                    __builtin_amdgcn_fence(__ATOMIC_ACQUIRE, "agent"); asm volatile("s_waitcnt vmcnt(0)" ::: "memory"); }
                __syncthreads();
                norm_phase(a, 1, wave, lane, bid, G);
            }
#endif
 }
        else if (ph == 1 || ph == 5 || ph == 9 || ph == 13 || ph == 17) {
#ifndef DIS_NORM
 norm_phase(a, ph, wave, lane, bid, G);
#endif
 }
        else if (ph == 3) {
#ifndef DIS_CONV
 convgate_phase(a, tid, bid, G);
#endif
 }
        else if (ph == 11) {
#ifndef DIS_ATTN
 attn_phase(a, lds, tid, wave, lane, bid, G);
#endif
 }
        else if (ph == 2) {
            pg8::Gemm g{(const bf16_t*)(ws + WS_H), (const bf16_t*)(ws + WS_WIN), MT, 3 * DM, DM}; pg8::EpiBf16 E{(bf16_t*)(ws + WS_BCX), 3 * DM};
            pg8::StaticOrder S; S.init(g.M, g.N, G, bid);
            pg8::gemm_phase<pg8::EpiBf16, pg8::StaticOrder>(lds, g, S, E, tid);
        }
        else if (ph == 6 || ph == 14) {
            const int l = ph == 14 ? 1 : 0;
            pg8::Gemm g{(const bf16_t*)(ws + WS_H), (const bf16_t*)(ws + WS_WUP) + (size_t)l * DM * 2 * DFF, MT, 2 * DFF, DM};
            pg8::EpiGate E{(bf16_t*)(ws + WS_A3), a.in[18] + (size_t)l * 3 * DFF, a.in[19] + (size_t)l * DFF, (float*)(ws + WS_SB)};
            pg8::StaticOrder S; S.init(g.M, g.N, G, bid);
            pg8::gemm_phase<pg8::EpiGate, pg8::StaticOrder>(lds, g, S, E, tid);
        }
        else if (ph == 10) {
            pg8::Gemm g{(const bf16_t*)(ws + WS_HB), (const bf16_t*)(ws + WS_WQKV), MT, 3 * DM, DM};
            float* sk = a.out + (size_t)MT * DM; float* sv = sk + (size_t)NB_P * NH * SEQ_P * HD;
            pg8::EpiQKV E{(bf16_t*)(ws + WS_Q), (bf16_t*)(ws + WS_K), (bf16_t*)(ws + WS_VT), sk, sv};
            pg8::StaticOrder S; S.init(g.M, g.N, G, bid);
#ifndef DIS_G2
            pg8::gemm_phase<pg8::EpiQKV, pg8::StaticOrder>(lds, g, S, E, tid);
#endif
        }
        else {
            pg8::Gemm g; pg8::EpiResNorm E;
            const float* MOD0 = (const float*)(ws + WS_MOD); const float* MOD1 = MOD0 + (size_t)NCV * MODW;
            float* X = a.out; float* XS = a.out + (size_t)MP * DM;
            float* xch = (float*)(ws + WS_XCH); unsigned* cnt = (unsigned*)(ws + WS_CTL) + CW_CNT;
            bf16_t* HA = (bf16_t*)(ws + WS_H); bf16_t* HB = (bf16_t*)(ws + WS_HB);
            if (ph == 4) { g = pg8::Gemm{(const bf16_t*)(ws + WS_A2), (const bf16_t*)(ws + WS_WOUT), MT, DM, DM};
                E = pg8::EpiResNorm{a.in[0], a.in[1], X, MOD0 + 2 * DM, HA, a.in[9], MOD0 + 3 * DM, MOD0 + 4 * DM, xch, cnt, 0}; }
            else if (ph == 8) { g = pg8::Gemm{(const bf16_t*)(ws + WS_A3), (const bf16_t*)(ws + WS_WDN), MT, DM, DFF};
                E = pg8::EpiResNorm{X, XS, X, MOD0 + 5 * DM, HB, a.in[8] + DM, MOD1, MOD1 + DM, xch + (size_t)MT * 4, cnt + 48 * 16, 0}; }
            else if (ph == 12) { g = pg8::Gemm{(const bf16_t*)(ws + WS_A2), (const bf16_t*)(ws + WS_WO), MT, DM, DM};
                E = pg8::EpiResNorm{X, XS, X, MOD1 + 2 * DM, HA, a.in[9] + DM, MOD1 + 3 * DM, MOD1 + 4 * DM, xch + (size_t)2 * MT * 4, cnt + 2 * 48 * 16, 0}; }
            else { g = pg8::Gemm{(const bf16_t*)(ws + WS_A3), (const bf16_t*)(ws + WS_WDN) + (size_t)DM * DFF, MT, DM, DFF};
                E = pg8::EpiResNorm{X, XS, X, MOD1 + 5 * DM, HA, a.in[21], MOD1, MOD1, xch + (size_t)3 * MT * 4, cnt + 3 * 48 * 16, 1}; }
            pg8::StaticOrder S; S.init(g.M, g.N, G, bid);
            if (ph != 16 && bid >= 192) {
                const int nidle = G - 192; constexpr int TI_A = TI_R1 + 640, TI_B = TI_R2 - I_DN;
                if (ph == 4) transpose_items(a, lds, TI_R0, TI_A, (bid - 192) * 8 + wave, nidle * 8, wave, lane);
                else if (ph == 8) transpose_items(a, lds, TI_A, TI_B, (bid - 192) * 8 + wave, nidle * 8, wave, lane);
                else transpose_items(a, lds, TI_B, TI_R2, (bid - 192) * 8 + wave, nidle * 8, wave, lane);
            }
            if (ph == 8 || ph == 16) { pg8::Unit u0; if (S.next(0, u0) && u0.pm >= 32) gate_fixup(a, ph == 16 ? 1 : 0, u0.pm, tid); }
#ifndef DIS_G3
            pg8::gemm_phase<pg8::EpiResNorm, pg8::StaticOrder>(lds, g, S, E, tid);
#endif
        }
      }
    }
}

extern "C" void kernel_launch(void* const* d_in, const int* in_sizes, int n_in, void* d_out, int out_size, void* d_ws, size_t ws_size, hipStream_t stream) {
    static int grid = 0;
    if (grid == 0) {
        if (n_in != 22 || ws_size < WS_END) { fprintf(stderr, "kernel_launch: unexpected n_in %d / ws_size %zu\n", n_in, ws_size); grid = -1; return; }
        int dev = 0, cus = 0, per_cu = 0;
        hipGetDevice(&dev); hipDeviceGetAttribute(&cus, hipDeviceAttributeMultiprocessorCount, dev);
        if (hipFuncSetAttribute((const void*)fwd_kernel, hipFuncAttributeMaxDynamicSharedMemorySize, LDS_BYTES) != hipSuccess) { fprintf(stderr, "hipFuncSetAttribute failed\n"); grid = -1; return; }
        hipOccupancyMaxActiveBlocksPerMultiprocessor(&per_cu, (const void*)fwd_kernel, 512, LDS_BYTES);
        (void)hipGetLastError();
        if (per_cu < 1) { fprintf(stderr, "occupancy query says %d\n", per_cu); per_cu = 1; }
        grid = cus;
    }
    if (grid < 0) return;
    Args a{};
    for (int i = 0; i < 22; ++i) a.in[i] = (const float*)d_in[i];
    a.out = (float*)d_out; a.ws = (unsigned char*)d_ws;
    if (hipMemsetAsync((char*)d_ws + WS_CTL, 0, CTL_BYTES, stream) != hipSuccess) { fprintf(stderr, "memset failed\n"); return; }
#if MK_MULTI
    for (int ph = 0; ph < NPH; ++ph) { a.ph_lo = ph; a.ph_hi = ph + 1; hipLaunchKernelGGL(fwd_kernel, dim3(grid), dim3(512), LDS_BYTES, stream, a); }
#else
    a.ph_lo = 0; a.ph_hi = NPH;
    void* args[] = {&a};
    hipError_t e = hipLaunchCooperativeKernel((const void*)fwd_kernel, dim3(grid), dim3(512), args, LDS_BYTES, stream);
    if (e != hipSuccess) fprintf(stderr, "cooperative launch failed: %s (grid %d)\n", hipGetErrorString(e), grid);
#endif
}
```

```cpp
#include <hip/hip_runtime.h>
#include <hip/hip_cooperative_groups.h>
#include <cstdio>
#include <cstdint>
namespace cg = cooperative_groups;

#ifndef MK_MULTI
#define MK_MULTI 0
#endif

#define LAS __attribute__((address_space(3)))
typedef unsigned short bf16_t;
typedef short bf16x8 __attribute__((ext_vector_type(8)));
typedef float f32x4 __attribute__((ext_vector_type(4)));
typedef float f32x2 __attribute__((ext_vector_type(2)));
typedef unsigned u32x4 __attribute__((ext_vector_type(4)));
typedef unsigned u32x2 __attribute__((ext_vector_type(2)));

constexpr int DM = 1024, NB_P = 32, SEQ_P = 256, NB_S = 4, SEQ_S = 1024, PAST = 256;
constexpr int MP = NB_P * SEQ_P;
constexpr int MS = NB_S * SEQ_S;
constexpr int MT = MP + MS;
constexpr int NH = 16, HD = 64, DFF = 2816, NCV = 5, MODW = 6 * DM;
constexpr float EPS = 1e-6f;
constexpr float LOG2E = 1.4426950408889634f, QSCALE = 0.125f * LOG2E;
constexpr int NPH = 18;

constexpr size_t MiB = 1u << 20;
constexpr size_t WS_WIN = 0, WS_WOUT = 6 * MiB, WS_WQKV = 8 * MiB, WS_WO = 14 * MiB, WS_WUP = 16 * MiB, WS_WDN = 38 * MiB;
constexpr size_t WS_MOD = 49 * MiB, WS_KC = 50 * MiB, WS_VTC = 52 * MiB;
constexpr size_t WS_A3 = 54 * MiB;
constexpr size_t WS_H = 120 * MiB, WS_HB = WS_H;
constexpr size_t WS_BCX = 144 * MiB, WS_A2 = 216 * MiB;
constexpr size_t WS_Q = 144 * MiB, WS_K = 168 * MiB, WS_VT = 192 * MiB;
constexpr size_t WS_CTL = 252 * MiB, CTL_BYTES = 32768;
constexpr size_t WS_XCH = 253 * MiB;
constexpr size_t WS_SB = 254 * MiB;
constexpr size_t WS_END = 256 * MiB;
constexpr int CW_MODCNT = 7900;
constexpr int CW_CNT = 4096;
constexpr int LDS_BYTES = 147456;

struct Args { const float* in[22]; float* out; unsigned char* ws; int ph_lo, ph_hi; };

__device__ __forceinline__ unsigned cvt_pk_bf16(float lo, float hi) { unsigned r; asm volatile("v_cvt_pk_bf16_f32 %0, %1, %2" : "=v"(r) : "v"(lo), "v"(hi)); return r; }
__device__ __forceinline__ float bf_lo(unsigned u) { return __uint_as_float(u << 16); }
__device__ __forceinline__ float bf_hi(unsigned u) { return __uint_as_float(u & 0xffff0000u); }
__device__ __forceinline__ unsigned short f2bf(float f) { return (unsigned short)(cvt_pk_bf16(f, 0.f) & 0xffffu); }

namespace pg8 {
constexpr int BM = 256, BK = 64, HALF = 128, HTB = HALF * BK * 2, STAGE_BYTES = 8 * HTB, NXCD = 8, WGM = 8;
__host__ __device__ __forceinline__ int lds_byte(int r, int c) { const int st = (r >> 4) * 2 + (c >> 5), rr = r & 15, cc = c & 31, ob = rr * 64 + cc * 2; return st * 1024 + (ob ^ (((ob >> 9) & 1) << 5)); }
__host__ __device__ __forceinline__ void stage_rc(int b, int& R, int& C) { const int st = b / 1024, sb = b % 1024, swz = sb ^ (((sb >> 9) & 1) << 5); R = (st >> 1) * 16 + swz / 64; C = (st & 1) * 32 + (swz % 64) / 2; }
__host__ __device__ __forceinline__ int perm32(int rho) { const int n = rho >> 4, i = rho & 15; return 8 * (i >> 2) + 4 * n + (i & 3); }

struct Unit { int pm, pn; };
struct Gemm { const bf16_t* A; const bf16_t* Bt; int M, N, K; };

struct StaticOrder {
    int nM, nN, nwg, G, c;
    __device__ void init(int M, int N, int G_, int c_) { nM = M / BM; nN = N / BM; nwg = nM * nN; G = G_; c = c_; }
    __device__ bool next(int i, Unit& u) const {
        const long L = (long)i * G + c; if (L >= nwg) return false;
        int wgid = (int)L; { const int q = nwg / NXCD, r = nwg % NXCD, xcd = wgid % NXCD, off = wgid / NXCD; wgid = (xcd < r ? xcd * (q + 1) : r * (q + 1) + (xcd - r) * q) + off; }
        const int nig = WGM * nN, gid = wgid / nig, fm = gid * WGM, gsz = (nM - fm) < WGM ? (nM - fm) : WGM;
        u.pm = fm + ((wgid % nig) % gsz); u.pn = (wgid % nig) / gsz; return true;
    }
};

struct EpiBf16 {
    static constexpr bool PERM = true, AFTER_DRAIN = false, NEEDS_LDS = false;
    bf16_t* O; int ldc;
    __device__ __forceinline__ void operator()(const f32x4 (&acc)[2][2][4][2], const Unit& u, int wr, int wc, int fr, int fq) const {
        const int row0 = u.pm * BM + wr * 64 + fr; const int col0 = u.pn * BM + wc * 32 + 8 * fq;
#pragma unroll
        for (int ai = 0; ai < 2; ++ai)
#pragma unroll
            for (int m = 0; m < 4; ++m) { bf16_t* rowp = O + (size_t)(row0 + ai * HALF + m * 16) * ldc + col0;
#pragma unroll
                for (int bj = 0; bj < 2; ++bj) { const f32x4 v0 = acc[ai][bj][m][0], v1 = acc[ai][bj][m][1];
                    u32x4 w; w.x = cvt_pk_bf16(v0[0], v0[1]); w.y = cvt_pk_bf16(v0[2], v0[3]); w.z = cvt_pk_bf16(v1[0], v1[1]); w.w = cvt_pk_bf16(v1[2], v1[3]);
                    *(u32x4*)(rowp + bj * HALF) = w; } }
    }
};

struct EpiRes {
    static constexpr bool PERM = false, AFTER_DRAIN = false, NEEDS_LDS = false;
    const float* base_p; const float* base_s; float* out; const float* gate;
    __device__ __forceinline__ void operator()(const f32x4 (&acc)[2][2][4][2], const Unit& u, int wr, int wc, int fr, int fq) const {
        const int cv = u.pm < 32 ? 0 : 1 + ((u.pm - 32) >> 2);
        const int col0 = u.pn * BM + wc * 32 + 4 * fq;
        const float* gp = gate + cv * MODW + col0;
        f32x4 gv[2][2];
#pragma unroll
        for (int bj = 0; bj < 2; ++bj)
#pragma unroll
            for (int n = 0; n < 2; ++n) gv[bj][n] = *(const f32x4*)(gp + bj * HALF + n * 16);
        const float* bb = u.pm < 32 ? base_p + (size_t)u.pm * BM * DM : base_s + (size_t)(u.pm - 32) * BM * DM;
        float* ob = out + (size_t)u.pm * BM * DM;
#pragma unroll
        for (int ai = 0; ai < 2; ++ai)
#pragma unroll
            for (int m = 0; m < 4; ++m) { const size_t off = (size_t)(ai * HALF + wr * 64 + m * 16 + fr) * DM + col0;
#pragma unroll
                for (int bj = 0; bj < 2; ++bj)
#pragma unroll
                    for (int n = 0; n < 2; ++n) { const f32x4 bs = *(const f32x4*)(bb + off + bj * HALF + n * 16);
                        *(f32x4*)(ob + off + bj * HALF + n * 16) = bs + gv[bj][n] * acc[ai][bj][m][n]; }
                asm volatile("" ::: "memory"); }
    }
};

struct EpiResNorm {
    static constexpr bool PERM = false, AFTER_DRAIN = true, NEEDS_LDS = false;
    const float* base_p; const float* base_s; float* out; const float* gate; bf16_t* H; const float* gn; const float* mod_sh; const float* mod_sc; float* xbuf; unsigned* cnt; int final_mode;
    __device__ __forceinline__ void fused(f32x4 (&acc)[2][2][4][2], const Unit& u, int wr, int wc, int fr, int fq, LAS unsigned char* lds, int wid, int lane) const {
        LAS float* P = (LAS float*)lds;
        LAS float* S = (LAS float*)(lds + 8192);
        const int cv = u.pm < 32 ? 0 : 1 + ((u.pm - 32) >> 2);
        const int col0 = u.pn * BM + wc * 32 + 4 * fq;
        const float* bb = u.pm < 32 ? base_p + (size_t)u.pm * BM * DM : base_s + (size_t)(u.pm - 32) * BM * DM;
        float* ob = out + (size_t)u.pm * BM * DM;
        {   const float* gp = gate + cv * MODW + col0;
            f32x4 gv[2][2];
#pragma unroll
            for (int bj = 0; bj < 2; ++bj)
#pragma unroll
                for (int n = 0; n < 2; ++n) gv[bj][n] = *(const f32x4*)(gp + bj * HALF + n * 16);
#pragma unroll
            for (int ai = 0; ai < 2; ++ai)
#pragma unroll
                for (int m = 0; m < 4; ++m) { const size_t off = (size_t)(ai * HALF + wr * 64 + m * 16 + fr) * DM + col0;
                    float ss = 0.f;
#pragma unroll
                    for (int bj = 0; bj < 2; ++bj)
#pragma unroll
                        for (int n = 0; n < 2; ++n) { const f32x4 bs = *(const f32x4*)(bb + off + bj * HALF + n * 16);
                            const f32x4 x = bs + gv[bj][n] * acc[ai][bj][m][n]; acc[ai][bj][m][n] = x;
                            if (!final_mode) *(f32x4*)(ob + off + bj * HALF + n * 16) = x;
                            ss += (x[0] * x[0] + x[1] * x[1]) + (x[2] * x[2] + x[3] * x[3]); }
                    ss += __shfl_xor(ss, 16); ss += __shfl_xor(ss, 32);
                    if (fq == 0) P[(ai * HALF + wr * 64 + m * 16 + fr) * 4 + wc] = ss;
                    asm volatile("" ::: "memory"); }
        }
        asm volatile("s_waitcnt lgkmcnt(0)" ::: "memory"); __builtin_amdgcn_s_barrier(); asm volatile("" ::: "memory");
        const int row = wid * 32 + (lane & 31);
        if (lane < 32) {
            const float tot = (P[row * 4 + 0] + P[row * 4 + 1]) + (P[row * 4 + 2] + P[row * 4 + 3]);
            __hip_atomic_store(xbuf + ((size_t)(u.pm * BM + row) * 4 + u.pn), tot, __ATOMIC_RELAXED, __HIP_MEMORY_SCOPE_AGENT);
        }
        asm volatile("s_waitcnt vmcnt(0)" ::: "memory");
        if (lane == 0) __hip_atomic_fetch_add(cnt + 16 * u.pm, 1u, __ATOMIC_RELAXED, __HIP_MEMORY_SCOPE_AGENT);
        if (wid == 0) {
            unsigned sp = 0;
            while ((unsigned)__builtin_amdgcn_readfirstlane(__hip_atomic_load(cnt + 16 * u.pm, __ATOMIC_RELAXED, __HIP_MEMORY_SCOPE_AGENT)) < 32u) { __builtin_amdgcn_s_sleep(2); if (++sp > (1u << 22)) break; }
            __builtin_amdgcn_fence(__ATOMIC_ACQUIRE, "agent");
        }
        asm volatile("s_waitcnt vmcnt(0) lgkmcnt(0)" ::: "memory"); __builtin_amdgcn_s_barrier(); asm volatile("" ::: "memory");
        if (lane < 32) {
            const float* slot = xbuf + (size_t)(u.pm * BM + row) * 4; float t = 0.f;
#pragma unroll
            for (int k = 0; k < 4; ++k) t += __hip_atomic_load(slot + k, __ATOMIC_RELAXED, __HIP_MEMORY_SCOPE_AGENT);
            S[row] = 1.0f / sqrtf(t * (1.0f / DM) + EPS);
        }
        asm volatile("s_waitcnt vmcnt(0) lgkmcnt(0)" ::: "memory"); __builtin_amdgcn_s_barrier(); asm volatile("" ::: "memory");
        f32x4 ga[2][2], gb[2][2];
#pragma unroll
        for (int bj = 0; bj < 2; ++bj)
#pragma unroll
            for (int n = 0; n < 2; ++n) { const int c = col0 + bj * HALF + n * 16; const f32x4 g4 = *(const f32x4*)(gn + c);
                if (final_mode) { ga[bj][n] = g4; gb[bj][n] = (f32x4){0.f, 0.f, 0.f, 0.f}; }
                else { const f32x4 sc = *(const f32x4*)(mod_sc + cv * MODW + c), sh = *(const f32x4*)(mod_sh + cv * MODW + c); ga[bj][n] = g4 * (1.0f + sc); gb[bj][n] = sh; } }
#pragma unroll
        for (int ai = 0; ai < 2; ++ai)
#pragma unroll
            for (int m = 0; m < 4; ++m) { const int r = ai * HALF + wr * 64 + m * 16 + fr; const float rstd = S[r]; const size_t off = (size_t)r * DM + col0;
#pragma unroll
                for (int bj = 0; bj < 2; ++bj)
#pragma unroll
                    for (int n = 0; n < 2; ++n) { const f32x4 h = (acc[ai][bj][m][n] * rstd) * ga[bj][n] + gb[bj][n];
                        if (final_mode) __builtin_nontemporal_store(h, (f32x4*)(ob + off + bj * HALF + n * 16));
                        else { u32x2 w; w.x = cvt_pk_bf16(h[0], h[1]); w.y = cvt_pk_bf16(h[2], h[3]); *(u32x2*)(H + (size_t)u.pm * BM * DM + off + bj * HALF + n * 16) = w; } }
            }
    }
};

__device__ __forceinline__ float gelu_tanh_f(float x) {
    const float t = x * x; const float p = __builtin_fmaf(t, -0.10294324f, -2.3022082f);
    return x * __builtin_amdgcn_rcpf(1.0f + __builtin_amdgcn_exp2f(p * x));
}
template <int CTRL> __device__ __forceinline__ float dppf(float oldv, float src) {
    return __int_as_float(__builtin_amdgcn_update_dpp(__float_as_int(oldv), __float_as_int(src), CTRL, 0xf, 0xf, false));
}
struct EpiGate {
    static constexpr bool PERM = true, AFTER_DRAIN = false, NEEDS_LDS = true;
    bf16_t* A3; const float* cw; const float* cbias; float* SB;
    __device__ __forceinline__ void operator()(f32x4 (&acc)[2][2][4][2], const Unit& u, int wr, int wc, int fr, int fq, LAS unsigned char* lds) const {
        LAS float* XU = (LAS float*)(lds + 131072);
        const int c8 = wc * 32 + 8 * fq, gc = u.pn * HALF + c8;
#ifndef NOXU
#pragma unroll
        for (int ai = 0; ai < 2; ++ai) { const int sidx = 2 * ai + wr;
            if (fr == 0)  { *(LAS f32x4*)(XU + (sidx * 2 + 0) * 128 + c8) = acc[ai][0][0][0]; *(LAS f32x4*)(XU + (sidx * 2 + 0) * 128 + c8 + 4) = acc[ai][0][0][1]; }
            if (fr == 15) { *(LAS f32x4*)(XU + (sidx * 2 + 1) * 128 + c8) = acc[ai][0][3][0]; *(LAS f32x4*)(XU + (sidx * 2 + 1) * 128 + c8 + 4) = acc[ai][0][3][1]; } }
#endif
        if (u.pm >= 32) {
            float* sb = SB + (size_t)(u.pm - 32) * 6 * DFF + gc;
            if (wr == 0 && fr < 2) { *(f32x4*)(sb + fr * DFF) = acc[0][0][0][0]; *(f32x4*)(sb + fr * DFF + 4) = acc[0][0][0][1];
                if (fr == 0) { *(f32x4*)(sb + 2 * DFF) = acc[0][1][0][0]; *(f32x4*)(sb + 2 * DFF + 4) = acc[0][1][0][1]; } }
            if (wr == 1 && fr >= 14) { *(f32x4*)(sb + (fr - 11) * DFF) = acc[1][0][3][0]; *(f32x4*)(sb + (fr - 11) * DFF + 4) = acc[1][0][3][1];
                if (fr == 15) { *(f32x4*)(sb + 5 * DFF) = acc[1][1][3][0]; *(f32x4*)(sb + 5 * DFF + 4) = acc[1][1][3][1]; } }
        }
        f32x4 w0[2], w1[2], w2[2], cb[2];
#pragma unroll
        for (int n = 0; n < 2; ++n) { w0[n] = *(const f32x4*)(cw + gc + 4 * n); w1[n] = *(const f32x4*)(cw + DFF + gc + 4 * n); w2[n] = *(const f32x4*)(cw + 2 * DFF + gc + 4 * n); cb[n] = *(const f32x4*)(cbias + gc + 4 * n); }
#ifndef NOXU
        asm volatile("s_waitcnt lgkmcnt(0)" ::: "memory"); __builtin_amdgcn_s_barrier(); asm volatile("" ::: "memory");
#endif
#pragma unroll
        for (int ai = 0; ai < 2; ++ai) { const int sidx = 2 * ai + wr;
            f32x4 top[2], bot[2];
#pragma unroll
            for (int n = 0; n < 2; ++n) {
#ifdef NOXU
                top[n] = (f32x4){0.f,0.f,0.f,0.f}; bot[n] = top[n];
#else
                top[n] = sidx > 0 ? *(const LAS f32x4*)(XU + ((sidx - 1) * 2 + 1) * 128 + c8 + 4 * n) : (f32x4){0.f, 0.f, 0.f, 0.f};
                bot[n] = sidx < 3 ? *(const LAS f32x4*)(XU + ((sidx + 1) * 2 + 0) * 128 + c8 + 4 * n) : (f32x4){0.f, 0.f, 0.f, 0.f};
#endif
            }
#pragma unroll
            for (int m = 0; m < 4; ++m) {
                u32x4 w;
#pragma unroll
                for (int n = 0; n < 2; ++n) { float ov[4];
#pragma unroll
                    for (int j = 0; j < 4; ++j) {
                        const float uc = acc[ai][0][m][n][j];
                        const float upo = m > 0 ? dppf<0x140>(0.f, acc[ai][0][m - 1][n][j]) : top[n][j];
                        const float up = dppf<0x111>(upo, uc);
                        const float dno = m < 3 ? dppf<0x140>(0.f, acc[ai][0][m + 1][n][j]) : bot[n][j];
                        const float dn = dppf<0x101>(dno, uc);
                        const float cv = __builtin_fmaf(w0[n][j], up, __builtin_fmaf(w1[n][j], uc, __builtin_fmaf(w2[n][j], dn, cb[n][j])));
                        ov[j] = gelu_tanh_f(cv) * acc[ai][1][m][n][j]; }
                    if (n == 0) { w.x = cvt_pk_bf16(ov[0], ov[1]); w.y = cvt_pk_bf16(ov[2], ov[3]); } else { w.z = cvt_pk_bf16(ov[0], ov[1]); w.w = cvt_pk_bf16(ov[2], ov[3]); } }
                *(u32x4*)(A3 + (size_t)(u.pm * BM + ai * HALF + wr * 64 + m * 16 + fr) * DFF + gc) = w;
            }
        }
#ifndef NOXU
        asm volatile("s_waitcnt lgkmcnt(0)" ::: "memory"); __builtin_amdgcn_s_barrier(); asm volatile("" ::: "memory");
#endif
    }
};

struct EpiQKV {
    static constexpr bool PERM = false, AFTER_DRAIN = false, NEEDS_LDS = false;
    bf16_t* Q; bf16_t* Kb; bf16_t* Vt; float* sk; float* sv;
    __device__ __forceinline__ void operator()(const f32x4 (&acc)[2][2][4][2], const Unit& u, int wr, int wc, int fr, int fq) const {
        const int which = u.pn >> 2; const int cb = (u.pn & 3) * BM + wc * 32 + 4 * fq;
        const bool prompt = u.pm < 32;
        const int bidx = prompt ? u.pm : ((u.pm - 32) >> 2);
        const int tbase = (prompt ? 0 : ((u.pm - 32) & 3) * 256) + wr * 64 + fr;
        const int T = prompt ? SEQ_P : SEQ_S;
#pragma unroll
        for (int ai = 0; ai < 2; ++ai)
#pragma unroll
            for (int m = 0; m < 4; ++m) {
                const int t = tbase + ai * HALF + m * 16; const size_t row = (size_t)u.pm * BM + ai * HALF + wr * 64 + m * 16 + fr;
#pragma unroll
                for (int bj = 0; bj < 2; ++bj)
#pragma unroll
                    for (int n = 0; n < 2; ++n) { const int c = cb + bj * HALF + n * 16; const f32x4 v = acc[ai][bj][m][n];
                        if (which == 0) { u32x2 w; w.x = cvt_pk_bf16(v[0] * QSCALE, v[1] * QSCALE); w.y = cvt_pk_bf16(v[2] * QSCALE, v[3] * QSCALE); *(u32x2*)(Q + row * DM + c) = w; }
                        else if (which == 1) { u32x2 w; w.x = cvt_pk_bf16(v[0], v[1]); w.y = cvt_pk_bf16(v[2], v[3]); *(u32x2*)(Kb + row * DM + c) = w;
                            if (prompt) __builtin_nontemporal_store(v, (f32x4*)(sk + ((size_t)(bidx * NH + (c >> 6)) * SEQ_P + t) * HD + (c & 63))); }
                        else { const int h = c >> 6, d = c & 63;
                            if (prompt) __builtin_nontemporal_store(v, (f32x4*)(sv + ((size_t)(bidx * NH + h) * SEQ_P + t) * HD + d));
                            bf16_t* vp = Vt + (prompt ? 0 : (size_t)MP * DM) + ((size_t)(bidx * NH + h) * HD + d) * T + t;
                            vp[0] = f2bf(v[0]); vp[T] = f2bf(v[1]); vp[2 * T] = f2bf(v[2]); vp[3 * T] = f2bf(v[3]); }
                    }
            }
    }
};

template <class Epi, class Sched>
__device__ __forceinline__ void gemm_phase(LAS unsigned char* lds, const Gemm g, const Sched& S, const Epi& E, const int tid) {
    const int wid = __builtin_amdgcn_readfirstlane(tid >> 6), lane = tid & 63, wr = wid >> 2, wc = wid & 3, fr = lane & 15, fq = lane >> 4;
    const int K = g.K, nt = K / BK;
    unsigned voffA[2], voffB[2];
#pragma unroll
    for (int i = 0; i < 2; ++i) { int R, C; stage_rc(tid * 16 + i * 8192, R, C); const int Rb = Epi::PERM ? ((R & ~31) + perm32(R & 31)) : R;
        voffA[i] = (unsigned)(R * K + C) * 2u; voffB[i] = (unsigned)(Rb * K + C) * 2u; }
    const size_t kstep = (size_t)(BK * 2);
    const size_t hstep = (size_t)HALF * K * 2;
    const size_t tstep = 2 * hstep;
    const unsigned ldsw = (unsigned)wid * 1024u;
    const int aoff = lds_byte(wr * 64 + fr, fq * 8), boff = lds_byte(wc * 32 + fr, fq * 8);
#define PG8_SA(b, h) (((b) * 2 + (h)) * HTB)
#define PG8_SB(b, h) ((4 + (b) * 2 + (h)) * HTB)
#define PG8_STAGE(bufoff, gbase, voff) do { _Pragma("unroll") for (int _i = 0; _i < 2; ++_i) \
        __builtin_amdgcn_global_load_lds((const unsigned*)((const char*)(gbase) + (voff)[_i]), (LAS unsigned*)(lds + (bufoff) + ldsw + _i * 8192), 16, 0, 0); } while (0)
#define PG8_LDA(dst, b, h) do { _Pragma("unroll") for (int m = 0; m < 4; ++m) _Pragma("unroll") for (int k = 0; k < 2; ++k) dst[m][k] = *(const LAS bf16x8*)(lds + PG8_SA(b, h) + aoff + m * 2048 + k * 1024); } while (0)
#define PG8_LDB(dst, b, h) do { _Pragma("unroll") for (int n = 0; n < 2; ++n) _Pragma("unroll") for (int k = 0; k < 2; ++k) dst[n][k] = *(const LAS bf16x8*)(lds + PG8_SB(b, h) + boff + n * 2048 + k * 1024); } while (0)
#define PG8_MMA(ai, bj, At, Bt) do { __builtin_amdgcn_s_setprio(1); _Pragma("unroll") for (int m = 0; m < 4; ++m) _Pragma("unroll") for (int n = 0; n < 2; ++n) _Pragma("unroll") for (int k = 0; k < 2; ++k) \
        acc[ai][bj][m][n] = __builtin_amdgcn_mfma_f32_16x16x32_bf16(Bt[n][k], At[m][k], acc[ai][bj][m][n], 0, 0, 0); __builtin_amdgcn_s_setprio(0); } while (0)
#define PG8_WAIT_V(n) asm volatile("s_waitcnt vmcnt(" #n ")" ::: "memory")
#define PG8_WAIT_L(n) asm volatile("s_waitcnt lgkmcnt(" #n ")" ::: "memory")
#define PG8_BAR __builtin_amdgcn_s_barrier()
#define PG8_SCHED __builtin_amdgcn_sched_barrier(0)
    Unit cur, nxt; int ui = 0;
    if (!S.next(0, cur)) return;
    f32x4 acc[2][2][4][2];
#pragma unroll
    for (int a = 0; a < 2; ++a)
#pragma unroll
        for (int b = 0; b < 2; ++b)
#pragma unroll
            for (int m = 0; m < 4; ++m)
#pragma unroll
                for (int n = 0; n < 2; ++n) acc[a][b][m][n] = (f32x4){0.f, 0.f, 0.f, 0.f};
    bf16x8 At[4][2], B0[2][2], B1[2][2];
    const char* cA = (const char*)g.A + (size_t)cur.pm * tstep; const char* cB = (const char*)g.Bt + (size_t)cur.pn * tstep;
    PG8_STAGE(PG8_SB(0, 0), cB, voffB); PG8_STAGE(PG8_SB(0, 1), cB + hstep, voffB); PG8_STAGE(PG8_SA(0, 0), cA, voffA); PG8_STAGE(PG8_SA(0, 1), cA + hstep, voffA);
    if (wr == 1) PG8_BAR;
    PG8_WAIT_V(2); PG8_BAR;
    PG8_STAGE(PG8_SB(1, 0), cB + kstep, voffB); PG8_STAGE(PG8_SA(1, 0), cA + kstep, voffA); PG8_STAGE(PG8_SB(1, 1), cB + hstep + kstep, voffB);
    PG8_WAIT_V(6); PG8_BAR;
    for (;;) {
        const bool has_next = S.next(ui + 1, nxt);
        const char* nA = has_next ? (const char*)g.A + (size_t)nxt.pm * tstep : cA; const char* nB = has_next ? (const char*)g.Bt + (size_t)nxt.pn * tstep : cB;
        for (int t = 0; t < nt; t += 2) {
            const bool last = (t == nt - 2);
            const char* a1 = cA + (size_t)(t + 1) * kstep;
            const char* a2 = last ? nA : cA + (size_t)(t + 2) * kstep; const char* b2 = last ? nB : cB + (size_t)(t + 2) * kstep;
            const char* a3 = a2 + kstep; const char* b3 = b2 + kstep;
            PG8_LDB(B0, 0, 0); PG8_LDB(B1, 0, 1); PG8_SCHED; PG8_LDA(At, 0, 0); PG8_STAGE(PG8_SA(1, 1), a1 + hstep, voffA);
            PG8_WAIT_V(8); PG8_WAIT_L(0); PG8_BAR; PG8_MMA(0, 0, At, B0); PG8_MMA(0, 1, At, B1); PG8_BAR; PG8_SCHED;
            PG8_LDA(At, 0, 1); PG8_STAGE(PG8_SB(0, 0), b2, voffB); PG8_STAGE(PG8_SB(0, 1), b2 + hstep, voffB); PG8_STAGE(PG8_SA(0, 0), a2, voffA);
            PG8_WAIT_V(8); PG8_WAIT_L(0); PG8_BAR; PG8_MMA(1, 0, At, B0); PG8_MMA(1, 1, At, B1); PG8_BAR; PG8_SCHED;
            PG8_LDB(B0, 1, 0); PG8_LDB(B1, 1, 1); PG8_SCHED; PG8_LDA(At, 1, 0); PG8_STAGE(PG8_SA(0, 1), a2 + hstep, voffA);
            PG8_WAIT_V(8); PG8_WAIT_L(0); PG8_BAR; PG8_MMA(0, 0, At, B0); PG8_MMA(0, 1, At, B1); PG8_BAR; PG8_SCHED;
            PG8_LDA(At, 1, 1); PG8_STAGE(PG8_SB(1, 0), b3, voffB); PG8_STAGE(PG8_SB(1, 1), b3 + hstep, voffB); PG8_STAGE(PG8_SA(1, 0), a3, voffA);
            PG8_WAIT_V(8); PG8_WAIT_L(0); PG8_BAR; PG8_MMA(1, 0, At, B0); PG8_MMA(1, 1, At, B1); PG8_BAR; PG8_SCHED;
        }
        if (wr == 0) PG8_BAR;
        if constexpr (!Epi::AFTER_DRAIN) { if constexpr (Epi::NEEDS_LDS) E(acc, cur, wr, wc, fr, fq, lds); else E(acc, cur, wr, wc, fr, fq); }
        if (!has_next) break;
#pragma unroll
        for (int a = 0; a < 2; ++a)
#pragma unroll
            for (int b = 0; b < 2; ++b)
#pragma unroll
                for (int m = 0; m < 4; ++m)
#pragma unroll
                    for (int n = 0; n < 2; ++n) acc[a][b][m][n] = (f32x4){0.f, 0.f, 0.f, 0.f};
        cur = nxt; cA = nA; cB = nB; ++ui;
        if (wr == 1) PG8_BAR;
    }
    PG8_WAIT_V(0);
    PG8_BAR;
    if constexpr (Epi::AFTER_DRAIN) E.fused(acc, cur, wr, wc, fr, fq, lds, wid, lane);
#undef PG8_SA
#undef PG8_SB
#undef PG8_STAGE
#undef PG8_LDA
#undef PG8_LDB
#undef PG8_MMA
#undef PG8_WAIT_V
#undef PG8_WAIT_L
#undef PG8_BAR
#undef PG8_SCHED
}
}

__device__ __forceinline__ float wave_sum(float v) {
#pragma unroll
    for (int o = 1; o < 64; o <<= 1) v += __shfl_xor(v, o);
    return v;
}
#define LDS_WAIT() asm volatile("s_waitcnt lgkmcnt(0)" ::: "memory")

template <bool UPMAP = false>
__device__ __forceinline__ void p0_transpose_item(const float* W, int K, int N, bf16_t* WT, LAS float* scr, int item, int lane) {
    const int nblk = N / 32, kb = item / nblk, nb = item % nblk, k0 = 64 * kb, n0 = 32 * nb;
    int d0 = n0; if (UPMAP) { const int part = n0 >= DFF ? 1 : 0, cc = n0 - part * DFF; d0 = 256 * (cc >> 7) + 128 * part + (cc & 127); }
    {
        f32x4 v[8]; const int cq = 4 * (lane & 7), kr = lane >> 3;
#pragma unroll
        for (int i = 0; i < 8; ++i) v[i] = __builtin_nontemporal_load((const f32x4*)(W + (size_t)(k0 + 8 * i + kr) * N + n0 + cq));
#pragma unroll
        for (int i = 0; i < 8; ++i) { LAS float* d = scr + (8 * i + kr) * 33 + cq; d[0] = v[i].x; d[1] = v[i].y; d[2] = v[i].z; d[3] = v[i].w; }
    }
    LDS_WAIT(); asm volatile("" ::: "memory");
    const int c = lane & 7;
#pragma unroll
    for (int j = 0; j < 4; ++j) { const int n = (lane >> 3) + 8 * j; const LAS float* s = scr + (8 * c) * 33 + n;
        u32x4 o; o.x = cvt_pk_bf16(s[0 * 33], s[1 * 33]); o.y = cvt_pk_bf16(s[2 * 33], s[3 * 33]); o.z = cvt_pk_bf16(s[4 * 33], s[5 * 33]); o.w = cvt_pk_bf16(s[6 * 33], s[7 * 33]);
        *(u32x4*)(WT + (size_t)(d0 + n) * K + k0 + 8 * c) = o; }
    LDS_WAIT(); asm volatile("" ::: "memory");
}

constexpr int I_IN = 16 * 96, I_OUT = 16 * 32, I_UP = 16 * 176, I_DN = 44 * 32;
constexpr int TI_R0 = I_IN + I_OUT + I_UP, TI_R1 = TI_R0 + I_DN, TI_R2 = TI_R1 + I_IN + I_OUT + I_UP + I_DN;
__device__ __forceinline__ void transpose_items(const Args& a, LAS unsigned char* lds, int lo, int hi, int worker, int nworkers, int wave, int lane) {
    unsigned char* ws = a.ws;
    LAS float* scr = (LAS float*)(lds + wave * 16384);
    for (int it = lo + worker; it < hi; it += nworkers) {
        int r = it;
        if (r < I_IN) { p0_transpose_item(a.in[10], DM, 3 * DM, (bf16_t*)(ws + WS_WIN), scr, r, lane); continue; } r -= I_IN;
        if (r < I_OUT) { p0_transpose_item(a.in[13], DM, DM, (bf16_t*)(ws + WS_WOUT), scr, r, lane); continue; } r -= I_OUT;
        if (r < I_UP) { p0_transpose_item<true>(a.in[17], DM, 2 * DFF, (bf16_t*)(ws + WS_WUP), scr, r, lane); continue; } r -= I_UP;
        if (r < I_DN) { p0_transpose_item(a.in[20], DFF, DM, (bf16_t*)(ws + WS_WDN), scr, r, lane); continue; } r -= I_DN;
        if (r < I_IN) { p0_transpose_item(a.in[14], DM, 3 * DM, (bf16_t*)(ws + WS_WQKV), scr, r, lane); continue; } r -= I_IN;
        if (r < I_OUT) { p0_transpose_item(a.in[16], DM, DM, (bf16_t*)(ws + WS_WO), scr, r, lane); continue; } r -= I_OUT;
        if (r < I_UP) { p0_transpose_item<true>(a.in[17] + (size_t)DM * 2 * DFF, DM, 2 * DFF, (bf16_t*)(ws + WS_WUP) + (size_t)DM * 2 * DFF, scr, r, lane); continue; } r -= I_UP;
        p0_transpose_item(a.in[20] + (size_t)DM * DFF, DFF, DM, (bf16_t*)(ws + WS_WDN) + (size_t)DM * DFF, scr, r, lane);
    }
}

__device__ __forceinline__ void prologue(const Args& a, LAS unsigned char* lds, int tid, int wave, int lane, int bid, int G) {
    unsigned char* ws = a.ws;
    float* MOD = (float*)(ws + WS_MOD);
    LAS float* sil = (LAS float*)lds;
    LAS float* red = (LAS float*)(lds + 5 * 1024 * 4);
    for (int i = tid; i < NCV * DM; i += 512) { const int cv = i >> 10, k = i & 1023; const float x = cv == 0 ? a.in[5][k] : a.in[4][(cv - 1) * DM + k]; sil[i] = x / (1.f + __expf(-x)); }
    __syncthreads();
    for (int item = bid; item < 2 * (MODW / 32); item += G) {
        const int l = item / (MODW / 32), col0 = (item % (MODW / 32)) * 32;
        const float* W = a.in[6] + (size_t)l * DM * MODW + col0 + 4 * (lane & 7);
        f32x4 acc[NCV];
#pragma unroll
        for (int cv = 0; cv < NCV; ++cv) acc[cv] = (f32x4){0.f, 0.f, 0.f, 0.f};
#pragma unroll 4
        for (int i = 0; i < 16; ++i) { const int k = 128 * wave + 8 * i + (lane >> 3); const f32x4 w = __builtin_nontemporal_load((const f32x4*)(W + (size_t)k * MODW));
#pragma unroll
            for (int cv = 0; cv < NCV; ++cv) acc[cv] += sil[cv * DM + k] * w; }
#pragma unroll
        for (int cv = 0; cv < NCV; ++cv)
#pragma unroll
            for (int j = 0; j < 4; ++j) { float v = acc[cv][j]; v += __shfl_xor(v, 8); v += __shfl_xor(v, 16); v += __shfl_xor(v, 32); acc[cv][j] = v; }
        if (lane < 8) {
#pragma unroll
            for (int cv = 0; cv < NCV; ++cv)
#pragma unroll
                for (int j = 0; j < 4; ++j) red[(wave * NCV + cv) * 32 + 4 * lane + j] = acc[cv][j];
        }
        __syncthreads();
        if (tid < NCV * 32) { const int cv = tid >> 5, c = tid & 31; float s = 0.f;
#pragma unroll
            for (int w = 0; w < 8; ++w) s += red[(w * NCV + cv) * 32 + c];
            MOD[((size_t)l * NCV + cv) * MODW + col0 + c] = s + a.in[7][l * MODW + col0 + c]; }
        asm volatile("s_waitcnt vmcnt(0)" ::: "memory");
        __syncthreads();
        if (l == 0 && col0 < 2 * DM && tid == 0) {
            __builtin_amdgcn_fence(__ATOMIC_RELEASE, "agent");
            __hip_atomic_fetch_add((unsigned*)(ws + WS_CTL) + CW_MODCNT, 1u, __ATOMIC_RELAXED, __HIP_MEMORY_SCOPE_AGENT);
        }
    }
    __syncthreads();
    transpose_items(a, lds, 0, TI_R0, bid * 8 + wave, G * 8, wave, lane);
    const int gt = bid * 512 + tid, NGT = G * 512;
    bf16_t* Kc = (bf16_t*)(ws + WS_KC); bf16_t* Vtc = (bf16_t*)(ws + WS_VTC);
    for (int i = gt; i < NB_S * NH * PAST * HD; i += NGT) {
        Kc[i] = f2bf(a.in[2][i]);
        const int t = i & 255, d = (i >> 8) & 63, bh = i >> 14;
        Vtc[i] = f2bf(a.in[3][((size_t)bh * PAST + t) * HD + d]);
    }
}

__device__ __forceinline__ void norm_phase(const Args& a, int ph, int wave, int lane, int bid, int G) {
    const int gw = bid * 8 + wave, NGW = G * 8;
    const bool is_final = ph == 17, ffn = (ph == 5 || ph == 13); const int layer = ph >= 9 ? 1 : 0;
    const float* g = is_final ? a.in[21] : ((ffn ? a.in[9] : a.in[8]) + layer * DM);
    const float* mod = (const float*)(a.ws + WS_MOD) + (size_t)layer * NCV * MODW + (ffn ? 3 * DM : 0);
    bf16_t* H = (bf16_t*)(a.ws + WS_H);
    f32x4 gv[4];
#pragma unroll
    for (int j = 0; j < 4; ++j) gv[j] = *(const f32x4*)(g + 4 * lane + 256 * j);
    for (int row = gw; row < MT; row += NGW) {
        const float* xr = (ph == 1) ? (row < MP ? a.in[0] + (size_t)row * DM : a.in[1] + (size_t)(row - MP) * DM) : a.out + (size_t)row * DM;
        f32x4 v[4]; float s = 0.f;
#pragma unroll
        for (int j = 0; j < 4; ++j) { v[j] = *(const f32x4*)(xr + 4 * lane + 256 * j); s += (v[j].x * v[j].x + v[j].y * v[j].y) + (v[j].z * v[j].z + v[j].w * v[j].w); }
        const float rstd = 1.0f / sqrtf(wave_sum(s) * (1.f / DM) + EPS);
        if (is_final) {
#pragma unroll
            for (int j = 0; j < 4; ++j) *(f32x4*)(a.out + (size_t)row * DM + 4 * lane + 256 * j) = (v[j] * rstd) * gv[j];
        } else {
            const int cv = row < MP ? 0 : 1 + ((row - MP) >> 10);
            const float* mp = mod + (size_t)cv * MODW + 4 * lane;
#pragma unroll
            for (int j = 0; j < 4; ++j) { const f32x4 sh = *(const f32x4*)(mp + 256 * j), sc = *(const f32x4*)(mp + DM + 256 * j);
                const f32x4 h = ((v[j] * rstd) * gv[j]) * (1.0f + sc) + sh;
                u32x2 w; w.x = cvt_pk_bf16(h.x, h.y); w.y = cvt_pk_bf16(h.z, h.w);
                *(u32x2*)(H + (size_t)row * DM + 4 * lane + 256 * j) = w; }
        }
    }
}

struct F8 { float v[8]; };
__device__ __forceinline__ F8 ld8(const bf16_t* p) { const u32x4 w = *(const u32x4*)p; F8 r; r.v[0] = bf_lo(w.x); r.v[1] = bf_hi(w.x); r.v[2] = bf_lo(w.y); r.v[3] = bf_hi(w.y); r.v[4] = bf_lo(w.z); r.v[5] = bf_hi(w.z); r.v[6] = bf_lo(w.w); r.v[7] = bf_hi(w.w); return r; }
__device__ __forceinline__ F8 ldf8(const float* p) { const f32x4 a = *(const f32x4*)p, b = *(const f32x4*)(p + 4); F8 r; r.v[0] = a.x; r.v[1] = a.y; r.v[2] = a.z; r.v[3] = a.w; r.v[4] = b.x; r.v[5] = b.y; r.v[6] = b.z; r.v[7] = b.w; return r; }
__device__ __forceinline__ void st8(bf16_t* p, const F8& o) { u32x4 w; w.x = cvt_pk_bf16(o.v[0], o.v[1]); w.y = cvt_pk_bf16(o.v[2], o.v[3]); w.z = cvt_pk_bf16(o.v[4], o.v[5]); w.w = cvt_pk_bf16(o.v[6], o.v[7]); *(u32x4*)p = w; }
__device__ __forceinline__ F8 zero8() { F8 r;
#pragma unroll
    for (int e = 0; e < 8; ++e) r.v[e] = 0.f;
    return r; }

constexpr int RS = 8;
__device__ __forceinline__ F8 unpack8c(const u32x4 w) { F8 r; r.v[0] = bf_lo(w.x); r.v[1] = bf_hi(w.x); r.v[2] = bf_lo(w.y); r.v[3] = bf_hi(w.y); r.v[4] = bf_lo(w.z); r.v[5] = bf_hi(w.z); r.v[6] = bf_lo(w.w); r.v[7] = bf_hi(w.w); return r; }
__device__ __forceinline__ void convgate_phase(const Args& a, int tid, int bid, int G) {
    const bf16_t* BCX = (const bf16_t*)(a.ws + WS_BCX); bf16_t* A2 = (bf16_t*)(a.ws + WS_A2);
    const float* cw = a.in[11]; const float* cbias = a.in[12];
    constexpr int NITEM = (MT / RS) * (DM / 8); const int per = (NITEM + G - 1) / G;
    for (int j = tid; j < per; j += 512) {
        const int item = bid * per + j; if (item >= NITEM) break;
        const int strip = item >> 7, c = (item & 127) * 8, r0 = strip * RS;
        const int seqm = r0 < MP ? (SEQ_P - 1) : (SEQ_S - 1);
        const bool first = (r0 & seqm) == 0, last = ((r0 + RS) & seqm) == 0;
        const bf16_t* p = BCX + (size_t)r0 * (3 * DM) + c;
        u32x4 cr[RS + 2], xr[RS + 2], br[RS];
        const u32x4 z4 = (u32x4){0u, 0u, 0u, 0u};
        cr[0] = first ? z4 : *(const u32x4*)(p - 3 * DM + DM); xr[0] = first ? z4 : *(const u32x4*)(p - 3 * DM + 2 * DM);
#pragma unroll
        for (int i = 0; i < RS; ++i) { br[i] = *(const u32x4*)(p + (size_t)i * 3 * DM); cr[i + 1] = *(const u32x4*)(p + (size_t)i * 3 * DM + DM); xr[i + 1] = *(const u32x4*)(p + (size_t)i * 3 * DM + 2 * DM); }
        cr[RS + 1] = last ? z4 : *(const u32x4*)(p + (size_t)RS * 3 * DM + DM); xr[RS + 1] = last ? z4 : *(const u32x4*)(p + (size_t)RS * 3 * DM + 2 * DM);
        const F8 w0 = ldf8(cw + c), w1 = ldf8(cw + DM + c), w2 = ldf8(cw + 2 * DM + c), cb = ldf8(cbias + c);
        F8 prev, cur;
        { const F8 x = unpack8c(cr[0]), y = unpack8c(xr[0]);
#pragma unroll
            for (int e = 0; e < 8; ++e) prev.v[e] = x.v[e] * y.v[e]; }
        { const F8 x = unpack8c(cr[1]), y = unpack8c(xr[1]);
#pragma unroll
            for (int e = 0; e < 8; ++e) cur.v[e] = x.v[e] * y.v[e]; }
#pragma unroll
        for (int i = 0; i < RS; ++i) {
            F8 nxt; { const F8 x = unpack8c(cr[i + 2]), y = unpack8c(xr[i + 2]);
#pragma unroll
                for (int e = 0; e < 8; ++e) nxt.v[e] = x.v[e] * y.v[e]; }
            const F8 bg = unpack8c(br[i]); F8 o;
#pragma unroll
            for (int e = 0; e < 8; ++e) o.v[e] = bg.v[e] * (w0.v[e] * prev.v[e] + w1.v[e] * cur.v[e] + w2.v[e] * nxt.v[e] + cb.v[e]);
            st8(A2 + (size_t)(r0 + i) * DM + c, o);
            prev = cur; cur = nxt;
        }
    }
}
__device__ __forceinline__ float gelu_tanh(float x) {
    const float t = x * x; const float p = __builtin_fmaf(t, -0.10294324f, -2.3022082f);
    return x * __builtin_amdgcn_rcpf(1.0f + __builtin_amdgcn_exp2f(p * x));
}
__device__ __forceinline__ F8 unpack8(const u32x4 w) { F8 r; r.v[0] = bf_lo(w.x); r.v[1] = bf_hi(w.x); r.v[2] = bf_lo(w.y); r.v[3] = bf_hi(w.y); r.v[4] = bf_lo(w.z); r.v[5] = bf_hi(w.z); r.v[6] = bf_lo(w.w); r.v[7] = bf_hi(w.w); return r; }
template <bool BIAS>
__device__ __forceinline__ void attn_chunk(const bf16_t* Kp, int kpitch, const bf16_t* Vp, int vpitch, int tok0, int gstride,
                                           const bf16x8 qf0, const bf16x8 qf1, float& m_run, float& l_run, f32x4 (&o)[4],
                                           const float* rpb_h, int drow0, int kc0, int qc, int lane) {
    const int i = lane & 15, q = lane >> 4;
    f32x4 s[8];
#pragma unroll
    for (int kt = 0; kt < 8; ++kt) {
        const bf16_t* kp = Kp + (size_t)(tok0 + (kt >> 1) * gstride + (kt & 1) * 16 + i) * kpitch + 8 * q;
        const bf16x8 a0 = *(const bf16x8*)kp, a1 = *(const bf16x8*)(kp + 32);
        f32x4 z = (f32x4){0.f, 0.f, 0.f, 0.f};
        z = __builtin_amdgcn_mfma_f32_16x16x32_bf16(a0, qf0, z, 0, 0, 0);
        s[kt] = __builtin_amdgcn_mfma_f32_16x16x32_bf16(a1, qf1, z, 0, 0, 0);
    }
    if (BIAS) {
        const int cs = min(max(qc - 8, 0), 48);
#pragma unroll
        for (int kt = 0; kt < 8; ++kt) {
            const float* rp = rpb_h + ((kt >> 1) + drow0) * 31;
#pragma unroll
            for (int j = 0; j < 4; ++j) { const int kc = kc0 + (kt & 1) * 16 + 4 * q + j; const bool ok = (kc >= cs) && (kc < cs + 16);
                const int dc = min(max(kc - qc, -15), 15);
                s[kt][j] = ok ? s[kt][j] + rp[dc + 15] : -1e30f; }
        }
    }
    float mx = -1e30f;
#pragma unroll
    for (int kt = 0; kt < 8; ++kt) mx = fmaxf(mx, fmaxf(fmaxf(s[kt][0], s[kt][1]), fmaxf(s[kt][2], s[kt][3])));
    mx = fmaxf(mx, __shfl_xor(mx, 16)); mx = fmaxf(mx, __shfl_xor(mx, 32));
    const float m_new = fmaxf(m_run, mx), alpha = __builtin_amdgcn_exp2f(m_run - m_new);
    float ls = 0.f;
#pragma unroll
    for (int kt = 0; kt < 8; ++kt)
#pragma unroll
        for (int j = 0; j < 4; ++j) { const float p = __builtin_amdgcn_exp2f(s[kt][j] - m_new); s[kt][j] = p; ls += p; }
    ls += __shfl_xor(ls, 16); ls += __shfl_xor(ls, 32);
    l_run = l_run * alpha + ls; m_run = m_new;
#pragma unroll
    for (int dt = 0; dt < 4; ++dt) o[dt] = o[dt] * alpha;
#pragma unroll
    for (int g = 0; g < 4; ++g) {
        u32x4 pw; pw.x = cvt_pk_bf16(s[2 * g][0], s[2 * g][1]); pw.y = cvt_pk_bf16(s[2 * g][2], s[2 * g][3]);
        pw.z = cvt_pk_bf16(s[2 * g + 1][0], s[2 * g + 1][1]); pw.w = cvt_pk_bf16(s[2 * g + 1][2], s[2 * g + 1][3]);
        const bf16x8 pb = __builtin_bit_cast(bf16x8, pw);
#pragma unroll
        for (int dt = 0; dt < 4; ++dt) {
            const bf16_t* vp = Vp + (size_t)(16 * dt + i) * vpitch + tok0 + g * gstride + 4 * q;
            const u32x2 lo = *(const u32x2*)vp, hi = *(const u32x2*)(vp + 16);
            u32x4 vw; vw.x = lo.x; vw.y = lo.y; vw.z = hi.x; vw.w = hi.y;
            o[dt] = __builtin_amdgcn_mfma_f32_16x16x32_bf16(__builtin_bit_cast(bf16x8, vw), pb, o[dt], 0, 0, 0);
        }
    }
    asm volatile("" ::: "memory");
}

constexpr int KROWB = 144;
template <bool BIAS, bool RING = false>
__device__ __forceinline__ void attn_chunk_lds(const LAS unsigned char* Kl, const LAS unsigned char* Vl, int vpitchB, int tok0, int gstride,
                                               const bf16x8 qf0, const bf16x8 qf1, float& m_run, float& l_run, f32x4 (&o)[4],
                                               const float* rpb_h, int drow0, int kc0, int qc, int lane) {
    const int i = lane & 15, q = lane >> 4;
    f32x4 s[8];
#pragma unroll
    for (int kt = 0; kt < 8; ++kt) {
        const int tg = RING ? ((((gstride + (kt >> 1)) & 7) << 6) + tok0) : (tok0 + (kt >> 1) * gstride);
        const LAS unsigned char* kp = Kl + (tg + (kt & 1) * 16 + i) * KROWB + 16 * q;
        const bf16x8 a0 = *(const LAS bf16x8*)kp, a1 = *(const LAS bf16x8*)(kp + 64);
        f32x4 z = (f32x4){0.f, 0.f, 0.f, 0.f};
        z = __builtin_amdgcn_mfma_f32_16x16x32_bf16(a0, qf0, z, 0, 0, 0);
        s[kt] = __builtin_amdgcn_mfma_f32_16x16x32_bf16(a1, qf1, z, 0, 0, 0);
        if (kt & 1) asm volatile("" ::: "memory");
    }
    if (BIAS) {
        const int cs = min(max(qc - 8, 0), 48);
        int off[8]; bool ok[8];
#pragma unroll
        for (int ee = 0; ee < 8; ++ee) { const int kc = kc0 + (ee >> 2) * 16 + 4 * q + (ee & 3); ok[ee] = (unsigned)(kc - cs) < 16u; off[ee] = min(max(kc - qc + 15, 0), 30); }
#pragma unroll
        for (int g = 0; g < 4; ++g) {
            const float* rp = rpb_h + (g + drow0) * 31;
#pragma unroll
            for (int ee = 0; ee < 8; ++ee) { const float bv = rp[off[ee]] * LOG2E; const float sv = s[2 * g + (ee >> 2)][ee & 3]; s[2 * g + (ee >> 2)][ee & 3] = ok[ee] ? sv + bv : -1e30f; }
        }
    }
    float mx = -1e30f;
#pragma unroll
    for (int kt = 0; kt < 8; ++kt) mx = fmaxf(mx, fmaxf(fmaxf(s[kt][0], s[kt][1]), fmaxf(s[kt][2], s[kt][3])));
    mx = fmaxf(mx, __shfl_xor(mx, 16)); mx = fmaxf(mx, __shfl_xor(mx, 32));
    const float m_new = fmaxf(m_run, mx), alpha = __builtin_amdgcn_exp2f(m_run - m_new);
    float ls = 0.f;
#pragma unroll
    for (int kt = 0; kt < 8; ++kt)
#pragma unroll
        for (int j = 0; j < 4; ++j) { const float p = __builtin_amdgcn_exp2f(s[kt][j] - m_new); s[kt][j] = p; ls += p; }
    ls += __shfl_xor(ls, 16); ls += __shfl_xor(ls, 32);
    l_run = l_run * alpha + ls; m_run = m_new;
#pragma unroll
    for (int dt = 0; dt < 4; ++dt) o[dt] = o[dt] * alpha;
#pragma unroll
    for (int g = 0; g < 4; ++g) {
        u32x4 pw; pw.x = cvt_pk_bf16(s[2 * g][0], s[2 * g][1]); pw.y = cvt_pk_bf16(s[2 * g][2], s[2 * g][3]);
        pw.z = cvt_pk_bf16(s[2 * g + 1][0], s[2 * g + 1][1]); pw.w = cvt_pk_bf16(s[2 * g + 1][2], s[2 * g + 1][3]);
        const bf16x8 pb = __builtin_bit_cast(bf16x8, pw);
#pragma unroll
        for (int dt = 0; dt < 4; ++dt) {
            const int tgv = RING ? ((((gstride + g) & 7) << 6) + tok0) : (tok0 + g * gstride);
            const LAS unsigned char* vp = Vl + (16 * dt + i) * vpitchB + (tgv + 4 * q) * 2;
            const u32x2 lo = *(const LAS u32x2*)vp, hi = *(const LAS u32x2*)(vp + 32);
            u32x4 vw; vw.x = lo.x; vw.y = lo.y; vw.z = hi.x; vw.w = hi.y;
            o[dt] = __builtin_amdgcn_mfma_f32_16x16x32_bf16(__builtin_bit_cast(bf16x8, vw), pb, o[dt], 0, 0, 0);
        }
        asm volatile("" ::: "memory");
    }
}
__device__ __forceinline__ void attn_chunk_lds2(const LAS unsigned char* Kl, const LAS unsigned char* Vl, int vpitchB, int tok0, int gstride,
                                                const bf16x8 qa0, const bf16x8 qa1, const bf16x8 qb0, const bf16x8 qb1,
                                                float (&m_run)[2], float (&l_run)[2], f32x4 (&o)[2][4], int lane) {
    const int i = lane & 15, q = lane >> 4;
    f32x4 s[2][8];
#pragma unroll
    for (int kt = 0; kt < 8; ++kt) {
        const LAS unsigned char* kp = Kl + (tok0 + (kt >> 1) * gstride + (kt & 1) * 16 + i) * KROWB + 16 * q;
        const bf16x8 a0 = *(const LAS bf16x8*)kp, a1 = *(const LAS bf16x8*)(kp + 64);
        f32x4 za = (f32x4){0.f, 0.f, 0.f, 0.f}, zb = (f32x4){0.f, 0.f, 0.f, 0.f};
        za = __builtin_amdgcn_mfma_f32_16x16x32_bf16(a0, qa0, za, 0, 0, 0); zb = __builtin_amdgcn_mfma_f32_16x16x32_bf16(a0, qb0, zb, 0, 0, 0);
        s[0][kt] = __builtin_amdgcn_mfma_f32_16x16x32_bf16(a1, qa1, za, 0, 0, 0); s[1][kt] = __builtin_amdgcn_mfma_f32_16x16x32_bf16(a1, qb1, zb, 0, 0, 0);
        if (kt & 1) asm volatile("" ::: "memory");
    }
#pragma unroll
    for (int u = 0; u < 2; ++u) {
        float mx = -1e30f;
#pragma unroll
        for (int kt = 0; kt < 8; ++kt) mx = fmaxf(mx, fmaxf(fmaxf(s[u][kt][0], s[u][kt][1]), fmaxf(s[u][kt][2], s[u][kt][3])));
        mx = fmaxf(mx, __shfl_xor(mx, 16)); mx = fmaxf(mx, __shfl_xor(mx, 32));
        const float m_new = fmaxf(m_run[u], mx), alpha = __builtin_amdgcn_exp2f(m_run[u] - m_new);
        float ls = 0.f;
#pragma unroll
        for (int kt = 0; kt < 8; ++kt)
#pragma unroll
            for (int j = 0; j < 4; ++j) { const float p = __builtin_amdgcn_exp2f(s[u][kt][j] - m_new); s[u][kt][j] = p; ls += p; }
        ls += __shfl_xor(ls, 16); ls += __shfl_xor(ls, 32);
        l_run[u] = l_run[u] * alpha + ls; m_run[u] = m_new;
#pragma unroll
        for (int dt = 0; dt < 4; ++dt) o[u][dt] = o[u][dt] * alpha;
    }
#pragma unroll
    for (int g = 0; g < 4; ++g) {
        bf16x8 pb[2];
#pragma unroll
        for (int u = 0; u < 2; ++u) { u32x4 pw; pw.x = cvt_pk_bf16(s[u][2 * g][0], s[u][2 * g][1]); pw.y = cvt_pk_bf16(s[u][2 * g][2], s[u][2 * g][3]);
            pw.z = cvt_pk_bf16(s[u][2 * g + 1][0], s[u][2 * g + 1][1]); pw.w = cvt_pk_bf16(s[u][2 * g + 1][2], s[u][2 * g + 1][3]); pb[u] = __builtin_bit_cast(bf16x8, pw); }
#pragma unroll
        for (int dt = 0; dt < 4; ++dt) {
            const LAS unsigned char* vp = Vl + (16 * dt + i) * vpitchB + (tok0 + g * gstride + 4 * q) * 2;
            const u32x2 lo = *(const LAS u32x2*)vp, hi = *(const LAS u32x2*)(vp + 32);
            u32x4 vw; vw.x = lo.x; vw.y = lo.y; vw.z = hi.x; vw.w = hi.y;
            const bf16x8 va = __builtin_bit_cast(bf16x8, vw);
            o[0][dt] = __builtin_amdgcn_mfma_f32_16x16x32_bf16(va, pb[0], o[0][dt], 0, 0, 0);
            o[1][dt] = __builtin_amdgcn_mfma_f32_16x16x32_bf16(va, pb[1], o[1][dt], 0, 0, 0);
        }
        asm volatile("" ::: "memory");
    }
}
__device__ __forceinline__ void stage_k(const bf16_t* src, int pitch, int nkeys, LAS unsigned char* dst, int tid) {
    for (int idx = tid; idx < nkeys * 8; idx += 512) { const int row = idx >> 3, ch = idx & 7; const u32x4 v = *(const u32x4*)(src + (size_t)row * pitch + ch * 8); *(LAS u32x4*)(dst + row * KROWB + ch * 16) = v; }
}
__device__ __forceinline__ void stage_vt(const bf16_t* src, int pitch, int nkeys, LAS unsigned char* dst, int vpitchB, int tid) {
    const int nch = nkeys >> 3, sh = nkeys == 512 ? 6 : 5;
    for (int idx = tid; idx < 64 * nch; idx += 512) { const int d = idx >> sh, ch = idx & (nch - 1); const u32x4 v = *(const u32x4*)(src + (size_t)d * pitch + ch * 8); *(LAS u32x4*)(dst + d * vpitchB + ch * 16) = v; }
}

template <int NK> struct KVRegs { u32x4 k[NK / 64]; u32x4 v[NK / 64]; };
template <int NK> __device__ __forceinline__ void kv_load(KVRegs<NK>& R, const bf16_t* ksrc, int kpitch, const bf16_t* vsrc, int vpitch, int tid) {
    constexpr int NCH = NK / 8, SH = NK == 512 ? 6 : 5;
#pragma unroll
    for (int j = 0; j < NK / 64; ++j) { const int idx = tid + 512 * j; const int row = idx >> 3, ch = idx & 7; R.k[j] = *(const u32x4*)(ksrc + (size_t)row * kpitch + ch * 8);
        const int d = idx >> SH, c2 = idx & (NCH - 1); R.v[j] = *(const u32x4*)(vsrc + (size_t)d * vpitch + c2 * 8); }
}
template <int NK> __device__ __forceinline__ void kv_store(const KVRegs<NK>& R, LAS unsigned char* Kl, LAS unsigned char* Vl, int vpitchB, int tid) {
    constexpr int NCH = NK / 8, SH = NK == 512 ? 6 : 5;
#pragma unroll
    for (int j = 0; j < NK / 64; ++j) { const int idx = tid + 512 * j; const int row = idx >> 3, ch = idx & 7; *(LAS u32x4*)(Kl + row * KROWB + ch * 16) = R.k[j];
        const int d = idx >> SH, c2 = idx & (NCH - 1); *(LAS u32x4*)(Vl + d * vpitchB + c2 * 16) = R.v[j]; }
}

template <int NK> struct KRegs { u32x4 k[NK / 64]; };
template <int NK> __device__ __forceinline__ void k_load(KRegs<NK>& R, const bf16_t* ksrc, int kpitch, int tid) {
#pragma unroll
    for (int j = 0; j < NK / 64; ++j) { const int idx = tid + 512 * j; const int row = idx >> 3, ch = idx & 7; R.k[j] = *(const u32x4*)(ksrc + (size_t)row * kpitch + ch * 8); }
}
template <int NK> __device__ __forceinline__ void k_store(const KRegs<NK>& R, LAS unsigned char* Kl, int tid) {
#pragma unroll
    for (int j = 0; j < NK / 64; ++j) { const int idx = tid + 512 * j; const int row = idx >> 3, ch = idx & 7; *(LAS u32x4*)(Kl + row * KROWB + ch * 16) = R.k[j]; }
}
__device__ __forceinline__ void attn_phase(const Args& a, LAS unsigned char* lds, int tid, int wave, int lane, int bid, int G) {
    const bf16_t* Q = (const bf16_t*)(a.ws + WS_Q); const bf16_t* Kb = (const bf16_t*)(a.ws + WS_K); const bf16_t* Vt = (const bf16_t*)(a.ws + WS_VT);
    const bf16_t* Kc = (const bf16_t*)(a.ws + WS_KC); const bf16_t* Vtc = (const bf16_t*)(a.ws + WS_VTC);
    bf16_t* O = (bf16_t*)(a.ws + WS_A2);
    const int i = lane & 15, q = lane >> 4;
    LAS unsigned char* Kl = lds; LAS unsigned char* Vl = lds + 73728;
    LAS float* scr = (LAS float*)(lds + 36864);
    constexpr int VP256 = 528, VP512 = 1040;
    for (int bh = bid; bh < NB_P * NH; bh += G) {
        const int b = bh >> 4, h = bh & 15;
        __syncthreads();
        stage_k(Kb + (size_t)b * SEQ_P * DM + h * HD, DM, 256, Kl, tid);
        stage_vt(Vt + (size_t)bh * HD * SEQ_P, SEQ_P, 256, Vl, VP256, tid);
        __syncthreads();
        {
            const size_t qrow = (size_t)b * SEQ_P + wave * 32;
            const bf16_t* qp = Q + (qrow + i) * DM + h * HD + 8 * q;
            const bf16x8 qa0 = *(const bf16x8*)qp, qa1 = *(const bf16x8*)(qp + 32), qb0 = *(const bf16x8*)(qp + 16 * DM), qb1 = *(const bf16x8*)(qp + 16 * DM + 32);
            float m_run[2] = {-1e30f, -1e30f}, l_run[2] = {0.f, 0.f}; f32x4 o[2][4];
#pragma unroll
            for (int u = 0; u < 2; ++u)
#pragma unroll
                for (int dt = 0; dt < 4; ++dt) o[u][dt] = (f32x4){0.f, 0.f, 0.f, 0.f};
#pragma unroll 1
            for (int c = 0; c < 2; ++c) attn_chunk_lds2(Kl, Vl, VP256, c * 128, 32, qa0, qa1, qb0, qb1, m_run, l_run, o, lane);
#pragma unroll
            for (int u = 0; u < 2; ++u) { const float inv = 1.0f / l_run[u];
                bf16_t* op = O + (qrow + 16 * u + i) * DM + h * HD + 4 * q;
#pragma unroll
                for (int dt = 0; dt < 4; ++dt) { u32x2 w; w.x = cvt_pk_bf16(o[u][dt][0] * inv, o[u][dt][1] * inv); w.y = cvt_pk_bf16(o[u][dt][2] * inv, o[u][dt][3] * inv); *(u32x2*)(op + 16 * dt) = w; } }
        }
    }
    const int jb = wave & 3, half = wave >> 2;
    const int kb0 = min(max(jb * 16 - 8, 0), 32);
    for (int unit = bid; unit < NB_S * NH * 4; unit += G) {
        const int quad = unit & 3, bh = unit >> 2, b = bh >> 4, h = bh & 15;
        const float* rpb_h = a.in[15] + (size_t)h * 15 * 31;
        const bf16_t* Kg = Kb + ((size_t)MP + (size_t)b * SEQ_S) * DM + h * HD;
        const bf16_t* Vg = Vt + (size_t)MP * DM + (size_t)bh * HD * SEQ_S;
        float m_run[4], l_run[4]; f32x4 o[4][4];
        const int rfirst = 4 * quad, r0first = min(max(rfirst - 4, 0), 8);
        __syncthreads();
#pragma unroll
        for (int w8 = 0; w8 < 8; ++w8) { const int wrow = r0first + w8, slot = wrow & 7;
            { const int key = tid >> 3, ch = tid & 7; *(LAS u32x4*)(Kl + (slot * 64 + key) * KROWB + ch * 16) = *(const u32x4*)(Kg + (size_t)(wrow * 64 + key) * DM + ch * 8); }
            { const int d = tid >> 3, ch = tid & 7; *(LAS u32x4*)(Vl + d * VP512 + (slot * 64) * 2 + ch * 16) = *(const u32x4*)(Vg + (size_t)d * SEQ_S + wrow * 64 + ch * 8); } }
        __syncthreads();
#pragma unroll
        for (int k = 0; k < 4; ++k) {
            const int r = rfirst + k, r0 = min(max(r - 4, 0), 8);
            if (k > 0 && r0 != min(max(r - 5, 0), 8)) {
                __syncthreads();
                const int wrow = r0 + 7, slot = wrow & 7;
                { const int key = tid >> 3, ch = tid & 7; *(LAS u32x4*)(Kl + (slot * 64 + key) * KROWB + ch * 16) = *(const u32x4*)(Kg + (size_t)(wrow * 64 + key) * DM + ch * 8); }
                { const int d = tid >> 3, ch = tid & 7; *(LAS u32x4*)(Vl + d * VP512 + (slot * 64) * 2 + ch * 16) = *(const u32x4*)(Vg + (size_t)d * SEQ_S + wrow * 64 + ch * 8); }
                __syncthreads();
            }
            const size_t qrow = (size_t)MP + (size_t)b * SEQ_S + r * 64 + jb * 16;
            const bf16_t* qp = Q + (qrow + i) * DM + h * HD + 8 * q;
            const bf16x8 qf0 = *(const bf16x8*)qp, qf1 = *(const bf16x8*)(qp + 32);
            m_run[k] = -1e30f; l_run[k] = 0.f;
#pragma unroll
            for (int dt = 0; dt < 4; ++dt) o[k][dt] = (f32x4){0.f, 0.f, 0.f, 0.f};
            attn_chunk_lds<true, true>(Kl, Vl, VP512, kb0, r0 + 4 * half, qf0, qf1, m_run[k], l_run[k], o[k], rpb_h, r0 + 4 * half - r + 7, kb0, jb * 16 + i, lane);
        }
        __syncthreads();
        stage_k(Kc + (size_t)bh * PAST * HD, HD, 256, Kl, tid);
        stage_vt(Vtc + (size_t)bh * HD * PAST, PAST, 256, Vl, VP256, tid);
        __syncthreads();
#pragma unroll
        for (int k = 0; k < 4; ++k) {
            const int r = rfirst + k;
            const size_t qrow = (size_t)MP + (size_t)b * SEQ_S + r * 64 + jb * 16;
            const bf16_t* qp = Q + (qrow + i) * DM + h * HD + 8 * q;
            const bf16x8 qf0 = *(const bf16x8*)qp, qf1 = *(const bf16x8*)(qp + 32);
            attn_chunk_lds<false>(Kl, Vl, VP256, half * 128, 32, qf0, qf1, m_run[k], l_run[k], o[k], nullptr, 0, 0, 0, lane);
        }
#pragma unroll
        for (int rnd = 0; rnd < 2; ++rnd) {
            if (half == 1) {
#pragma unroll
                for (int kk = 0; kk < 2; ++kk) { const int k = 2 * rnd + kk; LAS float* sp = scr + (kk * 4 + jb) * 18 * 64 + lane;
                    sp[0] = m_run[k]; sp[64] = l_run[k];
#pragma unroll
                    for (int dt = 0; dt < 4; ++dt)
#pragma unroll
                        for (int j = 0; j < 4; ++j) sp[(2 + dt * 4 + j) * 64] = o[k][dt][j]; }
            }
            __syncthreads();
            if (half == 0) {
#pragma unroll
                for (int kk = 0; kk < 2; ++kk) { const int k = 2 * rnd + kk; const LAS float* sp = scr + (kk * 4 + jb) * 18 * 64 + lane;
                    const float m2 = sp[0], l2 = sp[64], mm = fmaxf(m_run[k], m2), a1 = __builtin_amdgcn_exp2f(m_run[k] - mm), a2 = __builtin_amdgcn_exp2f(m2 - mm);
                    const float inv = 1.0f / (l_run[k] * a1 + l2 * a2);
                    const size_t qrow = (size_t)MP + (size_t)b * SEQ_S + (rfirst + k) * 64 + jb * 16;
                    bf16_t* op = O + (qrow + i) * DM + h * HD + 4 * q;
#pragma unroll
                    for (int dt = 0; dt < 4; ++dt) { float v[4];
#pragma unroll
                        for (int j = 0; j < 4; ++j) v[j] = (o[k][dt][j] * a1 + sp[(2 + dt * 4 + j) * 64] * a2) * inv;
                        u32x2 w; w.x = cvt_pk_bf16(v[0], v[1]); w.y = cvt_pk_bf16(v[2], v[3]); *(u32x2*)(op + 16 * dt) = w; } }
            }
            __syncthreads();
        }
    }
    __syncthreads();
}

__device__ __forceinline__ void gate_fixup(const Args& a, int layer, int pm, int tid) {
    const float* SB = (const float*)(a.ws + WS_SB); bf16_t* A3 = (bf16_t*)(a.ws + WS_A3);
    const float* cw = a.in[18] + (size_t)layer * 3 * DFF; const float* cbias = a.in[19] + (size_t)layer * DFF;
    const int T = pm - 32, pos = T & 3;
    const float* sT = SB + (size_t)T * 6 * DFF;
    for (int c = tid; c < DFF; c += 512) {
        const float w0 = cw[c], w1 = cw[DFF + c], w2 = cw[2 * DFF + c], cb = cbias[c];
        if (pos > 0) { const float up = sT[c - 6 * DFF + 4 * DFF], uc = sT[c], dn = sT[DFF + c], g = sT[2 * DFF + c];
            A3[(size_t)(pm * 256) * DFF + c] = f2bf(pg8::gelu_tanh_f(w0 * up + w1 * uc + w2 * dn + cb) * g); }
        if (pos < 3) { const float up = sT[3 * DFF + c], uc = sT[4 * DFF + c], dn = sT[6 * DFF + c], g = sT[5 * DFF + c];
            A3[(size_t)(pm * 256 + 255) * DFF + c] = f2bf(pg8::gelu_tanh_f(w0 * up + w1 * uc + w2 * dn + cb) * g); }
    }
    asm volatile("s_waitcnt vmcnt(0)" ::: "memory");
    __syncthreads();
}

#define XB_TMO      128
#define XB_XCNT(j)  (256  + 64 * (j))
#define XB_XSUB(j)  (1280 + 64 * (j))
#define XB_XGEN(j)  (2304 + 64 * (j))
#define XB_TOP      3328
#define XB_TOPGEN   3392
#define XCD_BAR_WORDS 3456
#define XB_SPIN_CAP (1u << 22)
__device__ __forceinline__ unsigned xb_ld(unsigned* p)              { return __hip_atomic_load(p, __ATOMIC_RELAXED, __HIP_MEMORY_SCOPE_AGENT); }
__device__ __forceinline__ unsigned xb_add(unsigned* p, unsigned v) { return __hip_atomic_fetch_add(p, v, __ATOMIC_RELAXED, __HIP_MEMORY_SCOPE_AGENT); }
__device__ __forceinline__ unsigned xb_xcc_id() { return (unsigned)__builtin_amdgcn_s_getreg((3 << 11) | 20) & 0xFu; }
#define XB_SPIN(cond, bar) do { unsigned _sp = 0; while (cond) { __builtin_amdgcn_s_sleep(1); \
    if ((++_sp & 255u) == 0u) { if (xb_ld(&(bar)[XB_TMO])) break; if (_sp > XB_SPIN_CAP) { atomicAdd(&(bar)[XB_TMO], 1u); break; } } } } while (0)
struct XcdBarrier { unsigned* bar; unsigned x; volatile LAS unsigned* st; };
__device__ __forceinline__ void xcd_barrier_complete(unsigned* bar, unsigned x, unsigned G, unsigned& nloc, unsigned& nx) {
    unsigned sum, cnt, mine, sp = 0u;
    for (;;) {
        sum = 0u; cnt = 0u; mine = 0u;
#pragma unroll
        for (unsigned j = 0; j < 16; ++j) { const unsigned c = xb_ld(&bar[XB_XCNT(j)]); sum += c; cnt += (c > 0u) ? 1u : 0u; mine = (j == x) ? c : mine; }
        if (sum == G) break;
        __builtin_amdgcn_s_sleep(1);
        if ((++sp & 255u) == 0u) { if (xb_ld(&bar[XB_TMO])) break; if (sp > XB_SPIN_CAP) { atomicAdd(&bar[XB_TMO], 1u); break; } }
    }
    nloc = mine > 0u ? mine : 1u; nx = cnt > 0u ? cnt : 1u;
}
__device__ __forceinline__ void xcd_barrier(const XcdBarrier& b, int tid, unsigned G) {
    asm volatile("s_waitcnt vmcnt(0)" ::: "memory");
    __syncthreads();
    if (tid == 0) {
        unsigned* bar = b.bar;
        __builtin_amdgcn_s_waitcnt(0);
        unsigned nloc = b.st[0], nx = b.st[1];
        if (nloc == 0u) { xcd_barrier_complete(bar, b.x, G, nloc, nx); b.st[0] = nloc; b.st[1] = nx; }
        const unsigned old = xb_add(&bar[XB_XSUB(b.x)], 1u);
        const unsigned gen = old / nloc;
        if (old + 1u == (gen + 1u) * nloc) {
            __builtin_amdgcn_fence(__ATOMIC_RELEASE, "agent");
            asm volatile("s_waitcnt vmcnt(0)" ::: "memory");
            const unsigned og = xb_add(&bar[XB_TOP], 1u);
            const unsigned tg = og / nx;
            if (og + 1u == (tg + 1u) * nx) xb_add(&bar[XB_TOPGEN], 1u);
            else XB_SPIN(xb_ld(&bar[XB_TOPGEN]) == tg, bar);
            __builtin_amdgcn_fence(__ATOMIC_ACQUIRE, "agent");
            xb_add(&bar[XB_XGEN(b.x)], 1u);
            asm volatile("s_waitcnt vmcnt(0)" ::: "memory");
        } else {
            XB_SPIN(xb_ld(&bar[XB_XGEN(b.x)]) == gen, bar);
            __builtin_amdgcn_fence(__ATOMIC_ACQUIRE, "agent");
            asm volatile("s_waitcnt vmcnt(0)" ::: "memory");
        }
    }
    __syncthreads();
}

__global__ void __launch_bounds__(512, 2) fwd_kernel(Args a) {
    extern __shared__ __attribute__((aligned(16))) unsigned char lds_raw[];
    LAS unsigned char* lds = (LAS unsigned char*)lds_raw;
    unsigned char* ws = a.ws;
    XcdBarrier xb; xb.bar = (unsigned*)(ws + WS_CTL); xb.x = xb_xcc_id(); xb.st = (volatile LAS unsigned*)(lds + LDS_BYTES - 64);
    if (threadIdx.x == 0) { xb.st[0] = 0u; xb.st[1] = 0u; if (a.ph_hi - a.ph_lo > 1) (void)xb_add(&xb.bar[XB_XCNT(xb.x)], 1u); }
    __syncthreads();
#ifndef PROBE_MASK
#define PROBE_MASK 0
#endif
    for (int ph = a.ph_lo; ph < a.ph_hi; ++ph) {
      if (ph == 5 || ph == 9 || ph == 13 || ph == 17 || ph == 7 || ph == 15) continue;
      if (ph == 1 && a.ph_lo == 0) continue;
      for (int rep = 0; rep < (((PROBE_MASK >> ph) & 1) ? 3 : 1); ++rep) {
        if (ph > a.ph_lo || rep > 0) { if (a.ph_hi > NPH + 1000) cg::this_grid().sync();
          xcd_barrier(xb, threadIdx.x, gridDim.x); }
        int tid = threadIdx.x, bid = blockIdx.x, G = gridDim.x;
        asm volatile("" : "+v"(tid)); asm volatile("" : "+s"(bid)); asm volatile("" : "+s"(G));
        const int lane = tid & 63, wave = __builtin_amdgcn_readfirstlane(tid >> 6);
        if (ph == 0) {
#ifndef DIS_P0
 prologue(a, lds, tid, wave, lane, bid, G);
            if (a.ph_hi > 1) {
                if (tid == 0) { unsigned sp = 0; unsigned* mc = (unsigned*)(ws + WS_CTL) + CW_MODCNT;
                    while (__hip_atomic_load(mc, __ATOMIC_RELAXED, __HIP_MEMORY_SCOPE_AGENT) < 2u * (DM / 32)) { __builtin_amdgcn_s_sleep(2); if (++sp > (1u << 22)) break; }
                    __builtin_amdgcn_fence(__ATOMIC_ACQUIRE, "agent"); asm volatile("s_waitcnt vmcnt(0)" ::: "memory"); }
                __syncthreads();
                norm_phase(a, 1, wave, lane, bid, G);
            }
#endif
 }
        else if (ph == 1 || ph == 5 || ph == 9 || ph == 13 || ph == 17) {
#ifndef DIS_NORM
 norm_phase(a, ph, wave, lane, bid, G);
#endif
 }
        else if (ph == 3) {
#ifndef DIS_CONV
 convgate_phase(a, tid, bid, G);
#endif
 }
        else if (ph == 11) {
#ifndef DIS_ATTN
 attn_phase(a, lds, tid, wave, lane, bid, G);
#endif
 }
        else if (ph == 2) {
            pg8::Gemm g{(const bf16_t*)(ws + WS_H), (const bf16_t*)(ws + WS_WIN), MT, 3 * DM, DM}; pg8::EpiBf16 E{(bf16_t*)(ws + WS_BCX), 3 * DM};
            pg8::StaticOrder S; S.init(g.M, g.N, G, bid);
            pg8::gemm_phase<pg8::EpiBf16, pg8::StaticOrder>(lds, g, S, E, tid);
        }
        else if (ph == 6 || ph == 14) {
            const int l = ph == 14 ? 1 : 0;
            pg8::Gemm g{(const bf16_t*)(ws + WS_H), (const bf16_t*)(ws + WS_WUP) + (size_t)l * DM * 2 * DFF, MT, 2 * DFF, DM};
            pg8::EpiGate E{(bf16_t*)(ws + WS_A3), a.in[18] + (size_t)l * 3 * DFF, a.in[19] + (size_t)l * DFF, (float*)(ws + WS_SB)};
            pg8::StaticOrder S; S.init(g.M, g.N, G, bid);
            pg8::gemm_phase<pg8::EpiGate, pg8::StaticOrder>(lds, g, S, E, tid);
        }
        else if (ph == 10) {
            pg8::Gemm g{(const bf16_t*)(ws + WS_HB), (const bf16_t*)(ws + WS_WQKV), MT, 3 * DM, DM};
            float* sk = a.out + (size_t)MT * DM; float* sv = sk + (size_t)NB_P * NH * SEQ_P * HD;
            pg8::EpiQKV E{(bf16_t*)(ws + WS_Q), (bf16_t*)(ws + WS_K), (bf16_t*)(ws + WS_VT), sk, sv};
            pg8::StaticOrder S; S.init(g.M, g.N, G, bid);
#ifndef DIS_G2
            pg8::gemm_phase<pg8::EpiQKV, pg8::StaticOrder>(lds, g, S, E, tid);
#endif
        }
        else {
            pg8::Gemm g; pg8::EpiResNorm E;
            const float* MOD0 = (const float*)(ws + WS_MOD); const float* MOD1 = MOD0 + (size_t)NCV * MODW;
            float* X = a.out; float* XS = a.out + (size_t)MP * DM;
            float* xch = (float*)(ws + WS_XCH); unsigned* cnt = (unsigned*)(ws + WS_CTL) + CW_CNT;
            bf16_t* HA = (bf16_t*)(ws + WS_H); bf16_t* HB = (bf16_t*)(ws + WS_HB);
            if (ph == 4) { g = pg8::Gemm{(const bf16_t*)(ws + WS_A2), (const bf16_t*)(ws + WS_WOUT), MT, DM, DM};
                E = pg8::EpiResNorm{a.in[0], a.in[1], X, MOD0 + 2 * DM, HA, a.in[9], MOD0 + 3 * DM, MOD0 + 4 * DM, xch, cnt, 0}; }
            else if (ph == 8) { g = pg8::Gemm{(const bf16_t*)(ws + WS_A3), (const bf16_t*)(ws + WS_WDN), MT, DM, DFF};
                E = pg8::EpiResNorm{X, XS, X, MOD0 + 5 * DM, HB, a.in[8] + DM, MOD1, MOD1 + DM, xch + (size_t)MT * 4, cnt + 48 * 16, 0}; }
            else if (ph == 12) { g = pg8::Gemm{(const bf16_t*)(ws + WS_A2), (const bf16_t*)(ws + WS_WO), MT, DM, DM};
                E = pg8::EpiResNorm{X, XS, X, MOD1 + 2 * DM, HA, a.in[9] + DM, MOD1 + 3 * DM, MOD1 + 4 * DM, xch + (size_t)2 * MT * 4, cnt + 2 * 48 * 16, 0}; }
            else { g = pg8::Gemm{(const bf16_t*)(ws + WS_A3), (const bf16_t*)(ws + WS_WDN) + (size_t)DM * DFF, MT, DM, DFF};
                E = pg8::EpiResNorm{X, XS, X, MOD1 + 5 * DM, HA, a.in[21], MOD1, MOD1, xch + (size_t)3 * MT * 4, cnt + 3 * 48 * 16, 1}; }
            pg8::StaticOrder S; S.init(g.M, g.N, G, bid);
            if (ph != 16 && bid >= 192) {
                const int nidle = G - 192; constexpr int TI_A = TI_R1 + 640, TI_B = TI_R2 - I_DN;
                if (ph == 4) transpose_items(a, lds, TI_R0, TI_A, (bid - 192) * 8 + wave, nidle * 8, wave, lane);
                else if (ph == 8) transpose_items(a, lds, TI_A, TI_B, (bid - 192) * 8 + wave, nidle * 8, wave, lane);
                else transpose_items(a, lds, TI_B, TI_R2, (bid - 192) * 8 + wave, nidle * 8, wave, lane);
            }
            if (ph == 8 || ph == 16) { pg8::Unit u0; if (S.next(0, u0) && u0.pm >= 32) gate_fixup(a, ph == 16 ? 1 : 0, u0.pm, tid); }
#ifndef DIS_G3
            pg8::gemm_phase<pg8::EpiResNorm, pg8::StaticOrder>(lds, g, S, E, tid);
#endif
        }
      }
    }
}

extern "C" void kernel_launch(void* const* d_in, const int* in_sizes, int n_in, void* d_out, int out_size, void* d_ws, size_t ws_size, hipStream_t stream) {
    static int grid = 0;
    if (grid == 0) {
        if (n_in != 22 || ws_size < WS_END) { fprintf(stderr, "kernel_launch: unexpected n_in %d / ws_size %zu\n", n_in, ws_size); grid = -1; return; }
        int dev = 0, cus = 0, per_cu = 0;
        hipGetDevice(&dev); hipDeviceGetAttribute(&cus, hipDeviceAttributeMultiprocessorCount, dev);
        if (hipFuncSetAttribute((const void*)fwd_kernel, hipFuncAttributeMaxDynamicSharedMemorySize, LDS_BYTES) != hipSuccess) { fprintf(stderr, "hipFuncSetAttribute failed\n"); grid = -1; return; }
        hipOccupancyMaxActiveBlocksPerMultiprocessor(&per_cu, (const void*)fwd_kernel, 512, LDS_BYTES);
        (void)hipGetLastError();
        if (per_cu < 1) { fprintf(stderr, "occupancy query says %d\n", per_cu); per_cu = 1; }
        grid = cus;
    }
    if (grid < 0) return;
    Args a{};
    for (int i = 0; i < 22; ++i) a.in[i] = (const float*)d_in[i];
    a.out = (float*)d_out; a.ws = (unsigned char*)d_ws;
    if (hipMemsetAsync((char*)d_ws + WS_CTL, 0, CTL_BYTES, stream) != hipSuccess) { fprintf(stderr, "memset failed\n"); return; }
#if MK_MULTI
    for (int ph = 0; ph < NPH; ++ph) { a.ph_lo = ph; a.ph_hi = ph + 1; hipLaunchKernelGGL(fwd_kernel, dim3(grid), dim3(512), LDS_BYTES, stream, a); }
#else
    a.ph_lo = 0; a.ph_hi = NPH;
    void* args[] = {&a};
    hipError_t e = hipLaunchCooperativeKernel((const void*)fwd_kernel, dim3(grid), dim3(512), args, LDS_BYTES, stream);
    if (e != hipSuccess) fprintf(stderr, "cooperative launch failed: %s (grid %d)\n", hipGetErrorString(e), grid);
#endif
}
```
